# Optimizing an MI355X kernel written in HIP

```python
import math
import jax, jax.numpy as jnp
from jax import lax
import numpy as np

D_MODEL = 1024
BATCH = 8
SEQ = 4096
DEPTH = 1

HEAD_DIM = 128
MOBA_HEADS = 4
DSA_HEADS = 4
MOBA_W = MOBA_HEADS * HEAD_DIM
DSA_W = DSA_HEADS * HEAD_DIM
D_MIX = MOBA_W + DSA_W
MOBA_BLOCK = 256
MOBA_TOPK = 3
MOBA_Q_CHUNK = 64
DSA_MAX_TOPK = 256
DSA_Q_CHUNK = 128
KV_LORA = 256
IDX_HEADS = 8
IDX_DIM = 64
ROPE_THETA = 500000.0
ROPE_FRACTION_DIV = 4
N_EXPERTS = 256
EXPERT_TOPK = 8
N_GROUPS = 8
TOPK_GROUPS = 4
D_EXPERT = 256
D_SHARED = 256
ROUTED_SCALE = 2.5
MOE_BLOCK = 128
EPS = 1e-6

IN_SIZES = (MOBA_W, MOBA_W, MOBA_W, DSA_W, KV_LORA, IDX_HEADS * IDX_DIM, IDX_DIM, IDX_HEADS)
IN_COLS = sum(IN_SIZES)
IN_SPLITS = [int(v) for v in np.cumsum(IN_SIZES)[:-1]]

kernel_name = "hybrid_moba_dsa_moe_layer"


def rmsnorm(x, g):
    xf = x.astype(jnp.float32)
    y = xf * lax.rsqrt(jnp.mean(xf * xf, axis=-1, keepdims=True) + EPS)
    return (y * g.astype(jnp.float32)).astype(x.dtype)


def rope_tables(seq, rot_dim):
    inv = jnp.float32(ROPE_THETA) ** (-(jnp.arange(0, rot_dim, 2, dtype=jnp.float32) / rot_dim))
    ang = jnp.arange(seq, dtype=jnp.float32)[:, None] * inv[None, :]
    return jnp.cos(ang), jnp.sin(ang)


def partial_rope(x, cos, sin):
    half = cos.shape[-1]
    xf = x.astype(jnp.float32)
    x1 = xf[..., :half]
    x2 = xf[..., half:2 * half]
    c = cos[None, :, None, :]
    s = sin[None, :, None, :]
    out = jnp.concatenate([x1 * c - x2 * s, x2 * c + x1 * s, xf[..., 2 * half:]], axis=-1)
    return out.astype(x.dtype)


def moba_attention(q, k, v):
    B, S, H, dh = q.shape
    nb = -(-S // MOBA_BLOCK)
    pad = nb * MOBA_BLOCK - S

    def to_blocks(t):
        t = jnp.pad(t, ((0, 0), (0, pad), (0, 0), (0, 0)))
        return t.reshape(B, nb, MOBA_BLOCK, H, dh).transpose(0, 3, 1, 2, 4)

    kb = to_blocks(k)
    vb = to_blocks(v)
    kmean = jnp.mean(kb.astype(jnp.float32), axis=3)
    n_sel = min(MOBA_TOPK, nb)
    scale = dh ** -0.5
    bi = jnp.arange(B)[:, None, None]
    hi = jnp.arange(H)[None, :, None]
    blk_ids = jnp.arange(nb)
    key_off = jnp.arange(MOBA_BLOCK)

    def chunk(ci):
        start = ci * MOBA_Q_CHUNK
        qc = lax.dynamic_slice_in_dim(q, start, MOBA_Q_CHUNK, axis=1).transpose(0, 2, 1, 3)
        qpos = start + jnp.arange(MOBA_Q_CHUNK)
        own = start // MOBA_BLOCK
        gate = jnp.einsum('bhqd,bhnd->bhqn', qc.astype(jnp.float32), kmean)
        gate = jnp.where(blk_ids < own, gate, -jnp.inf)
        _, sel = lax.top_k(gate, n_sel)
        sel_ok = sel < own
        scores = []
        for j in range(n_sel):
            k_j = kb[bi, hi, sel[..., j]]
            s_j = jnp.einsum('bhqd,bhqkd->bhqk', qc, k_j).astype(jnp.float32) * scale
            scores.append(jnp.where(sel_ok[..., j, None], s_j, -jnp.inf))
        k_own = lax.dynamic_index_in_dim(kb, own, axis=2, keepdims=False)
        v_own = lax.dynamic_index_in_dim(vb, own, axis=2, keepdims=False)
        s_own = jnp.einsum('bhqd,bhkd->bhqk', qc, k_own).astype(jnp.float32) * scale
        own_pos = own * MOBA_BLOCK + key_off
        s_own = jnp.where(own_pos[None, :] <= qpos[:, None], s_own, -jnp.inf)
        p = jax.nn.softmax(jnp.concatenate(scores + [s_own], axis=-1), axis=-1).astype(v.dtype)
        p_parts = jnp.split(p, n_sel + 1, axis=-1)
        out = jnp.einsum('bhqk,bhkd->bhqd', p_parts[-1], v_own)
        for j in range(n_sel):
            v_j = vb[bi, hi, sel[..., j]]
            out = out + jnp.einsum('bhqk,bhqkd->bhqd', p_parts[j], v_j)
        return out.transpose(0, 2, 1, 3)

    outs = lax.map(chunk, jnp.arange(S // MOBA_Q_CHUNK))
    return outs.transpose(1, 0, 2, 3, 4).reshape(B, S, H, dh)


def dsa_attention(q, k, v, q_idx, k_idx, w_idx):
    B, S, H, dh = q.shape
    topk = min(DSA_MAX_TOPK, S // 4)
    scale = dh ** -0.5
    idx_scale = IDX_DIM ** -0.5
    key_pos = jnp.arange(S)
    bi = jnp.arange(B)[:, None, None]
    kif = k_idx.astype(jnp.float32)

    def chunk(ci):
        start = ci * DSA_Q_CHUNK
        qc = lax.dynamic_slice_in_dim(q, start, DSA_Q_CHUNK, axis=1)
        qic = lax.dynamic_slice_in_dim(q_idx, start, DSA_Q_CHUNK, axis=1)
        wic = lax.dynamic_slice_in_dim(w_idx, start, DSA_Q_CHUNK, axis=1)
        qpos = start + jnp.arange(DSA_Q_CHUNK)
        logits = jnp.einsum('bqhd,bsd->bqhs', qic.astype(jnp.float32), kif) * idx_scale
        iscore = jnp.einsum('bqhs,bqh->bqs', jax.nn.relu(logits), wic.astype(jnp.float32))
        causal = key_pos[None, :] <= qpos[:, None]
        iscore = jnp.where(causal[None], iscore, -jnp.inf)
        _, sel = lax.top_k(iscore, topk)
        ok = sel <= qpos[None, :, None]
        kg = k[bi, sel]
        vg = v[bi, sel]
        s = jnp.einsum('bqhd,bqkd->bqhk', qc, kg).astype(jnp.float32) * scale
        s = jnp.where(ok[:, :, None, :], s, -jnp.inf)
        p = jax.nn.softmax(s, axis=-1).astype(v.dtype)
        return jnp.einsum('bqhk,bqkd->bqhd', p, vg)

    outs = lax.map(chunk, jnp.arange(S // DSA_Q_CHUNK))
    return outs.transpose(1, 0, 2, 3, 4).reshape(B, S, H, dh)


def moe_ffn(h, w_router, router_bias, w_gate_e, w_up_e, w_down_e, w_gate_s, w_up_s, w_down_s):
    B, S, D = h.shape
    T = B * S
    hf = h.reshape(T, D)
    scores = jax.nn.sigmoid((hf @ w_router).astype(jnp.float32))
    biased = scores + router_bias.astype(jnp.float32)
    grp = biased.reshape(T, N_GROUPS, N_EXPERTS // N_GROUPS)
    grp_score = jnp.sum(lax.top_k(grp, 2)[0], axis=-1)
    _, grp_sel = lax.top_k(grp_score, TOPK_GROUPS)
    grp_mask = jnp.sum(jax.nn.one_hot(grp_sel, N_GROUPS, dtype=jnp.float32), axis=-2) > 0
    exp_mask = jnp.repeat(grp_mask, N_EXPERTS // N_GROUPS, axis=-1)
    _, expert_idx = lax.top_k(jnp.where(exp_mask, biased, -jnp.inf), EXPERT_TOPK)
    wts = jnp.take_along_axis(scores, expert_idx, axis=-1)
    wts = wts / jnp.sum(wts, axis=-1, keepdims=True) * ROUTED_SCALE
    A = T * EXPERT_TOPK
    e_flat = expert_idx.reshape(A).astype(jnp.int32)
    g_flat = wts.reshape(A)
    order = jnp.argsort(e_flat)
    e_sorted = e_flat[order]
    counts = jnp.bincount(e_flat, length=N_EXPERTS)
    starts = jnp.cumsum(counts) - counts
    padded = (counts + MOE_BLOCK - 1) // MOE_BLOCK * MOE_BLOCK
    pad_ends = jnp.cumsum(padded)
    pad_starts = pad_ends - padded
    dest = pad_starts[e_sorted] + (jnp.arange(A) - starts[e_sorted])
    n_blocks = A // MOE_BLOCK + N_EXPERTS
    P = n_blocks * MOE_BLOCK
    tok_buf = jnp.full((P,), T, jnp.int32).at[dest].set((order // EXPERT_TOPK).astype(jnp.int32))
    gate_buf = jnp.zeros((P,), jnp.float32).at[dest].set(g_flat[order])
    block_expert = jnp.minimum(
        jnp.searchsorted(pad_ends, jnp.arange(n_blocks) * MOE_BLOCK, side='right'), N_EXPERTS - 1)
    h_pad = jnp.concatenate([hf, jnp.zeros((1, D), hf.dtype)], axis=0)

    def expert_block(args):
        e, tok, g = args
        xb = h_pad[tok]
        a = xb @ w_gate_e[e]
        u = xb @ w_up_e[e]
        ob = (jax.nn.silu(a) * u) @ w_down_e[e]
        return ob * g[:, None].astype(ob.dtype)

    out = lax.map(expert_block, (block_expert, tok_buf.reshape(n_blocks, MOE_BLOCK),
                                 gate_buf.reshape(n_blocks, MOE_BLOCK)))
    routed = jax.ops.segment_sum(out.reshape(P, D), tok_buf, num_segments=T + 1)[:T]
    shared = (jax.nn.silu(hf @ w_gate_s) * (hf @ w_up_s)) @ w_down_s
    return (routed + shared).reshape(B, S, D)


def setup_inputs(seed: int = 0) -> dict:
    key = jax.random.key(seed)
    ks = jax.random.split(key, 24)
    L = DEPTH

    def nrm(k, shape, s):
        return jax.random.normal(k, shape, jnp.float32) * s

    return {
        "x": nrm(ks[0], (BATCH, SEQ, D_MODEL), 1.0),
        "c": nrm(ks[1], (BATCH, D_MODEL), 1.0),
        "w_ada": nrm(ks[2], (L, D_MODEL, 6 * D_MODEL), 0.5 * D_MODEL ** -0.5),
        "b_ada": nrm(ks[3], (L, 6 * D_MODEL), 0.01),
        "g_mix": 1.0 + nrm(ks[4], (L, D_MODEL), 0.05),
        "w_in": nrm(ks[5], (L, D_MODEL, IN_COLS), D_MODEL ** -0.5),
        "g_kv": 1.0 + nrm(ks[6], (L, KV_LORA), 0.05),
        "w_kv_up": nrm(ks[7], (L, KV_LORA, 2 * HEAD_DIM), KV_LORA ** -0.5),
        "g_moba_out": 1.0 + nrm(ks[8], (L, MOBA_W), 0.05),
        "g_dsa_out": 1.0 + nrm(ks[9], (L, DSA_W), 0.05),
        "w_out": nrm(ks[10], (L, D_MIX, D_MODEL), D_MIX ** -0.5),
        "g_ffn": 1.0 + nrm(ks[11], (L, D_MODEL), 0.05),
        "w_router": nrm(ks[12], (L, D_MODEL, N_EXPERTS), D_MODEL ** -0.5),
        "router_bias": nrm(ks[13], (L, N_EXPERTS), 0.01),
        "w_gate_e": nrm(ks[14], (L, N_EXPERTS, D_MODEL, D_EXPERT), D_MODEL ** -0.5),
        "w_up_e": nrm(ks[15], (L, N_EXPERTS, D_MODEL, D_EXPERT), D_MODEL ** -0.5),
        "w_down_e": nrm(ks[16], (L, N_EXPERTS, D_EXPERT, D_MODEL), D_EXPERT ** -0.5),
        "w_gate_s": nrm(ks[17], (L, D_MODEL, D_SHARED), D_MODEL ** -0.5),
        "w_up_s": nrm(ks[18], (L, D_MODEL, D_SHARED), D_MODEL ** -0.5),
        "w_down_s": nrm(ks[19], (L, D_SHARED, D_MODEL), D_SHARED ** -0.5),
        "g_final": 1.0 + nrm(ks[20], (D_MODEL,), 0.05),
    }


def reference(x, c, w_ada, b_ada, g_mix, w_in, g_kv, w_kv_up, g_moba_out, g_dsa_out, w_out,
              g_ffn, w_router, router_bias, w_gate_e, w_up_e, w_down_e, w_gate_s, w_up_s,
              w_down_s, g_final):
    B, S, _ = x.shape
    cos_h, sin_h = rope_tables(S, HEAD_DIM // ROPE_FRACTION_DIV)
    cos_i, sin_i = rope_tables(S, IDX_DIM // ROPE_FRACTION_DIV)
    c_act = jax.nn.silu(c)
    for l in range(DEPTH):
        mod = c_act @ w_ada[l] + b_ada[l]
        sh1, sc1, gt1, sh2, sc2, gt2 = [m[:, None, :] for m in jnp.split(mod, 6, axis=-1)]

        h = rmsnorm(x, g_mix[l]) * (1.0 + sc1) + sh1
        proj = h @ w_in[l]
        q_m, k_m, v_m, q_d, ckv, q_i, k_i, w_i = jnp.split(proj, IN_SPLITS, axis=-1)
        q_m = partial_rope(q_m.reshape(B, S, MOBA_HEADS, HEAD_DIM), cos_h, sin_h)
        k_m = partial_rope(k_m.reshape(B, S, MOBA_HEADS, HEAD_DIM), cos_h, sin_h)
        v_m = v_m.reshape(B, S, MOBA_HEADS, HEAD_DIM)
        o_m = moba_attention(q_m, k_m, v_m).reshape(B, S, MOBA_W)
        q_d = partial_rope(q_d.reshape(B, S, DSA_HEADS, HEAD_DIM), cos_h, sin_h)
        kv = rmsnorm(ckv, g_kv[l]) @ w_kv_up[l]
        k_d, v_d = jnp.split(kv, 2, axis=-1)
        k_d = partial_rope(k_d[:, :, None, :], cos_h, sin_h)[:, :, 0, :]
        q_i = partial_rope(q_i.reshape(B, S, IDX_HEADS, IDX_DIM), cos_i, sin_i)
        k_i = partial_rope(k_i[:, :, None, :], cos_i, sin_i)[:, :, 0, :]
        w_i = w_i * (IDX_HEADS ** -0.5)
        o_d = dsa_attention(q_d, k_d, v_d, q_i, k_i, w_i).reshape(B, S, DSA_W)
        mixed = jnp.concatenate([rmsnorm(o_m, g_moba_out[l]), rmsnorm(o_d, g_dsa_out[l])], axis=-1)
        x = x + gt1 * (mixed @ w_out[l])

        h = rmsnorm(x, g_ffn[l]) * (1.0 + sc2) + sh2
        y = moe_ffn(h, w_router[l], router_bias[l], w_gate_e[l], w_up_e[l], w_down_e[l],
                    w_gate_s[l], w_up_s[l], w_down_s[l])
        x = x + gt2 * y
    return rmsnorm(x, g_final)
```

```cpp
#include <hip/hip_runtime.h>
#include <cstdio>
#include <cstdint>

#define GAS __attribute__((address_space(1)))
#define LAS __attribute__((address_space(3)))
typedef unsigned short bf16_t;
typedef short bf16x8 __attribute__((ext_vector_type(8)));
typedef float f32x4 __attribute__((ext_vector_type(4)));
typedef float f32x2 __attribute__((ext_vector_type(2)));
typedef unsigned u32x4 __attribute__((ext_vector_type(4)));
typedef unsigned u32x2 __attribute__((ext_vector_type(2)));
typedef _Float16 f16_t;

constexpr int NB = 8, SEQ = 4096, T = NB * SEQ, DM = 1024;
constexpr int NPROJ = 2888, NPROJP = 3072;
constexpr int NE = 256, NEX = 257;
constexpr int NWAVES = 8, NTHR = 512;
constexpr float EPS = 1e-6f;
constexpr int NPHASE = 15;

constexpr size_t MiB = 1u << 20;
constexpr size_t WS_CTL = 0, CTL_ZERO_BYTES = 65536;
constexpr int CW_CNT = 4096, CNT_STRIDE = 32;
constexpr size_t WS_MOD = 1 * MiB;
constexpr size_t WS_KMEAN = 1 * MiB + 256 * 1024;
constexpr size_t WS_COSH = 2 * MiB, WS_SINH = WS_COSH + 256 * 1024, WS_COSI = WS_SINH + 256 * 1024, WS_SINI = WS_COSI + 128 * 1024;
constexpr size_t WS_WIN = 4 * MiB;
constexpr size_t WS_WOUT = 10 * MiB;
constexpr size_t WS_WR = 12 * MiB;
constexpr size_t WS_WKV = 14 * MiB;
constexpr size_t WS_WD = 16 * MiB;
constexpr size_t WS_WGU = 145 * MiB;
constexpr size_t WS_H = 402 * MiB;
constexpr size_t WS_KS = 466 * MiB;
constexpr size_t WS_QM = 706 * MiB, WS_KM = 738 * MiB, WS_VM = 770 * MiB, WS_QD = 802 * MiB;
constexpr size_t WS_MASK = 834 * MiB;
constexpr size_t WS_CKVN = 834 * MiB, WS_KVRAW = 850 * MiB, WS_KD = 866 * MiB, WS_VD = 874 * MiB;
constexpr size_t WS_QI = 896 * MiB, WS_KI = 928 * MiB, WS_WI = 932 * MiB, WS_OM = 936 * MiB;
constexpr size_t WS_H2 = 402 * MiB;
constexpr size_t WS_SH = 530 * MiB;
constexpr size_t WS_RLOG = 530 * MiB;
constexpr size_t WS_EW = 835 * MiB, WS_LIST = 836 * MiB;
constexpr size_t WS_ACT = 658 * MiB;
constexpr size_t WS_CA = 145 * MiB;
constexpr size_t WS_INV = 834 * MiB;
constexpr size_t WS_X1 = 944 * MiB;
constexpr size_t WS_END = 1024 * MiB;
static_assert(WS_WD + (size_t)NEX * 1024 * 256 * 2 <= WS_WGU && WS_WGU + (size_t)NEX * 512 * 1024 * 2 <= WS_H, "weights map");
static_assert(WS_LIST + (size_t)NE * T * 4 <= WS_KD + 16 * MiB && WS_ACT + 360448ull * 512 <= WS_INV, "moe map");

constexpr int RING_BYTES = 131072;
constexpr int MISC_OFF = 157 * 1024;
constexpr int TAB_OFF = MISC_OFF + 256;
constexpr int TOK_OFF = RING_BYTES, MAX_UNITS = 20;
static_assert(TOK_OFF + MAX_UNITS * 1024 <= MISC_OFF, "lds map");
constexpr int LDS_BYTES = 160 * 1024;

__device__ __forceinline__ unsigned f2bf(float f) { unsigned u = __builtin_bit_cast(unsigned, f); return (u + 0x7fffu + ((u >> 16) & 1u)) >> 16; }
__device__ __forceinline__ float bf2f(unsigned h) { return __builtin_bit_cast(float, h << 16); }
__device__ __forceinline__ unsigned pk2(float lo, float hi) { unsigned r; asm("v_cvt_pk_bf16_f32 %0, %1, %2" : "=v"(r) : "v"(lo), "v"(hi)); return r; }
__device__ __forceinline__ float bflo(unsigned w) { return __builtin_bit_cast(float, w << 16); }
__device__ __forceinline__ float bfhi(unsigned w) { return __builtin_bit_cast(float, w & 0xffff0000u); }
__device__ __forceinline__ int lane_opaque() { int l; asm volatile("v_mbcnt_lo_u32_b32 %0, -1, 0\n\tv_mbcnt_hi_u32_b32 %0, -1, %0" : "=v"(l)); return l; }


template <int CTRL> __device__ __forceinline__ float dpp_mov_f(float v) { return __builtin_bit_cast(float, __builtin_amdgcn_update_dpp(__builtin_bit_cast(int, v), __builtin_bit_cast(int, v), CTRL, 0xF, 0xF, false)); }
__device__ __forceinline__ float row_max16(float v) {
    v = fmaxf(v, dpp_mov_f<0xB1>(v)); v = fmaxf(v, dpp_mov_f<0x4E>(v)); v = fmaxf(v, dpp_mov_f<0x141>(v)); v = fmaxf(v, dpp_mov_f<0x140>(v)); return v;
}
__device__ __forceinline__ float rdl_f(float v, int l) { return __builtin_bit_cast(float, __builtin_amdgcn_readlane(__builtin_bit_cast(int, v), l)); }
__device__ __forceinline__ float wave_sum_dpp(float v) {
    v += dpp_mov_f<0xB1>(v); v += dpp_mov_f<0x4E>(v); v += dpp_mov_f<0x141>(v); v += dpp_mov_f<0x140>(v);
    return (rdl_f(v, 0) + rdl_f(v, 16)) + (rdl_f(v, 32) + rdl_f(v, 48));
}
__device__ __forceinline__ float wave_max_dpp(float v) { v = row_max16(v); return fmaxf(fmaxf(rdl_f(v, 0), rdl_f(v, 16)), fmaxf(rdl_f(v, 32), rdl_f(v, 48))); }
__device__ __forceinline__ void half_max_dpp(float v, float& lo, float& hi) { v = row_max16(v); lo = fmaxf(rdl_f(v, 0), rdl_f(v, 16)); hi = fmaxf(rdl_f(v, 32), rdl_f(v, 48)); }
#define VM_WAIT() asm volatile("s_waitcnt vmcnt(0)" ::: "memory")
#define LDS_WAIT() asm volatile("s_waitcnt lgkmcnt(0)" ::: "memory")

struct Args { const float* in[21]; float* out; unsigned char* ws; int ph_lo, ph_hi; };

#define XB_TMO      128
#define XB_XCNT(j)  (256  + 64 * (j))
#define XB_XSUB(j)  (1280 + 64 * (j))
#define XB_XGEN(j)  (2304 + 64 * (j))
#define XB_TOP      3328
#define XB_TOPGEN   3392
#define XCD_BAR_WORDS 3456
#define XB_SPIN_CAP (1u << 22)
__device__ __forceinline__ unsigned xb_ld(unsigned* p)              { return __hip_atomic_load(p, __ATOMIC_RELAXED, __HIP_MEMORY_SCOPE_AGENT); }
__device__ __forceinline__ unsigned xb_add(unsigned* p, unsigned v) { return __hip_atomic_fetch_add(p, v, __ATOMIC_RELAXED, __HIP_MEMORY_SCOPE_AGENT); }
__device__ __forceinline__ unsigned xb_xcc_id() { return (unsigned)__builtin_amdgcn_s_getreg((3 << 11) | 20) & 0xFu; }
#define XB_SPIN(cond, bar) do { unsigned _sp = 0; while (cond) { __builtin_amdgcn_s_sleep(1); \
    if ((++_sp & 255u) == 0u) { if (xb_ld(&(bar)[XB_TMO])) break; if (_sp > XB_SPIN_CAP) { atomicAdd(&(bar)[XB_TMO], 1u); break; } } } } while (0)
struct XcdBarrier { unsigned* bar; unsigned x; volatile LAS unsigned* st; };
__device__ __forceinline__ XcdBarrier xcd_barrier_post(unsigned* bar, volatile LAS unsigned* st, bool t0) {
    XcdBarrier b; b.bar = bar; b.x = xb_xcc_id(); b.st = st;
    if (t0) (void)xb_add(&bar[XB_XCNT(b.x)], 1u);
    return b;
}
__device__ __forceinline__ void xcd_barrier_complete(unsigned* bar, unsigned x, unsigned& nloc, unsigned& nx) {
    const unsigned G = gridDim.x * gridDim.y * gridDim.z;
    unsigned sum, cnt, mine, sp = 0u;
    for (;;) {
        sum = 0u; cnt = 0u; mine = 0u;
#pragma unroll
        for (unsigned j = 0; j < 16; ++j) { const unsigned c = xb_ld(&bar[XB_XCNT(j)]); sum += c; cnt += (c > 0u) ? 1u : 0u; mine = (j == x) ? c : mine; }
        if (sum == G) break;
        __builtin_amdgcn_s_sleep(1);
        if ((++sp & 255u) == 0u) { if (xb_ld(&bar[XB_TMO])) break; if (sp > XB_SPIN_CAP) { atomicAdd(&bar[XB_TMO], 1u); break; } }
    }
    nloc = mine > 0u ? mine : 1u; nx = cnt > 0u ? cnt : 1u;
}
__device__ __forceinline__ void xcd_barrier(const XcdBarrier& b, int wave) {
    asm volatile("s_waitcnt vmcnt(0)" ::: "memory");
    __syncthreads();
    if (wave == 0 && lane_opaque() == 0) {
        unsigned* bar = b.bar;
        __builtin_amdgcn_s_waitcnt(0);
        unsigned nloc = b.st[0], nx = b.st[1];
        if (nloc == 0u) { xcd_barrier_complete(bar, b.x, nloc, nx); b.st[0] = nloc; b.st[1] = nx; }
        const unsigned old = xb_add(&bar[XB_XSUB(b.x)], 1u);
        const unsigned gen = old / nloc;
        if (old + 1u == (gen + 1u) * nloc) {
            __builtin_amdgcn_fence(__ATOMIC_RELEASE, "agent");
            asm volatile("s_waitcnt vmcnt(0)" ::: "memory");
            const unsigned og = xb_add(&bar[XB_TOP], 1u);
            const unsigned tg = og / nx;
            if (og + 1u == (tg + 1u) * nx) xb_add(&bar[XB_TOPGEN], 1u);
            else XB_SPIN(xb_ld(&bar[XB_TOPGEN]) == tg, bar);
            __builtin_amdgcn_fence(__ATOMIC_ACQUIRE, "agent");
            xb_add(&bar[XB_XGEN(b.x)], 1u);
            asm volatile("s_waitcnt vmcnt(0)" ::: "memory");
        } else {
            XB_SPIN(xb_ld(&bar[XB_XGEN(b.x)]) == gen, bar);
            __builtin_amdgcn_fence(__ATOMIC_ACQUIRE, "agent");
            asm volatile("s_waitcnt vmcnt(0)" ::: "memory");
        }
    }
    __syncthreads();
}

namespace pg8 {
constexpr int BM = 256, BK = 64, HALF = 128, HTB = HALF * BK * 2, NXCD = 8, WGM = 8;
__host__ __device__ __forceinline__ int lds_byte(int r, int c) { const int st = (r >> 4) * 2 + (c >> 5), rr = r & 15, cc = c & 31, ob = rr * 64 + cc * 2; return st * 1024 + (ob ^ (((ob >> 9) & 1) << 5)); }
__host__ __device__ __forceinline__ void stage_rc(int b, int& R, int& C) { const int st = b / 1024, sb = b % 1024, swz = sb ^ (((sb >> 9) & 1) << 5); R = (st >> 1) * 16 + swz / 64; C = (st & 1) * 32 + (swz % 64) / 2; }
__host__ __device__ __forceinline__ int perm32(int rho) { const int n = rho >> 4, i = rho & 15; return 8 * (i >> 2) + 4 * n + (i & 3); }

struct Unit { int pm, pn, e, rt, slot; };

struct DenseSched {
    const char* A; const char* B; unsigned lda, ldb; int nM, nN, nwg, G, c;
    __device__ __forceinline__ void init(const void* A_, unsigned lda_, const void* B_, unsigned ldb_, int M, int N, int G_, int c_) { A = (const char*)A_; B = (const char*)B_; lda = lda_; ldb = ldb_; nM = M / BM; nN = N / BM; nwg = nM * nN; G = G_; c = c_; }
    __device__ __forceinline__ bool next(int i, Unit& u) const {
        const long L = (long)i * G + c; if (L >= nwg) return false;
        int wgid = (int)L; { const int q = nwg / NXCD, r = nwg % NXCD, xcd = wgid % NXCD, off = wgid / NXCD; wgid = (xcd < r ? xcd * (q + 1) : r * (q + 1) + (xcd - r) * q) + off; }
        const int nig = WGM * nN, gid = wgid / nig, fm = gid * WGM, gsz = (nM - fm) < WGM ? (nM - fm) : WGM;
        u.pm = fm + ((wgid % nig) % gsz); u.pn = (wgid % nig) / gsz; u.e = 0; u.rt = u.pm; u.slot = i; return true;
    }
    __device__ __forceinline__ const char* a_ubase(const Unit& u) const { return A + (size_t)u.pm * BM * lda; }
    __device__ __forceinline__ void a_off(const Unit& u, const int (&R)[2], const int (&C)[2], unsigned (&o)[2][2]) const {
#pragma unroll
        for (int h = 0; h < 2; ++h)
#pragma unroll
            for (int i = 0; i < 2; ++i) o[h][i] = (unsigned)(h * HALF + R[i]) * lda + (unsigned)C[i] * 2u;
    }
    __device__ __forceinline__ const char* b_base(const Unit& u) const { return B + (size_t)u.pn * BM * ldb; }
};

template <class Epi, class Sched, bool ALIGN_EPI, bool MIDHOOK = false>
__device__ __forceinline__ void gemm_phase(LAS unsigned char* lds, const Sched& S, const Epi& E, const int K, const int wid) {
    const int lane = lane_opaque(), tid = wid * 64 + lane, wr = wid >> 2, wc = wid & 3, fr = lane & 15, fq = lane >> 4;
    const int nt = K / BK;
    int Rr[2], Cc[2]; unsigned voffB[2];
#pragma unroll
    for (int i = 0; i < 2; ++i) { int R, C; stage_rc(tid * 16 + i * 8192, R, C); Rr[i] = R; Cc[i] = C; const int Rb = Epi::PERM ? ((R & ~31) + perm32(R & 31)) : R;
        voffB[i] = (unsigned)Rb * S.ldb + (unsigned)C * 2u; }
    const size_t kstep = (size_t)(BK * 2);
    const size_t hstepB = (size_t)HALF * S.ldb;
    const unsigned ldsw = (unsigned)wid * 1024u;
    const int aoff = lds_byte(wr * 64 + fr, fq * 8), boff = lds_byte(wc * 32 + fr, fq * 8);
#define PG8_SA(b, h) (((b) * 2 + (h)) * HTB)
#define PG8_SB(b, h) ((4 + (b) * 2 + (h)) * HTB)
#define PG8_STAGE(bufoff, gbase, voff) do { _Pragma("unroll") for (int _i = 0; _i < 2; ++_i) \
        __builtin_amdgcn_global_load_lds((const unsigned*)((const char*)(gbase) + (voff)[_i]), (LAS unsigned*)(lds + (bufoff) + ldsw + _i * 8192), 16, 0, 0); } while (0)
#define PG8_LDA(dst, b, h) do { _Pragma("unroll") for (int m = 0; m < 4; ++m) _Pragma("unroll") for (int k = 0; k < 2; ++k) dst[m][k] = *(const LAS bf16x8*)(lds + PG8_SA(b, h) + aoff + m * 2048 + k * 1024); } while (0)
#define PG8_LDB(dst, b, h) do { _Pragma("unroll") for (int n = 0; n < 2; ++n) _Pragma("unroll") for (int k = 0; k < 2; ++k) dst[n][k] = *(const LAS bf16x8*)(lds + PG8_SB(b, h) + boff + n * 2048 + k * 1024); } while (0)
#define PG8_MMA(ai, bj, At, Bt) do { __builtin_amdgcn_s_setprio(1); _Pragma("unroll") for (int m = 0; m < 4; ++m) _Pragma("unroll") for (int n = 0; n < 2; ++n) _Pragma("unroll") for (int k = 0; k < 2; ++k) \
        acc[ai][bj][m][n] = __builtin_amdgcn_mfma_f32_16x16x32_bf16(Bt[n][k], At[m][k], acc[ai][bj][m][n], 0, 0, 0); __builtin_amdgcn_s_setprio(0); } while (0)
#define PG8_WAIT_V(n) asm volatile("s_waitcnt vmcnt(" #n ")" ::: "memory")
#define PG8_WAIT_L(n) asm volatile("s_waitcnt lgkmcnt(" #n ")" ::: "memory")
#define PG8_BAR __builtin_amdgcn_s_barrier()
#define PG8_SCHED __builtin_amdgcn_sched_barrier(0)
    Unit cur, nxt; int ui = 0;
    if (!S.next(0, cur)) return;
    if constexpr (MIDHOOK) E.begin(cur, wid);
    f32x4 acc[2][2][4][2];
#pragma unroll
    for (int a = 0; a < 2; ++a)
#pragma unroll
        for (int b = 0; b < 2; ++b)
#pragma unroll
            for (int m = 0; m < 4; ++m)
#pragma unroll
                for (int n = 0; n < 2; ++n) acc[a][b][m][n] = (f32x4){0.f, 0.f, 0.f, 0.f};
    bf16x8 At[4][2], B0[2][2], B1[2][2];
    unsigned oc[2][2];
    S.a_off(cur, Rr, Cc, oc);
    const char* cA = S.a_ubase(cur);
    const char* cB = S.b_base(cur);
    PG8_STAGE(PG8_SB(0, 0), cB, voffB); PG8_STAGE(PG8_SB(0, 1), cB + hstepB, voffB); PG8_STAGE(PG8_SA(0, 0), cA, oc[0]); PG8_STAGE(PG8_SA(0, 1), cA, oc[1]);
    if (wr == 1) PG8_BAR;
    PG8_WAIT_V(2); PG8_BAR;
    PG8_STAGE(PG8_SB(1, 0), cB + kstep, voffB); PG8_STAGE(PG8_SA(1, 0), cA + kstep, oc[0]); PG8_STAGE(PG8_SB(1, 1), cB + hstepB + kstep, voffB);
    PG8_WAIT_V(6); PG8_BAR;
    for (;;) {
        const bool has_next = S.next(ui + 1, nxt);
        if constexpr (MIDHOOK) { if (has_next) E.begin(nxt, wid); }
        const char* nB = has_next ? S.b_base(nxt) : cB; const char* nA = has_next ? S.a_ubase(nxt) : cA;
#pragma nounroll
        for (int t = 0; t < nt; t += 2) {
            const bool last = (t == nt - 2);
            if constexpr (MIDHOOK) { if (t == nt / 2) E.mid(acc, cur, wr, fr); }
            const char* a1 = cA + (size_t)(t + 1) * kstep;
            const char* a2 = last ? nA : cA + (size_t)(t + 2) * kstep; const char* b2 = last ? nB : cB + (size_t)(t + 2) * kstep;
            const char* a3 = a2 + kstep; const char* b3 = b2 + kstep;
            PG8_LDB(B0, 0, 0); PG8_LDB(B1, 0, 1); PG8_SCHED; PG8_LDA(At, 0, 0); PG8_STAGE(PG8_SA(1, 1), a1, oc[1]);
            if (last && has_next) S.a_off(nxt, Rr, Cc, oc);
            PG8_WAIT_V(8); PG8_WAIT_L(0); PG8_BAR; PG8_MMA(0, 0, At, B0); PG8_MMA(0, 1, At, B1); PG8_BAR; PG8_SCHED;
            PG8_LDA(At, 0, 1); PG8_STAGE(PG8_SB(0, 0), b2, voffB); PG8_STAGE(PG8_SB(0, 1), b2 + hstepB, voffB); PG8_STAGE(PG8_SA(0, 0), a2, oc[0]);
            PG8_WAIT_V(8); PG8_WAIT_L(0); PG8_BAR; PG8_MMA(1, 0, At, B0); PG8_MMA(1, 1, At, B1); PG8_BAR; PG8_SCHED;
            PG8_LDB(B0, 1, 0); PG8_LDB(B1, 1, 1); PG8_SCHED; PG8_LDA(At, 1, 0); PG8_STAGE(PG8_SA(0, 1), a2, oc[1]);
            PG8_WAIT_V(8); PG8_WAIT_L(0); PG8_BAR; PG8_MMA(0, 0, At, B0); PG8_MMA(0, 1, At, B1); PG8_BAR; PG8_SCHED;
            PG8_LDA(At, 1, 1); PG8_STAGE(PG8_SB(1, 0), b3, voffB); PG8_STAGE(PG8_SB(1, 1), b3 + hstepB, voffB); PG8_STAGE(PG8_SA(1, 0), a3, oc[0]);
            PG8_WAIT_V(8); PG8_WAIT_L(0); PG8_BAR; PG8_MMA(1, 0, At, B0); PG8_MMA(1, 1, At, B1); PG8_BAR; PG8_SCHED;
        }
        if constexpr (ALIGN_EPI) { if (wr == 0) PG8_BAR; }
        E(acc, cur, wr, wc, fr, fq);
        if (!has_next) break;
#pragma unroll
        for (int a = 0; a < 2; ++a)
#pragma unroll
            for (int b = 0; b < 2; ++b)
#pragma unroll
                for (int m = 0; m < 4; ++m)
#pragma unroll
                    for (int n = 0; n < 2; ++n) acc[a][b][m][n] = (f32x4){0.f, 0.f, 0.f, 0.f};
        cur = nxt; cB = nB; cA = nA; ++ui;
        if constexpr (ALIGN_EPI) { if (wr == 1) PG8_BAR; }
    }
    PG8_WAIT_V(0);
    if constexpr (!ALIGN_EPI) { if (wr == 0) PG8_BAR; }
    PG8_BAR;
#undef PG8_SA
#undef PG8_SB
#undef PG8_STAGE
#undef PG8_LDA
#undef PG8_LDB
#undef PG8_MMA
#undef PG8_WAIT_V
#undef PG8_WAIT_L
#undef PG8_BAR
#undef PG8_SCHED
}

struct EpiProjFused {
    static constexpr bool PERM = true;
    bf16_t* QM; bf16_t* KM; bf16_t* VM; bf16_t* QD; bf16_t* CKV; float* SSQ; f16_t* QI; f16_t* KI; float* WI;
    const float* cosH; const float* sinH; const float* cosI; const float* sinI;
    __device__ __forceinline__ void operator()(const f32x4 (&acc)[2][2][4][2], const Unit& u, int wr, int wc, int fr, int fq) const {
        typedef _Float16 f16x8v __attribute__((ext_vector_type(8)));
        const int pn = u.pn, rowb = u.pm * BM + wr * 64 + fr;
        if (pn < 8) {
            const int sec = pn >> 1; bf16_t* dstb = sec == 0 ? QM : sec == 1 ? KM : sec == 2 ? VM : QD;
            const bool rope = (sec != 2) && (wc == 0);
            const int i0 = 8 * (fq & 1);
#define EPF_LD(it_, A0, A1, A2, A3) do { const int s_ = (rowb + ((it_) >> 2) * HALF + ((it_) & 3) * 16) & 4095; \
                A0 = *(const f32x4*)(cosH + s_ * 16 + i0); A1 = *(const f32x4*)(cosH + s_ * 16 + i0 + 4); A2 = *(const f32x4*)(sinH + s_ * 16 + i0); A3 = *(const f32x4*)(sinH + s_ * 16 + i0 + 4); } while (0)
            if (rope) {
                f32x4 n0, n1, n2, n3; EPF_LD(0, n0, n1, n2, n3);
#pragma unroll
                for (int it = 0; it < 8; ++it) { const int ai = it >> 2, m = it & 3; const int row = rowb + ai * HALF + m * 16, b = row >> 12, s = row & 4095;
                    const f32x4 c0 = n0, c1 = n1, s0 = n2, s1 = n3;
                    if (it < 7) { EPF_LD(it + 1, n0, n1, n2, n3); __builtin_amdgcn_sched_barrier(0); }
#pragma unroll
                    for (int bj = 0; bj < 2; ++bj) { f32x4 v0 = acc[ai][bj][m][0], v1 = acc[ai][bj][m][1]; f32x4 y0, y1;
#pragma unroll
                        for (int j = 0; j < 4; ++j) { y0[j] = __shfl_xor(v0[j], 32); y1[j] = __shfl_xor(v1[j], 32); }
                        const float sg = fq < 2 ? -1.f : 1.f;
                        v0 = v0 * c0 + sg * (y0 * s0); v1 = v1 * c1 + sg * (y1 * s1);
                        u32x4 w; w.x = pk2(v0[0], v0[1]); w.y = pk2(v0[2], v0[3]); w.z = pk2(v1[0], v1[1]); w.w = pk2(v1[2], v1[3]);
                        const int h = 2 * (pn & 1) + bj;
                        *(u32x4*)(dstb + ((size_t)(b * 4 + h) * SEQ + s) * 128 + wc * 32 + 8 * fq) = w; } }
            } else {
#pragma unroll
                for (int it = 0; it < 8; ++it) { const int ai = it >> 2, m = it & 3; const int row = rowb + ai * HALF + m * 16, b = row >> 12, s = row & 4095;
#pragma unroll
                    for (int bj = 0; bj < 2; ++bj) { const f32x4 v0 = acc[ai][bj][m][0], v1 = acc[ai][bj][m][1];
                        u32x4 w; w.x = pk2(v0[0], v0[1]); w.y = pk2(v0[2], v0[3]); w.z = pk2(v1[0], v1[1]); w.w = pk2(v1[2], v1[3]);
                        const int h = 2 * (pn & 1) + bj;
                        *(u32x4*)(dstb + ((size_t)(b * 4 + h) * SEQ + s) * 128 + wc * 32 + 8 * fq) = w; } }
            }
#undef EPF_LD
        } else if (pn == 8) {
#pragma unroll
            for (int ai = 0; ai < 2; ++ai)
#pragma unroll
                for (int m = 0; m < 4; ++m) { const int row = rowb + ai * HALF + m * 16; float ss = 0.f;
#pragma unroll
                    for (int bj = 0; bj < 2; ++bj) { const f32x4 v0 = acc[ai][bj][m][0], v1 = acc[ai][bj][m][1];
                        ss += (v0[0] * v0[0] + v0[1] * v0[1]) + (v0[2] * v0[2] + v0[3] * v0[3]) + (v1[0] * v1[0] + v1[1] * v1[1]) + (v1[2] * v1[2] + v1[3] * v1[3]);
                        u32x4 w; w.x = pk2(v0[0], v0[1]); w.y = pk2(v0[2], v0[3]); w.z = pk2(v1[0], v1[1]); w.w = pk2(v1[2], v1[3]);
                        *(u32x4*)(CKV + (size_t)row * 256 + bj * HALF + wc * 32 + 8 * fq) = w; }
                    ss += __shfl_xor(ss, 16); ss += __shfl_xor(ss, 32);
                    if (fq == 0) SSQ[(size_t)row * 4 + wc] = ss; }
        } else if (pn < 11) {
            const bool rope = (wc & 1) == 0;
#pragma unroll
            for (int ai = 0; ai < 2; ++ai)
#pragma unroll
                for (int m = 0; m < 4; ++m) { const int row = rowb + ai * HALF + m * 16, s = row & 4095;
                    f32x4 c0 = {0.f, 0.f, 0.f, 0.f}, c1 = c0, s0 = c0, s1 = c0;
                    if (rope) { c0 = *(const f32x4*)(cosI + s * 8); c1 = *(const f32x4*)(cosI + s * 8 + 4); s0 = *(const f32x4*)(sinI + s * 8); s1 = *(const f32x4*)(sinI + s * 8 + 4); }
#pragma unroll
                    for (int bj = 0; bj < 2; ++bj) { f32x4 v0 = acc[ai][bj][m][0], v1 = acc[ai][bj][m][1];
                        if (rope) { f32x4 y0, y1;
#pragma unroll
                            for (int j = 0; j < 4; ++j) { y0[j] = __shfl_xor(v0[j], 16); y1[j] = __shfl_xor(v1[j], 16); }
                            if (fq < 2) { const float sg = fq == 0 ? -1.f : 1.f; v0 = v0 * c0 + sg * (y0 * s0); v1 = v1 * c1 + sg * (y1 * s1); } }
                        f16x8v o; o[0] = (f16_t)v0[0]; o[1] = (f16_t)v0[1]; o[2] = (f16_t)v0[2]; o[3] = (f16_t)v0[3]; o[4] = (f16_t)v1[0]; o[5] = (f16_t)v1[1]; o[6] = (f16_t)v1[2]; o[7] = (f16_t)v1[3];
                        *(f16x8v*)(QI + (size_t)row * 512 + (pn - 9) * 256 + bj * HALF + wc * 32 + 8 * fq) = o; } }
        } else {
            if (wc < 2) {
#pragma unroll
                for (int ai = 0; ai < 2; ++ai)
#pragma unroll
                    for (int m = 0; m < 4; ++m) { const int row = rowb + ai * HALF + m * 16, s = row & 4095;
                        f32x4 v0 = acc[ai][0][m][0], v1 = acc[ai][0][m][1];
                        if (wc == 0) { f32x4 y0, y1;
#pragma unroll
                            for (int j = 0; j < 4; ++j) { y0[j] = __shfl_xor(v0[j], 16); y1[j] = __shfl_xor(v1[j], 16); }
                            if (fq < 2) { const f32x4 c0 = *(const f32x4*)(cosI + s * 8), c1 = *(const f32x4*)(cosI + s * 8 + 4), s0 = *(const f32x4*)(sinI + s * 8), s1 = *(const f32x4*)(sinI + s * 8 + 4);
                                const float sg = fq == 0 ? -1.f : 1.f; v0 = v0 * c0 + sg * (y0 * s0); v1 = v1 * c1 + sg * (y1 * s1); } }
                        f16x8v o; o[0] = (f16_t)v0[0]; o[1] = (f16_t)v0[1]; o[2] = (f16_t)v0[2]; o[3] = (f16_t)v0[3]; o[4] = (f16_t)v1[0]; o[5] = (f16_t)v1[1]; o[6] = (f16_t)v1[2]; o[7] = (f16_t)v1[3];
                        *(f16x8v*)(KI + (size_t)(row >> 5) * 2048 + (wc * 4 + fq) * 256 + (row & 31) * 8) = o; }
            } else if (wc == 2 && fq == 0) {
#pragma unroll
                for (int ai = 0; ai < 2; ++ai)
#pragma unroll
                    for (int m = 0; m < 4; ++m) { const int row = rowb + ai * HALF + m * 16; const float k = 0.35355339059327373f;
                        *(f32x4*)(WI + (size_t)row * 8) = acc[ai][0][m][0] * k; *(f32x4*)(WI + (size_t)row * 8 + 4) = acc[ai][0][m][1] * k; }
            }
        }
    }
};
struct EpiKV {
    static constexpr bool PERM = true;
    bf16_t* KD; bf16_t* VD; const float* SSQ; const float* cosH; const float* sinH;
    __device__ __forceinline__ void operator()(const f32x4 (&acc)[2][2][4][2], const Unit& u, int wr, int wc, int fr, int fq) const {
        const int rowb = u.pm * BM + wr * 64 + fr;
        float rs[8];
        { f32x4 q[8];
#pragma unroll
          for (int it = 0; it < 8; ++it) q[it] = *(const f32x4*)(SSQ + (size_t)(rowb + (it >> 2) * HALF + (it & 3) * 16) * 4);
#pragma unroll
          for (int it = 0; it < 8; ++it) rs[it] = 1.f / sqrtf(((q[it][0] + q[it][1]) + (q[it][2] + q[it][3])) * (1.f / 256.f) + EPS); }
        const int i0 = 8 * (fq & 1);
#define EKV_LD(it_, A0, A1, A2, A3) do { const int s_ = (rowb + ((it_) >> 2) * HALF + ((it_) & 3) * 16) & 4095; \
            A0 = *(const f32x4*)(cosH + s_ * 16 + i0); A1 = *(const f32x4*)(cosH + s_ * 16 + i0 + 4); A2 = *(const f32x4*)(sinH + s_ * 16 + i0); A3 = *(const f32x4*)(sinH + s_ * 16 + i0 + 4); } while (0)
#define EKV_ST(v0_, v1_) do { u32x4 w; w.x = pk2(v0_[0], v0_[1]); w.y = pk2(v0_[2], v0_[3]); w.z = pk2(v1_[0], v1_[1]); w.w = pk2(v1_[2], v1_[3]); \
            *(u32x4*)(KD + (size_t)row * 128 + wc * 32 + 8 * fq) = w; \
            const f32x4 u0 = acc[ai][1][m][0] * rstd, u1 = acc[ai][1][m][1] * rstd; \
            u32x4 x; x.x = pk2(u0[0], u0[1]); x.y = pk2(u0[2], u0[3]); x.z = pk2(u1[0], u1[1]); x.w = pk2(u1[2], u1[3]); \
            *(u32x4*)(VD + (size_t)row * 128 + wc * 32 + 8 * fq) = x; } while (0)
        if (wc == 0) {
            f32x4 n0, n1, n2, n3; EKV_LD(0, n0, n1, n2, n3);
#pragma unroll
            for (int it = 0; it < 8; ++it) { const int ai = it >> 2, m = it & 3; const int row = rowb + ai * HALF + m * 16; const float rstd = rs[it];
                const f32x4 c0 = n0, c1 = n1, s0 = n2, s1 = n3;
                if (it < 7) { EKV_LD(it + 1, n0, n1, n2, n3); __builtin_amdgcn_sched_barrier(0); }
                f32x4 v0 = acc[ai][0][m][0] * rstd, v1 = acc[ai][0][m][1] * rstd; f32x4 y0, y1;
#pragma unroll
                for (int j = 0; j < 4; ++j) { y0[j] = __shfl_xor(v0[j], 32); y1[j] = __shfl_xor(v1[j], 32); }
                const float sg = fq < 2 ? -1.f : 1.f; v0 = v0 * c0 + sg * (y0 * s0); v1 = v1 * c1 + sg * (y1 * s1);
                EKV_ST(v0, v1); }
        } else {
#pragma unroll
            for (int it = 0; it < 8; ++it) { const int ai = it >> 2, m = it & 3; const int row = rowb + ai * HALF + m * 16; const float rstd = rs[it];
                const f32x4 v0 = acc[ai][0][m][0] * rstd, v1 = acc[ai][0][m][1] * rstd;
                EKV_ST(v0, v1); }
        }
#undef EKV_LD
#undef EKV_ST
    }
};
struct EpiF32 {
    static constexpr bool PERM = true;
    float* O; int ldc;
    __device__ __forceinline__ void operator()(const f32x4 (&acc)[2][2][4][2], const Unit& u, int wr, int wc, int fr, int fq) const {
        const int row0 = u.pm * BM + wr * 64 + fr, col0 = u.pn * BM + wc * 32 + 8 * fq;
#pragma unroll
        for (int ai = 0; ai < 2; ++ai)
#pragma unroll
            for (int m = 0; m < 4; ++m) { float* rowp = O + (size_t)(row0 + ai * HALF + m * 16) * ldc + col0;
#pragma unroll
                for (int bj = 0; bj < 2; ++bj) { *(f32x4*)(rowp + bj * HALF) = acc[ai][bj][m][0]; *(f32x4*)(rowp + bj * HALF + 4) = acc[ai][bj][m][1]; } }
    }
};

struct EpiResidNorm {
    static constexpr bool PERM = true;
    const float* X; bf16_t* O; const float* mod; const float* SSQO; LAS float* tab;
    __device__ __forceinline__ void begin(const Unit& u, int wid) const {
        const int tid = wid * 64 + lane_opaque();
        if (tid < BM) { const float* p = SSQO + (size_t)(u.pm * BM + tid) * 8; const f32x4 a = *(const f32x4*)p, b = *(const f32x4*)(p + 4);
            const float rm = 1.f / sqrtf(((a[0] + a[1]) + (a[2] + a[3])) * (1.f / 512.f) + EPS), rd = 1.f / sqrtf(((b[0] + b[1]) + (b[2] + b[3])) * (1.f / 512.f) + EPS);
            *(LAS f32x2*)(tab + (u.slot % 3) * 512 + tid * 2) = (f32x2){rm / rd, rd}; }
    }
    __device__ __forceinline__ void mid(f32x4 (&acc)[2][2][4][2], const Unit& u, int wr, int fr) const {
        const LAS float* t = tab + (u.slot % 3) * 512 + (wr * 64 + fr) * 2;
#pragma unroll
        for (int ai = 0; ai < 2; ++ai)
#pragma unroll
            for (int m = 0; m < 4; ++m) { const float q = t[(ai * HALF + m * 16) * 2];
#pragma unroll
                for (int bj = 0; bj < 2; ++bj) { acc[ai][bj][m][0] = acc[ai][bj][m][0] * q; acc[ai][bj][m][1] = acc[ai][bj][m][1] * q; } }
    }
    __device__ __forceinline__ void operator()(const f32x4 (&acc)[2][2][4][2], const Unit& u, int wr, int wc, int fr, int fq) const {
        const int row0 = u.pm * BM + wr * 64 + fr, col0 = u.pn * BM + wc * 32 + 8 * fq;
        const float* g = mod + (size_t)((u.pm * BM) >> 12) * 6144 + 2048 + col0;
        const LAS float* t = tab + (u.slot % 3) * 512 + (wr * 64 + fr) * 2 + 1;
        f32x4 gg[2][2];
#pragma unroll
        for (int bj = 0; bj < 2; ++bj) { gg[bj][0] = *(const f32x4*)(g + bj * HALF); gg[bj][1] = *(const f32x4*)(g + bj * HALF + 4); }
#pragma unroll
        for (int ai = 0; ai < 2; ++ai)
#pragma unroll
            for (int m = 0; m < 4; ++m) { const float rd = t[(ai * HALF + m * 16) * 2];
                f32x4 xx[2][2];
#pragma unroll
                for (int bj = 0; bj < 2; ++bj) { const size_t o = (size_t)(row0 + ai * HALF + m * 16) * DM + col0 + bj * HALF; xx[bj][0] = *(const f32x4*)(X + o); xx[bj][1] = *(const f32x4*)(X + o + 4); }
#pragma unroll
                for (int bj = 0; bj < 2; ++bj) { const size_t o = (size_t)(row0 + ai * HALF + m * 16) * DM + col0 + bj * HALF;
                    const f32x4 r0 = xx[bj][0] + gg[bj][0] * rd * acc[ai][bj][m][0], r1 = xx[bj][1] + gg[bj][1] * rd * acc[ai][bj][m][1];
                    u32x4 w; w.x = pk2(r0[0], r0[1]); w.y = pk2(r0[2], r0[3]); w.z = pk2(r1[0], r1[1]); w.w = pk2(r1[2], r1[3]);
                    *(u32x4*)(O + o) = w; } }
    }
};
struct MoeTab { const LAS int* cnt; const LAS int* tstart; };
constexpr int UT_MAX = 32;
__device__ __forceinline__ int moe_find(const MoeTab& tb, int rt) {
    int lo = 0, hi = NEX;
    while (hi - lo > 1) { const int mid = (lo + hi) >> 1; if (tb.tstart[mid] <= rt) lo = mid; else hi = mid; }
    return lo;
}
struct MoeUpSched {
    MoeTab tb; const char* H2; const LAS int* tokl; const char* WGU; unsigned ldb; int total, G, c; const LAS int* utab;
    __device__ __forceinline__ bool next(int i, Unit& u) const {
        if (i < UT_MAX) { const u32x4 v = *(const LAS u32x4*)(utab + 4 * i); if ((int)v.x < 0) return false; u.e = (int)v.x; u.rt = (int)v.y; u.pn = (int)v.z & 0xff; u.pm = (int)v.w; u.slot = i | (((int)v.z >> 8) << 16); return true; }
        return compute(i, u);
    }
    __device__ __forceinline__ bool compute(int i, Unit& u) const {
        if (G == 256) { const int xcd = c & 7, k = c >> 3; u.rt = i * 128 + xcd * 16 + (k >> 1); u.pn = k & 1; if (u.rt * 2 >= total) return false; }
        else { const int L = i * G + c; if (L >= total) return false; u.rt = L >> 1; u.pn = L & 1; }
        u.e = moe_find(tb, u.rt); u.pm = u.rt - tb.tstart[u.e]; u.slot = i | (256 << 16); return true;
    }
    __device__ __forceinline__ const char* a_ubase(const Unit&) const { return H2; }
    __device__ __forceinline__ void a_off(const Unit& u, const int (&R)[2], const int (&C)[2], unsigned (&o)[2][2]) const {
#pragma unroll
        for (int h = 0; h < 2; ++h)
#pragma unroll
            for (int i = 0; i < 2; ++i) o[h][i] = (unsigned)(tokl[(u.slot & 0xffff) * BM + h * HALF + R[i]] & 0x7fff) * 4096u + (unsigned)C[i] * 2u;
    }
    __device__ __forceinline__ const char* b_base(const Unit& u) const { return WGU + ((size_t)u.e * 512 + (size_t)u.pn * 256) * 2048; }
};
struct EpiAct {
    static constexpr bool PERM = true;
    bf16_t* ACT; const LAS int* tokl;
    __device__ __forceinline__ void operator()(const f32x4 (&acc)[2][2][4][2], const Unit& u, int wr, int wc, int fr, int fq) const {
        const int row0 = u.rt * BM + wr * 64 + fr, col0 = u.pn * 128 + wc * 32 + 8 * fq;
#pragma unroll
        for (int ai = 0; ai < 2; ++ai)
#pragma unroll
            for (int m = 0; m < 4; ++m) { float a[8];
                const unsigned tw = (unsigned)tokl[(u.slot & 0xffff) * BM + ai * HALF + wr * 64 + m * 16 + fr];
                const float gw = (float)__builtin_bit_cast(f16_t, (unsigned short)(tw >> 16));
#pragma unroll
                for (int n = 0; n < 2; ++n)
#pragma unroll
                    for (int j = 0; j < 4; ++j) { const float gt = acc[ai][0][m][n][j], up = acc[ai][1][m][n][j]; a[n * 4 + j] = gt * __builtin_amdgcn_rcpf(1.f + __expf(-gt)) * up * gw; }
                u32x4 w; w.x = pk2(a[0], a[1]); w.y = pk2(a[2], a[3]); w.z = pk2(a[4], a[5]); w.w = pk2(a[6], a[7]);
                if (ai * HALF + wr * 64 + m * 16 + fr < (u.slot >> 16)) *(u32x4*)(ACT + (size_t)(row0 + ai * HALF + m * 16) * 256 + col0) = w; }
    }
};
struct MoeDownSched {
    MoeTab tb; const char* ACT; const char* WD; unsigned ldb; int total, G, c; const LAS int* utab;
    __device__ __forceinline__ bool next(int i, Unit& u) const {
        if (i < UT_MAX) { const u32x4 v = *(const LAS u32x4*)(utab + 4 * i); if ((int)v.x < 0) return false; u.e = (int)v.x; u.rt = (int)v.y; u.pn = (int)v.z & 0xff; u.pm = (int)v.w; u.slot = i | (((int)v.z >> 8) << 16); return true; }
        return compute(i, u);
    }
    __device__ __forceinline__ bool compute(int i, Unit& u) const {
        if (G == 256) { const int xcd = c & 7, k = c >> 3; u.rt = i * 64 + xcd * 8 + (k >> 2); u.pn = k & 3; if (u.rt * 4 >= total) return false; }
        else { const int L = i * G + c; if (L >= total) return false; u.rt = L >> 2; u.pn = L & 3; }
        u.e = moe_find(tb, u.rt); u.pm = u.rt - tb.tstart[u.e]; u.slot = i | (256 << 16); return true;
    }
    __device__ __forceinline__ const char* a_ubase(const Unit& u) const { return ACT + (size_t)u.rt * BM * 512; }
    __device__ __forceinline__ void a_off(const Unit& u, const int (&R)[2], const int (&C)[2], unsigned (&o)[2][2]) const {
#pragma unroll
        for (int h = 0; h < 2; ++h)
#pragma unroll
            for (int i = 0; i < 2; ++i) o[h][i] = (unsigned)(h * HALF + R[i]) * 512u + (unsigned)C[i] * 2u;
    }
    __device__ __forceinline__ const char* b_base(const Unit& u) const { return WD + ((size_t)u.e * 1024 + (size_t)u.pn * 256) * 512; }
};
struct EpiDown {
    static constexpr bool PERM = true;
    bf16_t* CA; bf16_t* SH;
    __device__ __forceinline__ void operator()(const f32x4 (&acc)[2][2][4][2], const Unit& u, int wr, int wc, int fr, int fq) const {
        const int col0 = u.pn * BM + wc * 32 + 8 * fq;
        {
            const bool shd = u.e == NE; const float fsc = shd ? 4.f : 16.f;
            unsigned char* base = (shd ? (unsigned char*)SH + ((size_t)u.pm * BM + wr * 64 + fr) * DM : (unsigned char*)CA + ((size_t)u.rt * BM + wr * 64 + fr) * DM) + (col0 - 8 * (fq & 1));
#pragma unroll
            for (int ai = 0; ai < 2; ++ai)
#pragma unroll
                for (int mp = 0; mp < 4; mp += 2)
#pragma unroll
                    for (int bj = 0; bj < 2; ++bj) { unsigned wx[2], wy[2];
#pragma unroll
                        for (int q = 0; q < 2; ++q) { f32x4 v0 = acc[ai][bj][mp + q][0] * fsc, v1 = acc[ai][bj][mp + q][1] * fsc;
#pragma unroll
                            for (int j2 = 0; j2 < 4; ++j2) { v0[j2] = __builtin_amdgcn_fmed3f(v0[j2], -448.f, 448.f); v1[j2] = __builtin_amdgcn_fmed3f(v1[j2], -448.f, 448.f); }
                            int t = 0;
                            t = __builtin_amdgcn_cvt_pk_fp8_f32(v0[0], v0[1], t, false); t = __builtin_amdgcn_cvt_pk_fp8_f32(v0[2], v0[3], t, true); wx[q] = (unsigned)t;
                            t = __builtin_amdgcn_cvt_pk_fp8_f32(v1[0], v1[1], t, false); t = __builtin_amdgcn_cvt_pk_fp8_f32(v1[2], v1[3], t, true); wy[q] = (unsigned)t; }
                        const auto sx = __builtin_amdgcn_permlane16_swap(wx[0], wx[1], false, false), sy = __builtin_amdgcn_permlane16_swap(wy[0], wy[1], false, false);
                        u32x4 w; w.x = sx[0]; w.y = sy[0]; w.z = sx[1]; w.w = sy[1];
                        if (ai * HALF + wr * 64 + (mp + (fq & 1)) * 16 + fr < (u.slot >> 16)) *(u32x4*)(base + (size_t)(ai * HALF + (mp + (fq & 1)) * 16) * DM + bj * HALF) = w; }
        }
    }
};
}

__constant__ float c_invH[16] = {1.000000000e+00f, 4.403665960e-01f, 1.939227432e-01f, 8.539710194e-02f, 3.760603070e-02f, 1.656044088e-02f, 7.292664610e-03f, 3.211446106e-03f,
                                 1.414213562e-03f, 6.227724371e-04f, 2.742481884e-04f, 1.207697351e-04f, 5.318295734e-05f, 2.341999971e-05f, 1.031338525e-05f, 4.541670478e-06f};
__constant__ float c_invI[8] = {1.000000000e+00f, 1.939227432e-01f, 3.760603070e-02f, 7.292664610e-03f, 1.414213562e-03f, 2.742481884e-04f, 5.318295734e-05f, 1.031338525e-05f};

struct TrJob { const float* W; int ldn, nvalid; bf16_t* WT; int dld, dcol, rmode, rbase, vmode, k0, n0; const float* kgain; };
template <bool CHECK = true>
__device__ __forceinline__ void tr_load(const TrJob& J, int lane, f32x4 (&v)[8]) {
    const int n4 = (lane & 7) * 4; const bool ok = !CHECK || J.n0 + n4 < J.nvalid;
#pragma unroll
    for (int i = 0; i < 8; ++i) { const int kk = 8 * i + (lane >> 3); v[i] = ok ? *(const f32x4*)(J.W + (size_t)(J.k0 + kk) * J.ldn + J.n0 + n4) : (f32x4){0.f, 0.f, 0.f, 0.f}; }
}
__device__ __forceinline__ void tr_finish(const TrJob& J, int lane, const f32x4 (&v)[8], LAS float* scr) {
    const int n4 = (lane & 7) * 4;
    float kg[8];
    { const float* kp = (J.kgain ? J.kgain + J.k0 : c_invH) + 8 * (lane & 7) * (J.kgain ? 1 : 0);
#pragma unroll
      for (int q = 0; q < 8; ++q) kg[q] = kp[q];
      if (!J.kgain) {
#pragma unroll
          for (int q = 0; q < 8; ++q) kg[q] = 1.f; } }
#pragma unroll
    for (int i = 0; i < 8; ++i) { const int kk = 8 * i + (lane >> 3); LAS float* d = scr + kk * 33 + n4; d[0] = v[i][0]; d[1] = v[i][1]; d[2] = v[i][2]; d[3] = v[i][3]; }
    LDS_WAIT(); asm volatile("" ::: "memory");
    const int c = lane & 7;
#pragma unroll
    for (int j = 0; j < 4; ++j) { const int n = (lane >> 3) + 8 * j; const LAS float* s = scr + (8 * c) * 33 + n;
        float x[8];
#pragma unroll
        for (int q = 0; q < 8; ++q) { x[q] = s[q * 33] * kg[q]; if (J.vmode == 2) x[q] = x[q] - bf2f(f2bf(x[q])); }
        u32x4 o; o.x = pk2(x[0], x[1]); o.y = pk2(x[2], x[3]); o.z = pk2(x[4], x[5]); o.w = pk2(x[6], x[7]);
        const int ng = J.n0 + n; const int drow = J.rmode ? ((ng >> 7) * 256 + (ng & 127) + J.rbase) : (J.rbase + ng);
        *(u32x4*)(J.WT + (size_t)drow * J.dld + J.dcol + J.k0 + 8 * c) = o; }
    LDS_WAIT(); asm volatile("" ::: "memory");
}
__device__ __forceinline__ void tr_item(const float* W, int ldn, int nvalid, bf16_t* WT, int dld, int dcol, int rmode, int rbase, int vmode, int k0, int n0, LAS float* scr, int lane, const float* kgain = nullptr) {
    const TrJob J{W, ldn, nvalid, WT, dld, dcol, rmode, rbase, vmode, k0, n0, kgain}; f32x4 v[8]; tr_load(J, lane, v); tr_finish(J, lane, v, scr);
}

__device__ __forceinline__ void phase0(const Args& A, unsigned char* lds_, const int wave) {
    LAS unsigned char* lds = (LAS unsigned char*)lds_;
    const int lane = lane_opaque(), tid = wave * 64 + lane, G = gridDim.x;
    unsigned char* ws = A.ws;
    {
        LAS float* cact = (LAS float*)lds;
        LAS float* part = cact + 8192;
        const float* c = A.in[1]; const float* w_ada = A.in[2]; const float* b_ada = A.in[3]; float* mod = (float*)(ws + WS_MOD);
        for (int i = tid; i < 8192; i += NTHR) { const float v = c[i]; cact[i] = v / (1.f + expf(-v)); }
        __syncthreads();
        for (int chunk = blockIdx.x; chunk < 256; chunk += G) {
            const int n0 = chunk * 24, j = tid % 24, q = tid / 24;
            float a0 = 0.f, a1 = 0.f, a2 = 0.f, a3 = 0.f, a4 = 0.f, a5 = 0.f, a6 = 0.f, a7 = 0.f;
            if (tid < 504) {
                float wv[49];
#pragma unroll
                for (int i = 0; i < 49; ++i) { const int k = q + 21 * i; wv[i] = k < 1024 ? w_ada[(size_t)k * 6144 + n0 + j] : 0.f; }
#pragma unroll
                for (int i = 0; i < 49; ++i) { const int k = q + 21 * i < 1024 ? q + 21 * i : 1023; const float w = wv[i];
                    a0 += cact[k] * w; a1 += cact[1024 + k] * w; a2 += cact[2048 + k] * w; a3 += cact[3072 + k] * w;
                    a4 += cact[4096 + k] * w; a5 += cact[5120 + k] * w; a6 += cact[6144 + k] * w; a7 += cact[7168 + k] * w; } }
            if (tid < 504) { LAS float* p = part + (q * 8) * 24 + j; p[0] = a0; p[24] = a1; p[48] = a2; p[72] = a3; p[96] = a4; p[120] = a5; p[144] = a6; p[168] = a7; }
            __syncthreads();
            if (tid < 192) { const int b = tid / 24, jj = tid % 24; float s = b_ada[n0 + jj];
                for (int qq = 0; qq < 21; ++qq) s += part[(qq * 8 + b) * 24 + jj];
                mod[b * 6144 + n0 + jj] = s; }
            __syncthreads();
        }
    }
    {
        float* cosH = (float*)(ws + WS_COSH); float* sinH = (float*)(ws + WS_SINH); float* cosI = (float*)(ws + WS_COSI); float* sinI = (float*)(ws + WS_SINI);
        for (int i = blockIdx.x * NTHR + tid; i < SEQ * 24; i += G * NTHR) {
            int pos, f; float inv; bool isH = i < SEQ * 16;
            if (isH) { pos = i >> 4; f = i & 15; inv = c_invH[f]; } else { const int k = i - SEQ * 16; pos = k >> 3; f = k & 7; inv = c_invI[f]; }
            const float ang = (float)pos * inv;
            double t = (double)ang * 0.15915494309189533577; t -= rint(t);
            const float rev = (float)t;
            const float cs = __builtin_amdgcn_cosf(rev), sn = __builtin_amdgcn_sinf(rev);
            if (isH) { cosH[i] = cs; sinH[i] = sn; } else { cosI[i - SEQ * 16] = cs; sinI[i - SEQ * 16] = sn; }
        }
    }
    {
        LAS float* scr = (LAS float*)(lds + 65536 + wave * 8448);
        const int gw = blockIdx.x * NWAVES + wave, NGW = G * NWAVES;
        bf16_t* WIN = (bf16_t*)(ws + WS_WIN); bf16_t* WOUT = (bf16_t*)(ws + WS_WOUT); bf16_t* WR = (bf16_t*)(ws + WS_WR); bf16_t* WKV = (bf16_t*)(ws + WS_WKV);
        constexpr int I_IN = 16 * 96, I_KV = 4 * 8, I_OUT = 16 * 32, I_R = 16 * 8;
        constexpr int NITEMS = I_IN + I_KV + I_OUT + 3 * I_R;
        for (int it = gw; it < NITEMS; it += NGW) {
            int r = it;
            if (r < I_IN) { tr_item(A.in[5], NPROJ, NPROJ, WIN, 1024, 0, 0, 0, 0, 64 * (r / 96), 32 * (r % 96), scr, lane); continue; } r -= I_IN;
            if (r < I_KV) { tr_item(A.in[7], 256, 256, WKV, 256, 0, 0, 0, 0, 64 * (r / 8), 32 * (r % 8), scr, lane, A.in[6]); continue; } r -= I_KV;
            if (r < I_OUT) { const int k0_ = 64 * (r / 32); tr_item(A.in[10], 1024, 1024, WOUT, 1024, 0, 0, 0, 0, k0_, 32 * (r % 32), scr, lane, k0_ < 512 ? A.in[8] : A.in[9] - 512); continue; } r -= I_OUT;
            if (r < I_R) { tr_item(A.in[12], 256, 256, WR, 2048, 0, 0, 0, 1, 64 * (r / 8), 32 * (r % 8), scr, lane); continue; } r -= I_R;
            if (r < I_R) { tr_item(A.in[12], 256, 256, WR, 2048, 1024, 0, 0, 1, 64 * (r / 8), 32 * (r % 8), scr, lane); continue; } r -= I_R;
            tr_item(A.in[12], 256, 256, WR, 2048, 0, 0, 256, 2, 64 * (r / 8), 32 * (r % 8), scr, lane);
        }
        for (int i = blockIdx.x * NTHR + tid; i < 256 * 128; i += G * NTHR) { const int rr = 256 + (i >> 7), cc = 1024 + (i & 127) * 8; *(u32x4*)(WR + (size_t)rr * 2048 + cc) = (u32x4){0u, 0u, 0u, 0u}; }
    }
}


__device__ __forceinline__ void convert_experts(const Args& A, unsigned char* lds_, const int wave) {
    LAS unsigned char* lds = (LAS unsigned char*)lds_;
    const int lane = lane_opaque();
    unsigned char* ws = A.ws;
    LAS float* scr = (LAS float*)(lds + wave * 8448);
    const int gw = blockIdx.x * NWAVES + wave, NGW = gridDim.x * NWAVES;
    bf16_t* WD = (bf16_t*)(ws + WS_WD); bf16_t* WGU = (bf16_t*)(ws + WS_WGU);
    struct XJob { const char* src; char* dst; unsigned ldnB, dldB; };
    auto job = [&](int r) -> XJob {
        const int e = r / 384, q = r % 384; const bool sh_ = (e == NE);
        if (q < 256) { const int q2 = q & 127, k0 = 64 * (q2 >> 3), n0 = 32 * (q2 & 7), up = q >> 7;
            const float* w = up ? (!sh_ ? A.in[15] + (size_t)e * 1024 * 256 : A.in[18]) : (!sh_ ? A.in[14] + (size_t)e * 1024 * 256 : A.in[17]);
            const int drow0 = (n0 >> 7) * 256 + (n0 & 127) + 128 * up;
            return XJob{(const char*)(w + (size_t)k0 * 256 + n0), (char*)(WGU + (size_t)e * 512 * 1024 + (size_t)drow0 * 1024 + k0), 256u * 4u, 1024u * 2u}; }
        const int q3 = q - 256, k0 = 64 * (q3 >> 5), n0 = 32 * (q3 & 31);
        const float* w = !sh_ ? A.in[16] + (size_t)e * 256 * 1024 : A.in[19];
        return XJob{(const char*)(w + (size_t)k0 * 1024 + n0), (char*)(WD + (size_t)e * 1024 * 256 + (size_t)n0 * 256 + k0), 1024u * 4u, 256u * 2u};
    };
    auto xload = [&](const XJob& J, f32x4 (&v)[8]) {
        const unsigned vo = (unsigned)(lane >> 3) * J.ldnB + (unsigned)(lane & 7) * 16u;
#pragma unroll
        for (int i = 0; i < 8; ++i) v[i] = *(const f32x4*)(J.src + (size_t)(8 * i) * J.ldnB + vo);
    };
    auto xfinish = [&](const XJob& J, const f32x4 (&v)[8]) {
        const int n4 = (lane & 7) * 4;
#pragma unroll
        for (int i = 0; i < 8; ++i) { const int kk = 8 * i + (lane >> 3); LAS float* d = scr + kk * 33 + n4; d[0] = v[i][0]; d[1] = v[i][1]; d[2] = v[i][2]; d[3] = v[i][3]; }
        LDS_WAIT(); asm volatile("" ::: "memory");
        const int c = lane & 7; const unsigned vo2 = (unsigned)(lane >> 3) * J.dldB + (unsigned)c * 16u;
#pragma unroll
        for (int jx = 0; jx < 4; ++jx) { const int n = (lane >> 3) + 8 * jx; const LAS float* sp = scr + (8 * c) * 33 + n;
            float x[8];
#pragma unroll
            for (int q = 0; q < 8; ++q) x[q] = sp[q * 33];
            u32x4 o; o.x = pk2(x[0], x[1]); o.y = pk2(x[2], x[3]); o.z = pk2(x[4], x[5]); o.w = pk2(x[6], x[7]);
            *(u32x4*)(J.dst + (size_t)(8 * jx) * J.dldB + vo2) = o; }
        LDS_WAIT(); asm volatile("" ::: "memory");
    };
    constexpr int NIT = 384 * NEX;
    int r = gw;
    if (r >= NIT) return;
    f32x4 va[8], vb[8], vc[8], vd[8];
#define CE_LD(dst, rr) do { const int r_ = (rr) < NIT ? (rr) : last; const XJob J_ = job(r_); xload(J_, dst); __builtin_amdgcn_fence(__ATOMIC_RELEASE, "wavefront"); } while (0)
#define CE_FIN(src, rr) do { if ((rr) < NIT) { const XJob J_ = job(rr); xfinish(J_, src); } } while (0)
    const int last = gw + ((NIT - 1 - gw) / NGW) * NGW;
    CE_LD(va, r); CE_LD(vb, r + NGW); CE_LD(vc, r + 2 * NGW);
    for (; r < NIT; r += 4 * NGW) {
        CE_LD(vd, r + 3 * NGW); CE_FIN(va, r);
        CE_LD(va, r + 4 * NGW); CE_FIN(vb, r + NGW);
        CE_LD(vb, r + 5 * NGW); CE_FIN(vc, r + 2 * NGW);
        CE_LD(vc, r + 6 * NGW); CE_FIN(vd, r + 3 * NGW);
    }
#undef CE_LD
#undef CE_FIN
}

template <bool BF16IN = false>
__device__ __forceinline__ void modnorm_row(const void* xrow_, const float* gain, const float* shift, const float* scale, int lane, f32x4 (&v)[4]) {
    float s = 0.f;
#pragma unroll
    for (int j = 0; j < 4; ++j) {
        if constexpr (BF16IN) { const u32x2 w = *((const u32x2*)xrow_ + lane + 64 * j); v[j] = (f32x4){bflo(w.x), bfhi(w.x), bflo(w.y), bfhi(w.y)}; }
        else v[j] = *((const f32x4*)xrow_ + lane + 64 * j);
        s += (v[j].x * v[j].x + v[j].y * v[j].y) + (v[j].z * v[j].z + v[j].w * v[j].w); }
    const float rstd = 1.f / sqrtf(wave_sum_dpp(s) * (1.f / DM) + EPS);
#pragma unroll
    for (int j = 0; j < 4; ++j) { const f32x4 g = *((const f32x4*)gain + lane + 64 * j), sh = *((const f32x4*)shift + lane + 64 * j), sc = *((const f32x4*)scale + lane + 64 * j);
        v[j] = (v[j] * rstd * g) * (sc + 1.f) + sh; }
}
__device__ __forceinline__ void phase1(const Args& A, const int wave) {
    const int lane = lane_opaque();
    const int gw = blockIdx.x * NWAVES + wave, NGW = gridDim.x * NWAVES;
    const float* x = A.in[0]; const float* mod = (const float*)(A.ws + WS_MOD); bf16_t* H = (bf16_t*)(A.ws + WS_H);
    for (int row = gw; row < T; row += NGW) {
        const float* mb = mod + (size_t)(row >> 12) * 6144; f32x4 v[4];
        modnorm_row(x + (size_t)row * DM, A.in[4], mb, mb + 1024, lane, v);
#pragma unroll
        for (int j = 0; j < 4; ++j) { u32x2 o; o.x = pk2(v[j].x, v[j].y); o.y = pk2(v[j].z, v[j].w); *((u32x2*)(H + (size_t)row * DM) + lane + 64 * j) = o; }
    }
}

__device__ __forceinline__ void kmean_units(const Args& A, unsigned char* lds_, const int wave, int u0, int ustep) {
    const int lane = lane_opaque(), tid = wave * 64 + lane;
    const bf16_t* KM = (const bf16_t*)(A.ws + WS_KM); float* KMEAN = (float*)(A.ws + WS_KMEAN);
    LAS float* part = (LAS float*)lds_;
    for (int u = u0; u < NB * 4 * 16; u += ustep) {
        const int bh = u >> 4, blk = u & 15;
        const bf16_t* base = KM + ((size_t)bh * SEQ + blk * 256 + wave * 32) * 128 + 2 * lane;
        float a0 = 0.f, a1 = 0.f;
        for (int j = 0; j < 32; ++j) { const unsigned w = *(const unsigned*)(base + (size_t)j * 128); a0 += bflo(w); a1 += bfhi(w); }
        part[wave * 128 + 2 * lane] = a0; part[wave * 128 + 2 * lane + 1] = a1;
        __syncthreads();
        if (tid < 128) { float sm = 0.f; for (int p = 0; p < 8; ++p) sm += part[p * 128 + tid]; KMEAN[(size_t)u * 128 + tid] = sm * (1.f / 256.f); }
        __syncthreads();
    }
}

namespace att {
typedef short s16x4 __attribute__((ext_vector_type(4)));
typedef float f32x16 __attribute__((ext_vector_type(16)));
constexpr int D = 128, NW = 8, QBLK = 32, KVBLK = 64;
constexpr int SHM_V = KVBLK * D * 2, SHM_K = KVBLK * D * 2;
constexpr int LDS_ATT = 2 * SHM_V + 2 * SHM_K + NW * 128 * 4;
constexpr float SCALE = 0.08838834764831845f, THR = 8.f;
#define KSWZ(row, colB) ((row) * 256 + ((colB) ^ (((row) & 7) << 4)))
#define SBAR() __builtin_amdgcn_sched_barrier(0)
__device__ __forceinline__ int v_st(int k, int c) { const int kk = (k & ~0xC) | ((k & 4) << 1) | ((k & 8) >> 1); return ((kk >> 3) * 4 + (c >> 5)) * 512 + ((kk & 7) * 32 + (c & 31)) * 2; }
__device__ __forceinline__ int v_rd_base(int lane) { return ((lane & 3) << 3) | (((lane >> 2) & 3) << 6) | (((lane >> 4) & 1) << 5) | (((lane >> 5) & 1) << 8); }
constexpr int v_rd_off(int d0, int ks, int half) { return d0 * 512 + ks * 4096 + half * 2048; }
__device__ __forceinline__ int crow(int r, int hi) { return (r & 3) + 8 * (r >> 2) + 4 * hi; }
__device__ __forceinline__ unsigned cvtpk(float lo, float hi) { unsigned r; asm volatile("v_cvt_pk_bf16_f32 %0, %1, %2" : "=v"(r) : "v"(lo), "v"(hi)); return r; }
__device__ __forceinline__ void mask_tile(f32x16& p0, f32x16& p1, int dq) {
    const float NEG = -__builtin_inff();
#pragma unroll
    for (int r = 0; r < 16; ++r) { const int c = (r & 3) + 8 * (r >> 2); if (dq - c < 0) p0[r] = NEG; if (dq - c - 32 < 0) p1[r] = NEG; }
}
__device__ __forceinline__ void bias_tile(f32x16& p0, f32x16& p1, unsigned long long mw, int hi) {
    const unsigned lo = (unsigned)mw >> (4 * hi), hh = (unsigned)(mw >> 32) >> (4 * hi);
#pragma unroll
    for (int r = 0; r < 16; ++r) { const int c = (r & 3) + 8 * (r >> 2);
        const unsigned x0 = (unsigned)__builtin_amdgcn_sbfe((int)lo, c, 1), x1 = (unsigned)__builtin_amdgcn_sbfe((int)hh, c, 1);
        p0[r] = __builtin_bit_cast(float, ~x0 & 0xFF800000u); p1[r] = __builtin_bit_cast(float, ~x1 & 0xFF800000u); }
}
__device__ __forceinline__ void partialSM(f32x16& p0, f32x16& p1, float& m_reg, float& mn, float& alpha, bool keep) {
    float pmax = p0[0];
#pragma unroll
    for (int r = 1; r < 16; ++r) pmax = fmaxf(pmax, p0[r]);
#pragma unroll
    for (int r = 0; r < 16; ++r) pmax = fmaxf(pmax, p1[r]);
    { auto rr = __builtin_amdgcn_permlane32_swap(__float_as_uint(pmax), __float_as_uint(pmax), false, false);
      pmax = fmaxf(__uint_as_float(rr[0]), __uint_as_float(rr[1])); }
    pmax = keep ? pmax : -__builtin_inff();
    constexpr float C2 = 1.4426950408889634f * SCALE;
    if (__builtin_expect(__all((pmax - m_reg) * SCALE <= THR), 1)) { mn = m_reg; alpha = 1.f; }
    else { mn = fmaxf(m_reg, pmax); alpha = __builtin_amdgcn_exp2f((m_reg - mn) * C2); m_reg = mn; }
    const float mnL = keep ? -mn * C2 : -__builtin_inff();
#pragma unroll
    for (int r = 0; r < 16; ++r) p0[r] = fmaf(p0[r], C2, mnL);
#pragma unroll
    for (int r = 0; r < 16; ++r) p1[r] = fmaf(p1[r], C2, mnL);
#pragma unroll
    for (int r = 0; r < 16; ++r) p0[r] = __builtin_amdgcn_exp2f(p0[r]);
}
__device__ __forceinline__ void finishSM(f32x16& p0, f32x16& p1, float alpha, float& l_reg, bf16x8& pa0, bf16x8& pa1, bf16x8& pa2, bf16x8& pa3) {
#pragma unroll
    for (int r = 0; r < 16; ++r) p1[r] = __builtin_amdgcn_exp2f(p1[r]);
    float ps = 0;
#pragma unroll
    for (int r = 0; r < 16; ++r) ps += p0[r];
#pragma unroll
    for (int r = 0; r < 16; ++r) ps += p1[r];
    { auto rr = __builtin_amdgcn_permlane32_swap(__float_as_uint(ps), __float_as_uint(ps), false, false);
      ps = __uint_as_float(rr[0]) + __uint_as_float(rr[1]); }
    l_reg = l_reg * alpha + ps;
#define PK4(P, B_, OUT) do { unsigned a0 = cvtpk(P[B_+0], P[B_+1]), a1 = cvtpk(P[B_+2], P[B_+3]);                          \
        unsigned b0 = cvtpk(P[B_+4], P[B_+5]), b1 = cvtpk(P[B_+6], P[B_+7]);                                             \
        auto r0 = __builtin_amdgcn_permlane32_swap(a0, b0, false, false); auto r1 = __builtin_amdgcn_permlane32_swap(a1, b1, false, false); \
        u32x4 w = {r0[0], r1[0], r0[1], r1[1]}; OUT = *reinterpret_cast<bf16x8*>(&w); } while (0)
    PK4(p0, 0, pa0); PK4(p0, 8, pa1); PK4(p1, 0, pa2); PK4(p1, 8, pa3);
#undef PK4
}
template <int KB>
__device__ __forceinline__ void qkt(f32x16& p0, f32x16& p1, const char* K_lds, int r32, int hi, const bf16x8* qr) {
    const char* kb[4];
#pragma unroll
    for (int dd = 0; dd < 4; ++dd) kb[dd] = K_lds + KB * SHM_K + KSWZ(r32, (dd * 16 + hi * 8) * 2);
#pragma unroll
    for (int d0 = 0; d0 < 8; ++d0) { const char* a = kb[d0 & 3] + (d0 >> 2) * 128;
        bf16x8 b0 = *reinterpret_cast<const bf16x8*>(a);
        bf16x8 b1 = *reinterpret_cast<const bf16x8*>(a + 32 * 256);
        p0 = __builtin_amdgcn_mfma_f32_32x32x16_bf16(b0, qr[d0], p0, 0, 0, 0);
        p1 = __builtin_amdgcn_mfma_f32_32x32x16_bf16(b1, qr[d0], p1, 0, 0, 0); }
}
template <int VB>
__device__ __forceinline__ void pv_tile(f32x16* o, int vb0, bf16x8 pa0, bf16x8 pa1, bf16x8 pa2, bf16x8 pa3) {
#define TRRD(dst, off) asm volatile("ds_read_b64_tr_b16 %0, %1 offset:%2" : "=&v"(dst) : "v"(vb0), "i"(off) : "memory")
#define PV_D0(d0) do { s16x4 l0, l1, l2, l3, h0, h1, h2, h3; constexpr int b_ = VB * SHM_V + v_rd_off(d0, 0, 0); \
        TRRD(l0, b_); TRRD(h0, b_ + 2048); TRRD(l1, b_ + 4096); TRRD(h1, b_ + 6144); TRRD(l2, b_ + 8192); TRRD(h2, b_ + 10240); TRRD(l3, b_ + 12288); TRRD(h3, b_ + 14336); \
        asm volatile("s_waitcnt lgkmcnt(0)" ::: "memory"); SBAR();   \
        o[d0] = __builtin_amdgcn_mfma_f32_32x32x16_bf16(pa0, (bf16x8){l0[0], l0[1], l0[2], l0[3], h0[0], h0[1], h0[2], h0[3]}, o[d0], 0, 0, 0);   \
        o[d0] = __builtin_amdgcn_mfma_f32_32x32x16_bf16(pa1, (bf16x8){l1[0], l1[1], l1[2], l1[3], h1[0], h1[1], h1[2], h1[3]}, o[d0], 0, 0, 0);   \
        o[d0] = __builtin_amdgcn_mfma_f32_32x32x16_bf16(pa2, (bf16x8){l2[0], l2[1], l2[2], l2[3], h2[0], h2[1], h2[2], h2[3]}, o[d0], 0, 0, 0);   \
        o[d0] = __builtin_amdgcn_mfma_f32_32x32x16_bf16(pa3, (bf16x8){l3[0], l3[1], l3[2], l3[3], h3[0], h3[1], h3[2], h3[3]}, o[d0], 0, 0, 0); } while (0)
    PV_D0(0); PV_D0(1); PV_D0(2); PV_D0(3);
#undef PV_D0
#undef TRRD
}
__device__ __forceinline__ __amdgpu_buffer_rsrc_t mkrsrc(const void* p, int bytes) {
    const unsigned long long a = (unsigned long long)p; const unsigned lo = __builtin_amdgcn_readfirstlane((unsigned)a), hi = __builtin_amdgcn_readfirstlane((unsigned)(a >> 32));
    return __builtin_amdgcn_make_buffer_rsrc((void*)(((unsigned long long)hi << 32) | lo), (short)0, bytes, 0x00020000);
}
#define BLD16(rs, vo, so) __builtin_bit_cast(bf16x8, __builtin_amdgcn_raw_buffer_load_b128((rs), (int)(vo), (int)(so), 0))
struct Blk { const bf16_t* Qw; const bf16_t* K; const bf16_t* V; bf16_t* Ow; float* Sq; int NT, qpos, own_t0; const unsigned long long* mrow; };
struct Seam { bf16x8 qr[8]; bf16x8 st0, st1; };
constexpr int OST = 1024;
#define VMW() asm volatile("s_waitcnt vmcnt(0)" ::: "memory")
#define VMWN(n) asm volatile("s_waitcnt vmcnt(%0)" :: "i"(n) : "memory")
#define SLOAD(rs, k0) do { S.st0 = BLD16(rs, kvoff, (k0) * 256); S.st1 = BLD16(rs, kvoff, (k0) * 256 + 8192); } while (0)
#define SWRITE_K(bf) do { *(bf16x8*)(K_lds + (bf) * SHM_K + kws) = S.st0; *(bf16x8*)(K_lds + (bf) * SHM_K + kws + 32 * 256) = S.st1; } while (0)
#define SWRITE_V(bf) do { *(bf16x8*)(V_lds + (bf) * SHM_V + vst0) = S.st0; *(bf16x8*)(V_lds + (bf) * SHM_V + vst1) = S.st1; } while (0)
__device__ __forceinline__ void att_prime(const Blk& cur, char* lds, Seam& S, int wid) {
    const int lane = lane_opaque(), tid = wid * 64 + lane, r32 = lane & 31, hi = lane >> 5;
    const int sr = tid >> 4, sc = (tid & 15) * 8, kws = KSWZ(sr, sc * 2); char* K_lds = lds + 2 * SHM_V;
    const unsigned kvoff = (unsigned)(sr * 256 + sc * 2), qoff = (unsigned)(r32 * 256 + hi * 16);
    const __amdgpu_buffer_rsrc_t rQ = mkrsrc(cur.Qw, 32 * 256), rK = mkrsrc(cur.K, SEQ * 256), rV = mkrsrc(cur.V, SEQ * 256);
#pragma unroll
    for (int d0 = 0; d0 < 8; ++d0) S.qr[d0] = BLD16(rQ, qoff + d0 * 32, 0);
    SLOAD(rK, 0); VMW(); SWRITE_K(0); SBAR(); SLOAD(rV, 0);
    __syncthreads();
}
template <int MODE>
__device__ __forceinline__ void att_block(const Blk& cur, const Blk& nxt, char* lds, Seam& S, int wid) {
    const int lane = lane_opaque(), tid = wid * 64 + lane, r32 = lane & 31, hi = lane >> 5;
    const int NT = cur.NT;
    const int qlo = cur.qpos, qm = qlo + r32 - 4 * hi;
    char* V_lds = lds; char* K_lds = lds + 2 * SHM_V;
    float* ws = (float*)(lds + 2 * SHM_V + 2 * SHM_K) + wid * 128; float* li_l = ws, * al_l = ws + 32; const unsigned* sel_l = (const unsigned*)(ws + 64);
    float m_reg = -1e30f, l_reg = 0; f32x16 o[4] = {};
    const int sr = tid >> 4, sc = (tid & 15) * 8, vst0 = v_st(sr, sc), vst1 = v_st(32 + sr, sc), kws = KSWZ(sr, sc * 2);
    const int vb0 = (int)(uintptr_t)V_lds + v_rd_base(lane);
    const unsigned kvoff = (unsigned)(sr * 256 + sc * 2), qoff = (unsigned)(r32 * 256 + hi * 16);
    const __amdgpu_buffer_rsrc_t Kh = mkrsrc(cur.K, SEQ * 256), Vh = mkrsrc(cur.V, SEQ * 256);
    const __amdgpu_buffer_rsrc_t rM = mkrsrc(MODE == 1 ? (const void*)cur.mrow : (const void*)cur.K, 64 * 512);
#define MLD(t) __builtin_bit_cast(unsigned long long, __builtin_amdgcn_raw_buffer_load_b64(rM, (int)((32 * (wid >> 2) + r32) * 8), (int)((t) * 512), 0))
#define RESC(a) do { if (__any((a) < 1.f)) { if (hi == 0) al_l[r32] = (a); asm volatile("s_waitcnt lgkmcnt(0)" ::: "memory");              \
                     for (int d_ = 0; d_ < 4; ++d_) for (int r = 0; r < 16; ++r) o[d_][r] *= al_l[crow(r, hi)]; } } while (0)
#define KBASE(t) ((t) * KVBLK)
#define MASKT(P0_, P1_, t) do { if (MODE == 0) { const int kb_ = KBASE(t); if ((t) >= cur.own_t0 && kb_ + KVBLK - 1 > qlo) mask_tile(P0_, P1_, qm - kb_); } } while (0)
#define KEEP(t) ((MODE == 0) ? (((t) >= cur.own_t0) || ((sel_l[r32] >> ((t) >> 2)) & 1u)) : true)
#define PINIT(P0_, P1_, t) do { if (MODE == 1) { bias_tile(P0_, P1_, mwq, hi); mwq = MLD(((t) + 1 < NT) ? (t) + 1 : (t)); } else { P0_ = f32x16{}; P1_ = f32x16{}; } } while (0)
#define SEAM_K0() do { VMWN(8); SWRITE_K(0); SBAR(); { const __amdgpu_buffer_rsrc_t rVn = mkrsrc(nxt.V, SEQ * 256); SLOAD(rVn, 0); } SBAR(); } while (0)
    f32x16 pA0, pA1, pB0, pB1; float mnA, mnB, alA, alB; bf16x8 pa0, pa1, pa2, pa3;
    unsigned long long mwq = 0ull; if (MODE == 1) mwq = MLD(0);
    VMW(); SWRITE_V(0); SBAR();
    if (NT > 1) SLOAD(Kh, KBASE(1));
    PINIT(pA0, pA1, 0);
    SBAR(); qkt<0>(pA0, pA1, K_lds, r32, hi, S.qr);
    if (NT > 1) { VMW(); SWRITE_K(1); SBAR(); SLOAD(Vh, KBASE(1)); }
    MASKT(pA0, pA1, 0); partialSM(pA0, pA1, m_reg, mnA, alA, KEEP(0));
    if (NT > 1) { VMW(); SWRITE_V(1); SBAR(); if (NT > 2) SLOAD(Kh, KBASE(2)); }
    __syncthreads();
#define HALF_STEP(PX0, PX1, mnX, alX, PY0, PY1, alY, t, KB, VB, SB) do {                                                      \
        PINIT(PX0, PX1, t);                                                                                                   \
        SBAR(); qkt<KB>(PX0, PX1, K_lds, r32, hi, S.qr);                                                                      \
        finishSM(PY0, PY1, alY, l_reg, pa0, pa1, pa2, pa3); SBAR();                                                           \
        if ((t) + 1 < NT) { VMW(); SWRITE_K(SB); SBAR(); SLOAD(Vh, KBASE((t) + 1)); SBAR(); }                                 \
        pv_tile<VB>(o, vb0, pa0, pa1, pa2, pa3); MASKT(PX0, PX1, (t)); partialSM(PX0, PX1, m_reg, mnX, alX, KEEP(t));        \
        __syncthreads();                                                                                                      \
        if ((t) + 1 < NT) { VMW(); SWRITE_V(SB); SBAR(); if ((t) + 2 < NT) SLOAD(Kh, KBASE((t) + 2)); }                       \
        RESC(alX); __syncthreads(); } while (0)
    for (int t = 1; t + 1 < NT; t += 2) {
        HALF_STEP(pB0, pB1, mnB, alB, pA0, pA1, alA, t, 1, 0, 0);
        HALF_STEP(pA0, pA1, mnA, alA, pB0, pB1, alB, t + 1, 0, 1, 1);
    }
    const bool even = (NT & 1) == 0;
    if (even) { PINIT(pB0, pB1, NT - 1); SBAR(); qkt<1>(pB0, pB1, K_lds, r32, hi, S.qr); SBAR(); }
    { const __amdgpu_buffer_rsrc_t rKn = mkrsrc(nxt.K, SEQ * 256); SLOAD(rKn, 0); } SBAR();
    { const __amdgpu_buffer_rsrc_t rQn = mkrsrc(nxt.Qw, 32 * 256);
#pragma unroll
      for (int d0 = 0; d0 < 8; ++d0) S.qr[d0] = BLD16(rQn, qoff + d0 * 32, 0); }
    SBAR();
    finishSM(pA0, pA1, alA, l_reg, pa0, pa1, pa2, pa3); SBAR();
    pv_tile<0>(o, vb0, pa0, pa1, pa2, pa3);
    if (even) { MASKT(pB0, pB1, NT - 1); partialSM(pB0, pB1, m_reg, mnB, alB, KEEP(NT - 1)); __syncthreads(); RESC(alB);
        finishSM(pB0, pB1, alB, l_reg, pa0, pa1, pa2, pa3); SBAR(); pv_tile<1>(o, vb0, pa0, pa1, pa2, pa3); }
    SBAR(); SEAM_K0();
    if (hi == 0) li_l[r32] = l_reg; asm volatile("s_waitcnt lgkmcnt(0)" ::: "memory");
    float rli[16];
#pragma unroll
    for (int r = 0; r < 16; ++r) rli[r] = __builtin_amdgcn_rcpf(li_l[crow(r, hi)]);
    bf16_t* Ow = cur.Ow;
#pragma unroll
    for (int r = 0; r < 16; ++r) { const int orow = crow(r, hi); float ss = 0.f;
#pragma unroll
        for (int d0 = 0; d0 < 4; ++d0) { const float v = o[d0][r] * rli[r]; ss += v * v;
            const float vn = __shfl_xor(v, 1);
            if ((r32 & 1) == 0) *(unsigned*)(Ow + (size_t)orow * OST + d0 * 32 + r32) = cvtpk(v, vn); }
        ss += __shfl_xor(ss, 1); ss += __shfl_xor(ss, 2); ss += __shfl_xor(ss, 4); ss += __shfl_xor(ss, 8); ss += __shfl_xor(ss, 16);
        if (r32 == 0) cur.Sq[(size_t)orow * 8] = ss; }
    __syncthreads();
#undef RESC
#undef KBASE
#undef MASKT
#undef KEEP
#undef PINIT
#undef SEAM_K0
#undef HALF_STEP
#undef MLD
}
__device__ __forceinline__ void moba_gate(const Seam& S, const float* km  , int own, char* lds, int wid) {
    const int lane = lane_opaque(), r32 = lane & 31, hi = lane >> 5;
    unsigned* sel_l = (unsigned*)((float*)(lds + 2 * SHM_V + 2 * SHM_K) + wid * 128 + 64);
    float* kl = (float*)(lds + 73728 + wid * 8192);
    { f32x4 t[8];
#pragma unroll
      for (int i = 0; i < 8; ++i) t[i] = *((const f32x4*)km + lane + 64 * i);
#pragma unroll
      for (int i = 0; i < 8; ++i) *((f32x4*)kl + lane + 64 * i) = t[i]; }
    float g[15];
#pragma unroll
    for (int n = 0; n < 15; ++n) { g[n] = -__builtin_inff();
        if (n < own) { float a = 0.f;
#pragma unroll
            for (int d0 = 0; d0 < 8; ++d0) { const float* kp = kl + n * 128 + d0 * 16 + hi * 8; const f32x4 k0 = *(const f32x4*)kp, k1 = *(const f32x4*)(kp + 4); const bf16x8 q = S.qr[d0];
                a += bf2f((unsigned short)q[0]) * k0[0] + bf2f((unsigned short)q[1]) * k0[1] + bf2f((unsigned short)q[2]) * k0[2] + bf2f((unsigned short)q[3]) * k0[3]
                   + bf2f((unsigned short)q[4]) * k1[0] + bf2f((unsigned short)q[5]) * k1[1] + bf2f((unsigned short)q[6]) * k1[2] + bf2f((unsigned short)q[7]) * k1[3]; }
            g[n] = a + __shfl_xor(a, 32); } }
    unsigned sel = 0u;
#pragma unroll
    for (int r = 0; r < 3; ++r) { int best = -1; float bv = -__builtin_inff();
#pragma unroll
        for (int n = 0; n < 15; ++n) if (n < own && !((sel >> n) & 1u) && g[n] > bv) { bv = g[n]; best = n; }
        if (best >= 0) sel |= 1u << best; }
    if (hi == 0) sel_l[r32] = sel;
    asm volatile("s_waitcnt lgkmcnt(0)" ::: "memory");
}

#undef ROW
#undef VMW
#undef VMWN
#undef SLOAD
#undef SWRITE_K
#undef SWRITE_V
}

namespace idx {
typedef _Float16 f16x8 __attribute__((ext_vector_type(8)));
typedef float f32x16 __attribute__((ext_vector_type(16)));
constexpr int HIST_OFF = 0, MASKL_OFF = 131072, META_OFF = 139264, CAP = 1024;
__device__ __forceinline__ unsigned fkey(float v) { const unsigned u = __builtin_bit_cast(unsigned, v); return u ^ ((unsigned)((int)u >> 31) | 0x80000000u); }
template <int CTRL> __device__ __forceinline__ int dpp_i0(int v) { return __builtin_amdgcn_update_dpp(0, v, CTRL, 0xF, 0xF, true); }
__device__ __forceinline__ int suffix_sum64(int v, int lane) {
    int s = v;
    s += dpp_i0<0x101>(s); s += dpp_i0<0x102>(s); s += dpp_i0<0x104>(s); s += dpp_i0<0x108>(s);
    const int t1 = __builtin_amdgcn_readlane(s, 16), t2 = __builtin_amdgcn_readlane(s, 32), t3 = __builtin_amdgcn_readlane(s, 48);
    const int r = lane >> 4;
    return s + (r == 0 ? t1 + t2 + t3 : r == 1 ? t2 + t3 : r == 2 ? t3 : 0);
}
__device__ __forceinline__ int kbin(unsigned key) {
    const unsigned nt = ~(unsigned)((int)key >> 31);
    const unsigned mag = (key ^ nt) & 0x7fffffffu;
    int e6 = (int)(mag >> 17) - 107 * 64; e6 = e6 < 0 ? 0 : e6; e6 = e6 > 2047 ? 2047 : e6;
    return 2048 + (int)((unsigned)e6 ^ nt);
}
__device__ __forceinline__ float fadd1(float a, float b) { float r; asm("v_add_f32_e32 %0, %1, %2" : "=v"(r) : "v"(a), "v"(b)); return r; }
#define IDX_LATOM_ADD(p, v) __hip_atomic_fetch_add((LAS unsigned*)(p), (v), __ATOMIC_RELAXED, __HIP_MEMORY_SCOPE_WORKGROUP)
#define IDX_LATOM_OR(p, v) __hip_atomic_fetch_or((LAS unsigned*)(p), (v), __ATOMIC_RELAXED, __HIP_MEMORY_SCOPE_WORKGROUP)
template <bool CHECK>
__device__ __forceinline__ void tile1(const f16x8 (&b)[4], const int t, const f16x8 (&a)[2][4], const float (&sg)[2][16], int q0, int qh, int lane, LAS unsigned* hist, unsigned* ks) {
    const int c = lane & 31, hi = lane >> 5;
    f32x16 acc[2] = {};
#pragma unroll
    for (int kk = 0; kk < 4; ++kk) { acc[0] = __builtin_amdgcn_mfma_f32_32x32x16_f16(a[0][kk], b[kk], acc[0], 0, 0, 0); acc[1] = __builtin_amdgcn_mfma_f32_32x32x16_f16(a[1][kk], b[kk], acc[1], 0, 0, 0); }
    const int s = t * 32 + c;
#pragma unroll
    for (int m = 0; m < 2; ++m)
#pragma unroll
        for (int k = 0; k < 2; ++k) { const int ql = 8 * qh + 4 * m + 2 * hi + k;
            float e_[8];
#pragma unroll
            for (int r = 0; r < 8; ++r) e_[r] = __builtin_amdgcn_fmed3f(acc[m][8 * k + r], 0.f, sg[m][8 * k + r]);
            const float v = fadd1(fadd1(fadd1(e_[0], e_[1]), fadd1(e_[2], e_[3])), fadd1(fadd1(e_[4], e_[5]), fadd1(e_[6], e_[7])));
            const unsigned key = fkey(v);
            ks[(2 * m + k) * 64] = key;
            const int bin = kbin(key);
            IDX_LATOM_ADD(hist + ql * 2048 + (bin >> 1), (!CHECK || s <= q0 + ql) ? (1u << (16 * (bin & 1))) : 0u); }
}
__device__ __forceinline__ void pass1(const f16_t* KIb  , const f16x8 (&a)[2][4], const float (&sg)[2][16], int q0, int qh, int kp, int lane, LAS unsigned char* lds, unsigned* ks  ) {
    LAS unsigned* hist = (LAS unsigned*)(lds + HIST_OFF);
    const int tmax = (q0 + 15) >> 5;
    if (kp > tmax) return;
    int tl = kp + ((tmax - kp) & ~3);
    const bool own = tl == tmax;
    const f16_t* kr = KIb + lane * 8;
    f16x8 b0[4], b1[4], b2[4], b3[4];
#define IDX_LD(dst, t_) do { const int tt_ = (t_) < tmax ? (t_) : tmax; const f16_t* p_ = kr + (size_t)tt_ * 2048; _Pragma("unroll") for (int kk = 0; kk < 4; ++kk) dst[kk] = *(const f16x8*)(p_ + kk * 512); __builtin_amdgcn_fence(__ATOMIC_RELEASE, "wavefront"); } while (0)
#define IDX_TILE(bb, tt) do { tile1<false>(bb, tt, a, sg, q0, qh, lane, hist, ks); ks += 256; } while (0)
    int t = kp;
    if (own) IDX_LD(b3, tmax);
    IDX_LD(b0, t); IDX_LD(b1, t + 4); IDX_LD(b2, t + 8);
    if (own) { tile1<true>(b3, tmax, a, sg, q0, qh, lane, hist, ks + ((tmax - kp) >> 2) * 256); tl -= 4; }
    for (; t + 12 <= tl; t += 16) {
        IDX_LD(b3, t + 12); IDX_TILE(b0, t);
        IDX_LD(b0, t + 16); IDX_TILE(b1, t + 4);
        IDX_LD(b1, t + 20); IDX_TILE(b2, t + 8);
        IDX_LD(b2, t + 24); IDX_TILE(b3, t + 12);
    }
    if (t <= tl) { IDX_TILE(b0, t); if (t + 4 <= tl) { IDX_TILE(b1, t + 4); if (t + 8 <= tl) IDX_TILE(b2, t + 8); } }
#undef IDX_LD
#undef IDX_TILE
}
__device__ __forceinline__ void pass2(int q0, int qh, int kp, int lane, LAS unsigned char* lds, const unsigned* ks) {
    const int c = lane & 31, hi = lane >> 5;
    LAS unsigned* hist = (LAS unsigned*)(lds + HIST_OFF); LAS unsigned* maskl = (LAS unsigned*)(lds + MASKL_OFF); LAS int* meta = (LAS int*)(lds + META_OFF);
    const int tmax = (q0 + 15) >> 5;
    if (kp > tmax) return;
    const int n = ((tmax - kp) >> 2) + 1;
    int thr[4];
#pragma unroll
    for (int j = 0; j < 4; ++j) thr[j] = meta[(8 * qh + 4 * (j >> 1) + 2 * hi + (j & 1)) * 4];
    unsigned ka[16], kb[16];
#define IDX_LDG(dst, g_) do { _Pragma("unroll") for (int u = 0; u < 4; ++u) { const int i_ = 4 * (g_) + u < n ? n - 1 - (4 * (g_) + u) : 0; _Pragma("unroll") for (int j = 0; j < 4; ++j) dst[4 * u + j] = ks[i_ * 256 + j * 64]; } \
        __builtin_amdgcn_fence(__ATOMIC_RELEASE, "wavefront"); } while (0)
#define IDX_PRG(src, g_) do { _Pragma("unroll") for (int u = 0; u < 4; ++u) { const int io_ = 4 * (g_) + u; if (io_ < n) { const int i_ = n - 1 - io_, t = kp + 4 * i_, s = t * 32 + c; \
        _Pragma("unroll") for (int m = 0; m < 2; ++m) { unsigned long long bal[2]; \
            _Pragma("unroll") for (int k = 0; k < 2; ++k) { const int ql = 8 * qh + 4 * m + 2 * hi + k; const unsigned key = src[4 * u + 2 * m + k]; const int bin = kbin(key); const bool valid = s <= q0 + ql; \
                bal[k] = __ballot(valid && bin > thr[2 * m + k]); \
                if (valid && bin == thr[2 * m + k]) { const unsigned p = IDX_LATOM_ADD((LAS unsigned*)(meta + ql * 4 + 2), 1u); \
                    if (p < (unsigned)CAP) { LAS unsigned* e = hist + ql * 2048 + 2 * p; e[0] = key; e[1] = (unsigned)s; } } } \
            if (lane == 0) { const int qb = 8 * qh + 4 * m; \
                maskl[(qb + 0) * 128 + t] = (unsigned)bal[0]; maskl[(qb + 2) * 128 + t] = (unsigned)(bal[0] >> 32); \
                maskl[(qb + 1) * 128 + t] = (unsigned)bal[1]; maskl[(qb + 3) * 128 + t] = (unsigned)(bal[1] >> 32); } } } } } while (0)
    const int ng = (n + 3) >> 2;
    IDX_LDG(ka, 0);
    for (int g = 0; g < ng; g += 2) {
        IDX_LDG(kb, g + 1); IDX_PRG(ka, g);
        IDX_LDG(ka, g + 2); IDX_PRG(kb, g + 1);
    }
#undef IDX_LDG
#undef IDX_PRG
}
struct Ops { f16x8 q[2][4]; float w[2]; f32x4 s[2][2][2]; };
__device__ __forceinline__ void load_raw(int b, int q0, const f16_t* QI, const float* WI, int wid, Ops& o) {
    const int lane = lane_opaque(), c = lane & 31, hi = lane >> 5, qh = wid & 1;
#pragma unroll
    for (int m = 0; m < 2; ++m) { const int qq = 2 * ((c >> 2) & 1) + (c >> 4), hd = 4 * ((c >> 3) & 1) + (c & 3);
        const size_t row = (size_t)b * SEQ + q0 + 8 * qh + 4 * m + qq;
        const f16_t* qr = QI + row * 512 + hd * 64 + hi * 8; o.w[m] = WI[row * 8 + hd];
#pragma unroll
        for (int kk = 0; kk < 4; ++kk) o.q[m][kk] = *(const f16x8*)(qr + kk * 16);
#pragma unroll
        for (int k = 0; k < 2; ++k) { const float* wp = WI + ((size_t)b * SEQ + q0 + 8 * qh + 4 * m + 2 * hi + k) * 8; o.s[m][k][0] = *(const f32x4*)wp; o.s[m][k][1] = *(const f32x4*)(wp + 4); } }
}
__device__ __forceinline__ void unit(int b, int q0, bool has_next, const f16_t* QI, const f16_t* KI, const float* WI, unsigned long long* MASK, unsigned* KS  , unsigned char* lds_, int wid, Ops& ops) {
    LAS unsigned char* lds = (LAS unsigned char*)lds_;
    const int lane = lane_opaque(), tid = wid * 64 + lane, c = lane & 31, hi = lane >> 5, qh = wid & 1, kp = wid >> 1;
    LAS unsigned* hist = (LAS unsigned*)(lds + HIST_OFF); LAS unsigned* maskl = (LAS unsigned*)(lds + MASKL_OFF); LAS int* meta = (LAS int*)(lds + META_OFF);
    for (int i = tid; i < 8192 + 512; i += NTHR) ((LAS u32x4*)hist)[i] = (u32x4){0u, 0u, 0u, 0u};
    if (tid < 64) meta[tid] = 0;
    f16x8 a[2][4]; float sg[2][16];
#pragma unroll
    for (int m = 0; m < 2; ++m) { const f16_t w = (f16_t)ops.w[m];
#pragma unroll
        for (int kk = 0; kk < 4; ++kk) a[m][kk] = ops.q[m][kk] * w;
#pragma unroll
        for (int r = 0; r < 16; ++r) { const float w2 = ops.s[m][r >> 3][(r >> 2) & 1][r & 3];
            sg[m][r] = (float)(f16_t)w2 < 0.f ? -__builtin_inff() : __builtin_inff(); } }
    const f16_t* KIb = KI + (size_t)b * SEQ * 64;
    __syncthreads();
    unsigned* ks = KS + (size_t)wid * 8192 + lane;
    pass1(KIb, a, sg, q0, qh, kp, lane, lds, ks);
    load_raw(b, has_next ? q0 + 16 : q0, QI, WI, wid, ops);
    __syncthreads();
#pragma unroll
    for (int k = 0; k < 2; ++k) { const int qi = 2 * wid + k, N = q0 + qi + 1;
        if (N > 256) {
            const LAS u32x4* h4 = (const LAS u32x4*)(hist + qi * 2048 + lane * 32);
            u32x4 hv[8];
#pragma unroll
            for (int i = 0; i < 8; ++i) hv[i] = h4[(i + lane) & 7];
            int tot = 0;
#pragma unroll
            for (int i = 0; i < 8; ++i)
#pragma unroll
                for (int d = 0; d < 4; ++d) { const unsigned w = hv[i][d]; tot += (int)(w & 0xffffu) + (int)(w >> 16); }
            const int suf = suffix_sum64(tot, lane);
            const unsigned long long ge = __ballot(suf >= 256);
            const int L = 63 - __clzll((long long)ge);
            const int above = __builtin_amdgcn_readlane(suf - tot, L);
            const unsigned w = hist[qi * 2048 + L * 32 + (lane >> 1)]; const int cnt = (lane & 1) ? (int)(w >> 16) : (int)(w & 0xffffu);
            const int sb = suffix_sum64(cnt, lane);
            const unsigned long long g2 = __ballot(above + sb >= 256);
            const int Bn = 63 - __clzll((long long)g2);
            if (lane == Bn) { meta[qi * 4] = L * 64 + Bn; meta[qi * 4 + 1] = 256 - (above + sb - cnt); }
        } else if (lane == 0) { meta[qi * 4] = -1; meta[qi * 4 + 1] = 0; }
    }
    __syncthreads();
    VM_WAIT();
    pass2(q0, qh, kp, lane, lds, ks);
    __syncthreads();
#pragma unroll
    for (int k = 0; k < 2; ++k) { const int qi = 2 * wid + k; const int need = __builtin_amdgcn_readfirstlane(meta[qi * 4 + 1]); int n = __builtin_amdgcn_readfirstlane(meta[qi * 4 + 2]); n = n < CAP ? n : CAP;
        const LAS unsigned* cl = hist + qi * 2048;
        if (n <= 64) {
            unsigned lo = 0u, hi2 = 0u;
            if (lane < n) { const u32x2 w = *(const LAS u32x2*)(cl + 2 * lane); lo = (w.x << 12) | (4095u - w.y); hi2 = w.x >> 20; }
            const unsigned long long mine = ((unsigned long long)hi2 << 32) | lo; int rank = 0;
            for (int j = 0; j < n; ++j) { const unsigned long long cj = ((unsigned long long)(unsigned)__builtin_amdgcn_readlane((int)hi2, j) << 32) | (unsigned)__builtin_amdgcn_readlane((int)lo, j); rank += cj > mine ? 1 : 0; }
            if (lane < n && rank < need) { const unsigned si = 4095u - (lo & 0xfffu); IDX_LATOM_OR(maskl + qi * 128 + (si >> 5), 1u << (si & 31)); }
        } else if (n <= 256) {
            unsigned long long cv[4];
#pragma unroll
            for (int e = 0; e < 4; ++e) { const int i = lane + 64 * e; cv[e] = 0ull;
                if (i < n) { const u32x2 w = *(const LAS u32x2*)(cl + 2 * i); cv[e] = ((unsigned long long)w.x << 12) | (unsigned long long)(4095u - w.y); } }
            unsigned long long Tv = 0ull;
            if (n > 0) for (int b = 43; b >= 0; --b) { const unsigned long long t = Tv | (1ull << b); int cnt = 0;
#pragma unroll
                for (int e = 0; e < 4; ++e) cnt += __popcll(__ballot(cv[e] >= t));
                if (cnt >= need) Tv = t; }
#pragma unroll
            for (int e = 0; e < 4; ++e) { const int i = lane + 64 * e; if (i < n && cv[e] >= Tv) { const unsigned si = 4095u - (unsigned)(cv[e] & 0xfffull); IDX_LATOM_OR(maskl + qi * 128 + (si >> 5), 1u << (si & 31)); } }
        } else {
            for (int i0 = 0; i0 < n; i0 += 64) { const int i = i0 + lane; const bool act = i < n; const unsigned ki = act ? cl[2 * i] : 0u, si = act ? cl[2 * i + 1] : 0u; int rank = 0;
                for (int j = 0; j < n; j += 2) { const u32x4 e = *(const LAS u32x4*)(cl + 2 * j);
                    rank += (e.x > ki || (e.x == ki && e.y < si)) ? 1 : 0; if (j + 1 < n) rank += (e.z > ki || (e.z == ki && e.w < si)) ? 1 : 0; }
                if (act && rank < need) IDX_LATOM_OR(maskl + qi * 128 + (si >> 5), 1u << (si & 31)); }
        }
    }
    __syncthreads();
    { const int qi = tid >> 5, w4 = tid & 31;
      const u32x4 v = *(const LAS u32x4*)(maskl + qi * 128 + w4 * 4);
      unsigned long long* tb_ = MASK + ((size_t)b * SEQ + (q0 & ~63)) * 64 + (q0 & 63) + qi;
      *(u32x2*)(tb_ + (size_t)(2 * w4) * 64) = (u32x2){v.x, v.y}; *(u32x2*)(tb_ + (size_t)(2 * w4 + 1) * 64) = (u32x2){v.z, v.w}; }
    __syncthreads();
}
#undef IDX_LATOM_ADD
#undef IDX_LATOM_OR
}


__device__ __forceinline__ void phase6(const Args& A, unsigned char* lds_, const int wave) {
    char* lds = (char*)lds_;
    att::Seam S;
#define P6_WS() unsigned char* ws = A.ws; asm volatile("" : "+s"(ws))
    for (int v = blockIdx.x; v < 256; v += gridDim.x) {
        {
            P6_WS();
            const bf16_t* QM = (const bf16_t*)(ws + WS_QM); const bf16_t* KM = (const bf16_t*)(ws + WS_KM); const bf16_t* VM = (const bf16_t*)(ws + WS_VM);
            bf16_t* OO = (bf16_t*)(ws + WS_H); float* SSQO = (float*)(ws + WS_OM); const float* KMEAN = (const float*)(ws + WS_KMEAN);
            const int bh = (v & 7) * 4 + (v >> 6), j = (v >> 3) & 7;
            for (int ps = 0; ps < 2; ++ps) { const int qb = ps ? 15 - j : j; const int qpos = qb * 256 + 32 * wave;
                if ((v & 3) == ps) { __syncthreads(); convert_experts(A, lds_, wave); __syncthreads(); }
                att::Blk cur; cur.Qw = QM + ((size_t)bh * SEQ + qpos) * 128; cur.K = KM + (size_t)bh * SEQ * 128; cur.V = VM + (size_t)bh * SEQ * 128;
                cur.Ow = OO + ((size_t)(bh >> 2) * SEQ + qpos) * 1024 + (bh & 3) * 128; cur.Sq = SSQO + ((size_t)(bh >> 2) * SEQ + qpos) * 8 + (bh & 3); cur.NT = 4 * (qb + 1); cur.qpos = qpos; cur.own_t0 = 4 * qb; cur.mrow = nullptr;
                att::att_prime(cur, lds, S, wave);
                att::moba_gate(S, KMEAN + (size_t)bh * 16 * 128, qb, lds, wave);
                att::att_block<0>(cur, cur, lds, S, wave); }
        }
        {
            P6_WS();
            const bf16_t* QD = (const bf16_t*)(ws + WS_QD); const bf16_t* KD = (const bf16_t*)(ws + WS_KD); const bf16_t* VD = (const bf16_t*)(ws + WS_VD);
            bf16_t* OO = (bf16_t*)(ws + WS_H); float* SSQO = (float*)(ws + WS_OM);
            const f16_t* QI = (const f16_t*)(ws + WS_QI); const f16_t* KI = (const f16_t*)(ws + WS_KI); const float* WI = (const float*)(ws + WS_WI);
            unsigned long long* MASK = (unsigned long long*)(ws + WS_MASK);
            const int b = 2 * (v & 3) + ((v >> 3) & 1), j = (v >> 4) + 16 * ((v >> 2) & 1);
            for (int ps = 0; ps < 2; ++ps) { const int qt = ps ? 63 - j : j;
                if ((v & 3) == 2 + ps) { __syncthreads(); convert_experts(A, lds_, wave); __syncthreads(); }
                { idx::Ops ops; idx::load_raw(b, 64 * qt, QI, WI, wave, ops);
                  for (int i = 0; i < 4; ++i) idx::unit(b, 64 * qt + 16 * i, i < 3, QI, KI, WI, MASK, (unsigned*)(ws + WS_KS) + (size_t)blockIdx.x * 65536, lds_, wave, ops); }
                VM_WAIT(); __syncthreads();
                const int qpos = 64 * qt + 32 * (wave >> 2), hd = wave & 3;
                att::Blk cur; cur.Qw = QD + ((size_t)(b * 4 + hd) * SEQ + qpos) * 128; cur.K = KD + (size_t)b * SEQ * 128; cur.V = VD + (size_t)b * SEQ * 128;
                cur.Ow = OO + ((size_t)b * SEQ + qpos) * 1024 + 512 + hd * 128; cur.Sq = SSQO + ((size_t)b * SEQ + qpos) * 8 + 4 + hd; cur.NT = qt + 1; cur.qpos = qpos; cur.own_t0 = 0; cur.mrow = MASK + ((size_t)b * SEQ + 64 * qt) * 64;
                att::att_prime(cur, lds, S, wave);
                att::att_block<1>(cur, cur, lds, S, wave); }
        }
    }
#undef P6_WS
}

__device__ __forceinline__ void phase9(const Args& A, const int wave) {
    const int lane = lane_opaque();
    const int gw = blockIdx.x * NWAVES + wave, NGW = gridDim.x * NWAVES;
    const bf16_t* x1 = (const bf16_t*)(A.ws + WS_X1); const float* mod = (const float*)(A.ws + WS_MOD); bf16_t* H2 = (bf16_t*)(A.ws + WS_H2);
    for (int row = gw; row < T; row += NGW) {
        const float* mb = mod + (size_t)(row >> 12) * 6144; f32x4 v[4];
        modnorm_row<true>(x1 + (size_t)row * DM, A.in[11], mb + 3072, mb + 4096, lane, v);
#pragma unroll
        for (int j = 0; j < 4; ++j) { unsigned h[4]; float l[4];
#pragma unroll
            for (int k = 0; k < 4; ++k) { h[k] = f2bf(v[j][k]); l[k] = v[j][k] - bf2f(h[k]); }
            u32x2 oh, ol; oh.x = h[0] | (h[1] << 16); oh.y = h[2] | (h[3] << 16); ol.x = pk2(l[0], l[1]); ol.y = pk2(l[2], l[3]);
            *((u32x2*)(H2 + (size_t)row * 2048) + lane + 64 * j) = oh; *((u32x2*)(H2 + (size_t)row * 2048 + 1024) + lane + 64 * j) = ol; }
    }
}

__device__ __forceinline__ void phase11(const Args& A, unsigned char* lds_, const int wave) {
    const int lane = lane_opaque();
    LAS int* sE = (LAS int*)((LAS unsigned char*)lds_ + wave * 1024); LAS float* sW = (LAS float*)(sE + 128);
    LAS int* hcnt = (LAS int*)((LAS unsigned char*)lds_ + 8192); LAS int* hbase = hcnt + NE;
    { const int t_ = wave * 64 + lane; if (t_ < NE) hcnt[t_] = 0; } __syncthreads();
    const int gw = blockIdx.x * NWAVES + wave, NGW = gridDim.x * NWAVES;
    unsigned char* ws = A.ws;
    const float* RLOG = (const float*)(ws + WS_RLOG); const float* bias = A.in[13];
    float* EW = (float*)(ws + WS_EW); int* LIST = (int*)(ws + WS_LIST); int* CNT = (int*)(ws + WS_CTL) + CW_CNT;
    const float NINF = -__builtin_inff();
    const int half = lane >> 5;
    float lgn[4];
#pragma unroll
    for (int j = 0; j < 4; ++j) { const int e = lane + 64 * j; lgn[j] = (gw < T) ? RLOG[(size_t)gw * 512 + e] + RLOG[(size_t)gw * 512 + 256 + e] : 0.f; }
    int it = 0;
    for (int row = gw; row < T; row += NGW, ++it) {
        float sc[4], bv[4];
#pragma unroll
        for (int j = 0; j < 4; ++j) { const int e = lane + 64 * j; const float lg = lgn[j];
            sc[j] = 1.f / (1.f + expf(-lg)); bv[j] = sc[j] + bias[e]; }
        if (row + NGW < T) {
#pragma unroll
            for (int j = 0; j < 4; ++j) { const int e = lane + 64 * j; lgn[j] = RLOG[(size_t)(row + NGW) * 512 + e] + RLOG[(size_t)(row + NGW) * 512 + 256 + e]; } }
        float gs[8];
#pragma unroll
        for (int j = 0; j < 4; ++j) { float m1l, m1h; half_max_dpp(bv[j], m1l, m1h); const float m1 = half ? m1h : m1l;
            const unsigned long long bal = __ballot(bv[j] == m1); const int fl = __ffs((unsigned)bal) - 1, fh = __ffs((unsigned)(bal >> 32)) - 1;
            const float v2 = ((lane & 31) == (half ? fh : fl)) ? NINF : bv[j]; float m2l, m2h; half_max_dpp(v2, m2l, m2h);
            gs[2 * j] = m1l + m2l; gs[2 * j + 1] = m1h + m2h; }
        unsigned gmask = 0u;
#pragma unroll
        for (int g = 0; g < 8; ++g) { int rank = 0;
#pragma unroll
            for (int o = 0; o < 8; ++o) rank += (gs[o] > gs[g] || (gs[o] == gs[g] && o < g)) ? 1 : 0;
            if (rank < 4) gmask |= 1u << g; }
        float val[4];
#pragma unroll
        for (int j = 0; j < 4; ++j) val[j] = ((gmask >> (half + 2 * j)) & 1u) ? bv[j] : NINF;
        int ei[8]; float ew[8]; float wsum = 0.f;
#pragma unroll
        for (int r = 0; r < 8; ++r) {
            const float lm = fmaxf(fmaxf(val[0], val[1]), fmaxf(val[2], val[3])); const float m = wave_max_dpp(lm);
            const unsigned long long b0 = __ballot(val[0] == m), b1 = __ballot(val[1] == m), b2 = __ballot(val[2] == m), b3 = __ballot(val[3] == m);
            const int js = b0 ? 0 : b1 ? 1 : b2 ? 2 : 3; const unsigned long long bs = b0 ? b0 : b1 ? b1 : b2 ? b2 : b3;
            const int ls = __ffsll((long long)bs) - 1; const int es = ls + 64 * js;
            const float mys = js == 0 ? sc[0] : js == 1 ? sc[1] : js == 2 ? sc[2] : sc[3];
            const float w = rdl_f(mys, ls);
#pragma unroll
            for (int j = 0; j < 4; ++j) val[j] = (lane == ls && js == j) ? NINF : val[j];
            ei[r] = es; ew[r] = w; wsum += w; }
        int my_e = 0; float my_w = 0.f;
#pragma unroll
        for (int r = 0; r < 8; ++r) if (lane == r) { my_e = ei[r]; my_w = ew[r] / wsum * 2.5f; }
        if (lane < 8) { sE[it * 8 + lane] = my_e; sW[it * 8 + lane] = my_w; }
    }
    LDS_WAIT();
    int eL[2], rkL[2], entL[2]; bool actL[2];
#pragma unroll
    for (int h = 0; h < 2; ++h) { const int p = lane + 64 * h, ti = p >> 3; const int row = gw + ti * NGW;
        actL[h] = ti < it; eL[h] = 0; rkL[h] = 0; entL[h] = row * 8 + (p & 7);
        if (actL[h]) { eL[h] = sE[p]; EW[entL[h]] = sW[p]; rkL[h] = __hip_atomic_fetch_add(hcnt + eL[h], 1, __ATOMIC_RELAXED, __HIP_MEMORY_SCOPE_WORKGROUP); } }
    __syncthreads();
    { const int t_ = wave * 64 + lane; if (t_ < NE) { const int c = hcnt[t_]; hbase[t_] = c > 0 ? atomicAdd(&CNT[t_ * CNT_STRIDE], c) : 0; } }
    __syncthreads();
#pragma unroll
    for (int h = 0; h < 2; ++h) if (actL[h]) LIST[(size_t)eL[h] * T + hbase[eL[h]] + rkL[h]] = entL[h];
}

__device__ __forceinline__ int moe_tables(const Args& A, unsigned char* lds_, const int wave) {
    LAS int* cnt = (LAS int*)((LAS unsigned char*)lds_ + TAB_OFF); LAS int* tstart = cnt + 264;
    const int* CNT = (const int*)(A.ws + WS_CTL) + CW_CNT;
    const int tid = wave * 64 + lane_opaque();
    if (tid < NE) cnt[tid] = __hip_atomic_load(CNT + tid * CNT_STRIDE, __ATOMIC_RELAXED, __HIP_MEMORY_SCOPE_AGENT);
    if (tid == NE) cnt[NE] = T;
    __syncthreads();
    if (wave == 0) {
        const int l = tid; const u32x4 c4 = *(const LAS u32x4*)(cnt + 4 * l);
        const int t0 = (int)(c4.x + 255u) >> 8, t1 = (int)(c4.y + 255u) >> 8, t2 = (int)(c4.z + 255u) >> 8, t3 = (int)(c4.w + 255u) >> 8, loc = (t0 + t1) + (t2 + t3);
        int p = loc;
        p += idx::dpp_i0<0x111>(p); p += idx::dpp_i0<0x112>(p); p += idx::dpp_i0<0x114>(p); p += idx::dpp_i0<0x118>(p);
        const int r0 = __builtin_amdgcn_readlane(p, 15), r1 = __builtin_amdgcn_readlane(p, 31), r2 = __builtin_amdgcn_readlane(p, 47);
        const int rr = l >> 4; p += rr == 0 ? 0 : rr == 1 ? r0 : rr == 2 ? r0 + r1 : r0 + r1 + r2;
        const int ex = p - loc;
        *(LAS u32x4*)(tstart + 4 * l) = (u32x4){(unsigned)ex, (unsigned)(ex + t0), (unsigned)(ex + t0 + t1), (unsigned)(ex + t0 + t1 + t2)};
        if (l == 63) { tstart[NE] = p; tstart[NEX] = p + ((T + 255) >> 8); }
    }
    __syncthreads();
    return tstart[NEX];
}


__device__ __forceinline__ void phase14(const Args& A, const int wave) {
    const int lane = lane_opaque();
    const int gw = blockIdx.x * NWAVES + wave, NGW = gridDim.x * NWAVES;
    float* out = A.out; const float* mod = (const float*)(A.ws + WS_MOD); const int* INV = (const int*)(A.ws + WS_INV);
    const unsigned char* CA = (const unsigned char*)(A.ws + WS_CA); const bf16_t* SH = (const bf16_t*)(A.ws + WS_SH); const bf16_t* X1 = (const bf16_t*)(A.ws + WS_X1);
#define P14_LOAD(pr_, row_, w_, x_, g2_) do { _Pragma("unroll") for (int k = 0; k < 8; ++k) { const int p = __builtin_amdgcn_readlane(pr_, k); w_[k] = *((const u32x4*)(CA + (size_t)p * DM) + lane); } \
        _Pragma("unroll") for (int q = 0; q < 4; ++q) g2_[q] = *((const f32x4*)(mod + (size_t)((row_) >> 12) * 6144 + 5120 + 16 * lane) + q); \
        w_[8] = *((const u32x4*)((const unsigned char*)SH + (size_t)(row_) * DM) + lane); \
        w_[10] = *((const u32x4*)(X1 + (size_t)(row_) * DM + 16 * lane)); w_[11] = *((const u32x4*)(X1 + (size_t)(row_) * DM + 16 * lane) + 1); } while (0)
#define P14_FIN(row_, w_, x_, g2_) do { float* orow = out + (size_t)(row_) * DM + 16 * lane; \
        float y[16]; _Pragma("unroll") for (int q = 0; q < 16; ++q) y[q] = 0.f; \
        _Pragma("unroll") for (int k = 0; k < 8; ++k) _Pragma("unroll") for (int d = 0; d < 4; ++d) { \
            const f32x2 lo = __builtin_amdgcn_cvt_pk_f32_fp8((int)w_[k][d], false), hi = __builtin_amdgcn_cvt_pk_f32_fp8((int)w_[k][d], true); \
            y[4 * d] += lo[0]; y[4 * d + 1] += lo[1]; y[4 * d + 2] += hi[0]; y[4 * d + 3] += hi[1]; } \
        float ysh[16]; _Pragma("unroll") for (int d = 0; d < 4; ++d) { \
            const f32x2 lo = __builtin_amdgcn_cvt_pk_f32_fp8((int)w_[8][d], false), hi = __builtin_amdgcn_cvt_pk_f32_fp8((int)w_[8][d], true); \
            ysh[4 * d] = lo[0]; ysh[4 * d + 1] = lo[1]; ysh[4 * d + 2] = hi[0]; ysh[4 * d + 3] = hi[1]; } \
        float v[16]; float s = 0.f; \
        _Pragma("unroll") for (int q = 0; q < 4; ++q) { const f32x4 g = g2_[q]; \
            _Pragma("unroll") for (int e = 0; e < 4; ++e) { const unsigned xw = w_[10 + (q >> 1)][2 * (q & 1) + (e >> 1)]; \
                const float xv = (e & 1) ? bfhi(xw) : bflo(xw); \
                v[4 * q + e] = xv + g[e] * (y[4 * q + e] * (1.f / 16.f) + ysh[4 * q + e] * 0.25f); s += v[4 * q + e] * v[4 * q + e]; } } \
        const float rstd = 1.f / sqrtf(wave_sum_dpp(s) * (1.f / DM) + EPS); \
        _Pragma("unroll") for (int q = 0; q < 4; ++q) { const f32x4 g = gfin[q]; \
            *((f32x4*)orow + q) = (f32x4){v[4 * q] * rstd * g[0], v[4 * q + 1] * rstd * g[1], v[4 * q + 2] * rstd * g[2], v[4 * q + 3] * rstd * g[3]}; } } while (0)
    f32x4 gfin[4];
#pragma unroll
    for (int q = 0; q < 4; ++q) gfin[q] = *((const f32x4*)(A.in[20] + 16 * lane) + q);
    int prA = (gw < T) ? INV[(size_t)gw * 8 + (lane & 7)] : 0, prB = (gw + NGW < T) ? INV[(size_t)(gw + NGW) * 8 + (lane & 7)] : 0;
    for (int row = gw; row < T; row += 2 * NGW) {
        const int rowB = row + NGW; const bool hasB = rowB < T;
        const int pa = prA, pb = prB;
        if (row + 2 * NGW < T) prA = INV[(size_t)(row + 2 * NGW) * 8 + (lane & 7)];
        if (row + 3 * NGW < T) prB = INV[(size_t)(row + 3 * NGW) * 8 + (lane & 7)];
        u32x4 wa[12], wb[12]; f32x4 xa[4], xb[4], ga[4], gb[4];
        P14_LOAD(pa, row, wa, xa, ga);
        if (hasB) P14_LOAD(pb, rowB, wb, xb, gb);
        P14_FIN(row, wa, xa, ga);
        if (hasB) P14_FIN(rowB, wb, xb, gb);
    }
#undef P14_LOAD
#undef P14_FIN
}

__global__ void __launch_bounds__(NTHR, 2) fwd(Args args) {
    extern __shared__ __attribute__((aligned(16))) unsigned char lds[];
    const int wave = __builtin_amdgcn_readfirstlane((int)threadIdx.x >> 6);
    volatile LAS unsigned* MISC = (volatile LAS unsigned*)((LAS unsigned char*)lds + MISC_OFF);
    if (wave == 0) MISC[lane_opaque()] = 0u;
    __syncthreads();
    const int lo = args.ph_lo, hi = args.ph_hi;
    unsigned char* ws = args.ws;
    XcdBarrier bar; bar.bar = (unsigned*)(ws + WS_CTL); bar.x = 0; bar.st = nullptr;
    if (hi - lo > 1) bar = xcd_barrier_post((unsigned*)(ws + WS_CTL), MISC, wave == 0 && lane_opaque() == 0);
    const int G = gridDim.x, cid = blockIdx.x;
#define IN(k) (lo <= (k) && (k) < hi)
#define SEAM(k) do { if (IN(k) && IN((k) + 1)) xcd_barrier(bar, wave); } while (0)
    LAS unsigned char* ring = (LAS unsigned char*)lds;

    if (IN(0)) { phase0(args, lds, wave); __syncthreads(); } SEAM(0);
    if (IN(1)) { phase1(args, wave); } SEAM(1);
    if (IN(2)) {
        pg8::DenseSched S; S.init(ws + WS_H, 2048u, ws + WS_WIN, 2048u, T, NPROJP, G, cid);
        pg8::EpiProjFused E{(bf16_t*)(ws + WS_QM), (bf16_t*)(ws + WS_KM), (bf16_t*)(ws + WS_VM), (bf16_t*)(ws + WS_QD), (bf16_t*)(ws + WS_CKVN), (float*)(ws + WS_KVRAW),
                            (f16_t*)(ws + WS_QI), (f16_t*)(ws + WS_KI), (float*)(ws + WS_WI), (const float*)(ws + WS_COSH), (const float*)(ws + WS_SINH), (const float*)(ws + WS_COSI), (const float*)(ws + WS_SINI)};
        pg8::gemm_phase<pg8::EpiProjFused, pg8::DenseSched, true>(ring, S, E, 1024, wave);
    }
    if (IN(2) && IN(4)) xcd_barrier(bar, wave);
    if (IN(4)) {
        const int ngemm = T / 256;
        if (G > ngemm && cid >= ngemm) kmean_units(args, lds, wave, cid - ngemm, G - ngemm);
        else {
            pg8::DenseSched S; S.init(ws + WS_CKVN, 512u, ws + WS_WKV, 512u, T, 256, G, cid);
            pg8::EpiKV E{(bf16_t*)(ws + WS_KD), (bf16_t*)(ws + WS_VD), (const float*)(ws + WS_KVRAW), (const float*)(ws + WS_COSH), (const float*)(ws + WS_SINH)};
            pg8::gemm_phase<pg8::EpiKV, pg8::DenseSched, true>(ring, S, E, 256, wave);
            if (G <= ngemm) { __syncthreads(); kmean_units(args, lds, wave, cid, G); }
        }
    }
    if (IN(4) && IN(6)) xcd_barrier(bar, wave);
    if (IN(6)) { phase6(args, lds, wave); __syncthreads(); }
    if (IN(6) && IN(8)) xcd_barrier(bar, wave);
    if (IN(8)) {
        pg8::DenseSched S; S.init(ws + WS_H, 2048u, ws + WS_WOUT, 2048u, T, 1024, G, cid);
        pg8::EpiResidNorm E{args.in[0], (bf16_t*)(ws + WS_X1), (const float*)(ws + WS_MOD), (const float*)(ws + WS_OM), (LAS float*)((LAS unsigned char*)lds + TOK_OFF)};
        pg8::gemm_phase<pg8::EpiResidNorm, pg8::DenseSched, true, true>(ring, S, E, 1024, wave);
    } SEAM(8);
    if (IN(9)) { phase9(args, wave); } SEAM(9);
    if (IN(10)) {
        pg8::DenseSched S; S.init(ws + WS_H2, 4096u, ws + WS_WR, 4096u, T, 512, G, cid);
        pg8::EpiF32 E{(float*)(ws + WS_RLOG), 512};
        pg8::gemm_phase<pg8::EpiF32, pg8::DenseSched, true>(ring, S, E, 2048, wave);
    } SEAM(10);
    if (IN(11)) { phase11(args, lds, wave); } SEAM(11);
    if (IN(12)) {
        const int total_rt = moe_tables(args, lds, wave);
        pg8::MoeTab tb{(const LAS int*)((LAS unsigned char*)lds + TAB_OFF), (const LAS int*)((LAS unsigned char*)lds + TAB_OFF) + 264};
        LAS int* tokl = (LAS int*)((LAS unsigned char*)lds + TOK_OFF);
        LAS int* utab = (LAS int*)((LAS unsigned char*)lds + TAB_OFF) + 528;
        pg8::MoeUpSched S{tb, (const char*)(ws + WS_H2), tokl, (const char*)(ws + WS_WGU), 2048u, total_rt * 2, G, cid, utab};
        { const int t_ = wave * 64 + lane_opaque(); if (t_ < pg8::UT_MAX) { pg8::Unit u; const bool ok = S.compute(t_, u); *(LAS u32x4*)(utab + 4 * t_) = ok ? (u32x4){(unsigned)u.e, (unsigned)u.rt, (unsigned)(u.pn | ((u.e == NE ? 256 : (tb.cnt[u.e] - u.pm * 256 < 256 ? tb.cnt[u.e] - u.pm * 256 : 256)) << 8)), (unsigned)u.pm} : (u32x4){~0u, 0u, 0u, 0u}; } __syncthreads(); }
        {
            const int lane = lane_opaque(), tid = wave * 64 + lane, half = tid >> 8, row = tid & 255;
            const int* list = (const int*)(ws + WS_LIST); const float* ew = (const float*)(ws + WS_EW); int* inv = (int*)(ws + WS_INV);
            int ue = -1, upm = 0, urt = 0;
            { pg8::Unit u; if (lane < MAX_UNITS && S.next(lane, u)) { ue = u.e; upm = u.pm; urt = u.rt; } }
            const int nun = __popcll(__ballot(ue >= 0));
            for (int i0 = 0; i0 < MAX_UNITS / 2; i0 += 5) {
                int ent[5], ke[5], kpos[5], krt[5]; bool val[5];
#pragma unroll
                for (int jj = 0; jj < 5; ++jj) { const int k = half + 2 * (i0 + jj), kc = k < MAX_UNITS ? k : 0;
                    ke[jj] = __builtin_amdgcn_readlane(ue, kc); krt[jj] = __builtin_amdgcn_readlane(urt, kc); kpos[jj] = __builtin_amdgcn_readlane(upm, kc) * 256 + row;
                    val[jj] = k < nun && ke[jj] != NE && kpos[jj] < tb.cnt[ke[jj] < 0 ? 0 : ke[jj]];
                    ent[jj] = list[(size_t)(val[jj] ? ke[jj] : 0) * T + (val[jj] ? kpos[jj] : 0)]; }
                float wv[5];
#pragma unroll
                for (int jj = 0; jj < 5; ++jj) { ent[jj] = val[jj] ? ent[jj] : 0; wv[jj] = ew[ent[jj]]; }
#pragma unroll
                for (int jj = 0; jj < 5; ++jj) { const int k = half + 2 * (i0 + jj);
                    if (k < nun) { unsigned tw = 0u;
                        if (ke[jj] == NE) tw = (unsigned)kpos[jj] | 0x3C000000u;
                        else if (val[jj]) { const f16_t wh = (f16_t)wv[jj]; tw = (unsigned)(ent[jj] >> 3) | ((unsigned)__builtin_bit_cast(unsigned short, wh) << 16); inv[ent[jj]] = krt[jj] * 256 + row; }
                        tokl[k * 256 + row] = (int)tw; } }
            }
            __syncthreads();
        }
        pg8::EpiAct E{(bf16_t*)(ws + WS_ACT), tokl};
        pg8::gemm_phase<pg8::EpiAct, pg8::MoeUpSched, true>(ring, S, E, 1024, wave);
    } SEAM(12);
    if (IN(13)) {
        const int total_rt = moe_tables(args, lds, wave);
        pg8::MoeTab tb{(const LAS int*)((LAS unsigned char*)lds + TAB_OFF), (const LAS int*)((LAS unsigned char*)lds + TAB_OFF) + 264};
        LAS int* utab = (LAS int*)((LAS unsigned char*)lds + TAB_OFF) + 528;
        pg8::MoeDownSched S{tb, (const char*)(ws + WS_ACT), (const char*)(ws + WS_WD), 512u, total_rt * 4, G, cid, utab};
        { const int t_ = wave * 64 + lane_opaque(); if (t_ < pg8::UT_MAX) { pg8::Unit u; const bool ok = S.compute(t_, u); *(LAS u32x4*)(utab + 4 * t_) = ok ? (u32x4){(unsigned)u.e, (unsigned)u.rt, (unsigned)(u.pn | ((u.e == NE ? 256 : (tb.cnt[u.e] - u.pm * 256 < 256 ? tb.cnt[u.e] - u.pm * 256 : 256)) << 8)), (unsigned)u.pm} : (u32x4){~0u, 0u, 0u, 0u}; } __syncthreads(); }
        pg8::EpiDown E{(bf16_t*)(ws + WS_CA), (bf16_t*)(ws + WS_SH)};
        pg8::gemm_phase<pg8::EpiDown, pg8::MoeDownSched, true>(ring, S, E, 256, wave);
    } SEAM(13);
    if (IN(14)) { phase14(args, wave); }
#undef IN
#undef SEAM
}

#ifndef N_LAUNCHES
#define N_LAUNCHES 1
#endif
extern "C" void kernel_launch(void* const* d_in, const int* in_sizes, int n_in, void* d_out, int out_size, void* d_ws, size_t ws_size, hipStream_t stream) {
    static int grid = 0;
    if (grid == 0) {
        if (n_in != 21 || in_sizes[0] != T * DM || out_size != T * DM || ws_size < WS_END) {
            fprintf(stderr, "kernel_launch: shape/workspace mismatch (n_in %d, in0 %d, out %d, ws %zu, need %zu); nothing launched\n", n_in, n_in > 0 ? in_sizes[0] : -1, out_size, ws_size, (size_t)WS_END); grid = -1; return; }
        int dev = 0, cus = 0, per_cu = 0;
        if (hipGetDevice(&dev) != hipSuccess || hipDeviceGetAttribute(&cus, hipDeviceAttributeMultiprocessorCount, dev) != hipSuccess) { grid = -1; return; }
        if (hipFuncSetAttribute((const void*)fwd, hipFuncAttributeMaxDynamicSharedMemorySize, LDS_BYTES) != hipSuccess) { fprintf(stderr, "kernel_launch: hipFuncSetAttribute failed\n"); grid = -1; return; }
        if (hipOccupancyMaxActiveBlocksPerMultiprocessor(&per_cu, (const void*)fwd, NTHR, LDS_BYTES) != hipSuccess || per_cu < 1) fprintf(stderr, "kernel_launch: occupancy query says %d\n", per_cu);
        (void)hipGetLastError();
        grid = cus;
    }
    if (grid < 0) return;
    (void)hipMemsetAsync((char*)d_ws + WS_CTL, 0, CTL_ZERO_BYTES, stream);
    Args a{};
    for (int i = 0; i < 21; ++i) a.in[i] = (const float*)d_in[i];
    a.out = (float*)d_out; a.ws = (unsigned char*)d_ws;
    if (N_LAUNCHES == 1) { a.ph_lo = 0; a.ph_hi = NPHASE; hipLaunchKernelGGL(fwd, dim3(grid), dim3(NTHR), LDS_BYTES, stream, a); }
    else for (int p = 0; p < NPHASE; ++p) { a.ph_lo = p; a.ph_hi = p + 1; hipLaunchKernelGGL(fwd, dim3(grid), dim3(NTHR), LDS_BYTES, stream, a); }
}
```

```cpp
#include <hip/hip_runtime.h>
#include <cstdio>
#include <cstdint>

#define GAS __attribute__((address_space(1)))
#define LAS __attribute__((address_space(3)))
typedef unsigned short bf16_t;
typedef short bf16x8 __attribute__((ext_vector_type(8)));
typedef float f32x4 __attribute__((ext_vector_type(4)));
typedef float f32x2 __attribute__((ext_vector_type(2)));
typedef unsigned u32x4 __attribute__((ext_vector_type(4)));
typedef unsigned u32x2 __attribute__((ext_vector_type(2)));
typedef _Float16 f16_t;

constexpr int NB = 8, SEQ = 4096, T = NB * SEQ, DM = 1024;
constexpr int NPROJ = 2888, NPROJP = 3072;
constexpr int NE = 256, NEX = 257;
constexpr int NWAVES = 8, NTHR = 512;
constexpr float EPS = 1e-6f;
constexpr int NPHASE = 15;

constexpr size_t MiB = 1u << 20;
constexpr size_t WS_CTL = 0, CTL_ZERO_BYTES = 65536;
constexpr int CW_CNT = 4096, CNT_STRIDE = 32;
constexpr size_t WS_MOD = 1 * MiB;
constexpr size_t WS_KMEAN = 1 * MiB + 256 * 1024;
constexpr size_t WS_COSH = 2 * MiB, WS_SINH = WS_COSH + 256 * 1024, WS_COSI = WS_SINH + 256 * 1024, WS_SINI = WS_COSI + 128 * 1024;
constexpr size_t WS_WIN = 4 * MiB;
constexpr size_t WS_WOUT = 10 * MiB;
constexpr size_t WS_WR = 12 * MiB;
constexpr size_t WS_WKV = 14 * MiB;
constexpr size_t WS_WD = 16 * MiB;
constexpr size_t WS_WGU = 145 * MiB;
constexpr size_t WS_H = 402 * MiB;
constexpr size_t WS_KS = 466 * MiB;
constexpr size_t WS_QM = 706 * MiB, WS_KM = 738 * MiB, WS_VM = 770 * MiB, WS_QD = 802 * MiB;
constexpr size_t WS_MASK = 834 * MiB;
constexpr size_t WS_CKVN = 834 * MiB, WS_KVRAW = 850 * MiB, WS_KD = 866 * MiB, WS_VD = 874 * MiB;
constexpr size_t WS_QI = 896 * MiB, WS_KI = 928 * MiB, WS_WI = 932 * MiB, WS_OM = 936 * MiB;
constexpr size_t WS_H2 = 402 * MiB;
constexpr size_t WS_SH = 530 * MiB;
constexpr size_t WS_RLOG = 530 * MiB;
constexpr size_t WS_EW = 835 * MiB, WS_LIST = 836 * MiB;
constexpr size_t WS_ACT = 658 * MiB;
constexpr size_t WS_CA = 145 * MiB;
constexpr size_t WS_INV = 834 * MiB;
constexpr size_t WS_X1 = 944 * MiB;
constexpr size_t WS_END = 1024 * MiB;
static_assert(WS_WD + (size_t)NEX * 1024 * 256 * 2 <= WS_WGU && WS_WGU + (size_t)NEX * 512 * 1024 * 2 <= WS_H, "weights map");
static_assert(WS_LIST + (size_t)NE * T * 4 <= WS_KD + 16 * MiB && WS_ACT + 360448ull * 512 <= WS_INV, "moe map");

constexpr int RING_BYTES = 131072;
constexpr int MISC_OFF = 157 * 1024;
constexpr int TAB_OFF = MISC_OFF + 256;
constexpr int TOK_OFF = RING_BYTES, MAX_UNITS = 20;
static_assert(TOK_OFF + MAX_UNITS * 1024 <= MISC_OFF, "lds map");
constexpr int LDS_BYTES = 160 * 1024;

__device__ __forceinline__ unsigned f2bf(float f) { unsigned u = __builtin_bit_cast(unsigned, f); return (u + 0x7fffu + ((u >> 16) & 1u)) >> 16; }
__device__ __forceinline__ float bf2f(unsigned h) { return __builtin_bit_cast(float, h << 16); }
__device__ __forceinline__ unsigned pk2(float lo, float hi) { unsigned r; asm("v_cvt_pk_bf16_f32 %0, %1, %2" : "=v"(r) : "v"(lo), "v"(hi)); return r; }
__device__ __forceinline__ float bflo(unsigned w) { return __builtin_bit_cast(float, w << 16); }
__device__ __forceinline__ float bfhi(unsigned w) { return __builtin_bit_cast(float, w & 0xffff0000u); }
__device__ __forceinline__ int lane_opaque() { int l; asm volatile("v_mbcnt_lo_u32_b32 %0, -1, 0\n\tv_mbcnt_hi_u32_b32 %0, -1, %0" : "=v"(l)); return l; }


template <int CTRL> __device__ __forceinline__ float dpp_mov_f(float v) { return __builtin_bit_cast(float, __builtin_amdgcn_update_dpp(__builtin_bit_cast(int, v), __builtin_bit_cast(int, v), CTRL, 0xF, 0xF, false)); }
__device__ __forceinline__ float row_max16(float v) {
    v = fmaxf(v, dpp_mov_f<0xB1>(v)); v = fmaxf(v, dpp_mov_f<0x4E>(v)); v = fmaxf(v, dpp_mov_f<0x141>(v)); v = fmaxf(v, dpp_mov_f<0x140>(v)); return v;
}
__device__ __forceinline__ float rdl_f(float v, int l) { return __builtin_bit_cast(float, __builtin_amdgcn_readlane(__builtin_bit_cast(int, v), l)); }
__device__ __forceinline__ float wave_sum_dpp(float v) {
    v += dpp_mov_f<0xB1>(v); v += dpp_mov_f<0x4E>(v); v += dpp_mov_f<0x141>(v); v += dpp_mov_f<0x140>(v);
    return (rdl_f(v, 0) + rdl_f(v, 16)) + (rdl_f(v, 32) + rdl_f(v, 48));
}
__device__ __forceinline__ float wave_max_dpp(float v) { v = row_max16(v); return fmaxf(fmaxf(rdl_f(v, 0), rdl_f(v, 16)), fmaxf(rdl_f(v, 32), rdl_f(v, 48))); }
__device__ __forceinline__ void half_max_dpp(float v, float& lo, float& hi) { v = row_max16(v); lo = fmaxf(rdl_f(v, 0), rdl_f(v, 16)); hi = fmaxf(rdl_f(v, 32), rdl_f(v, 48)); }
#define VM_WAIT() asm volatile("s_waitcnt vmcnt(0)" ::: "memory")
#define LDS_WAIT() asm volatile("s_waitcnt lgkmcnt(0)" ::: "memory")

struct Args { const float* in[21]; float* out; unsigned char* ws; int ph_lo, ph_hi; };

#define XB_TMO      128
#define XB_XCNT(j)  (256  + 64 * (j))
#define XB_XSUB(j)  (1280 + 64 * (j))
#define XB_XGEN(j)  (2304 + 64 * (j))
#define XB_TOP      3328
#define XB_TOPGEN   3392
#define XCD_BAR_WORDS 3456
#define XB_SPIN_CAP (1u << 22)
__device__ __forceinline__ unsigned xb_ld(unsigned* p)              { return __hip_atomic_load(p, __ATOMIC_RELAXED, __HIP_MEMORY_SCOPE_AGENT); }
__device__ __forceinline__ unsigned xb_add(unsigned* p, unsigned v) { return __hip_atomic_fetch_add(p, v, __ATOMIC_RELAXED, __HIP_MEMORY_SCOPE_AGENT); }
__device__ __forceinline__ unsigned xb_xcc_id() { return (unsigned)__builtin_amdgcn_s_getreg((3 << 11) | 20) & 0xFu; }
#define XB_SPIN(cond, bar) do { unsigned _sp = 0; while (cond) { __builtin_amdgcn_s_sleep(1); \
    if ((++_sp & 255u) == 0u) { if (xb_ld(&(bar)[XB_TMO])) break; if (_sp > XB_SPIN_CAP) { atomicAdd(&(bar)[XB_TMO], 1u); break; } } } } while (0)
struct XcdBarrier { unsigned* bar; unsigned x; volatile LAS unsigned* st; };
__device__ __forceinline__ XcdBarrier xcd_barrier_post(unsigned* bar, volatile LAS unsigned* st, bool t0) {
    XcdBarrier b; b.bar = bar; b.x = xb_xcc_id(); b.st = st;
    if (t0) (void)xb_add(&bar[XB_XCNT(b.x)], 1u);
    return b;
}
__device__ __forceinline__ void xcd_barrier_complete(unsigned* bar, unsigned x, unsigned& nloc, unsigned& nx) {
    const unsigned G = gridDim.x * gridDim.y * gridDim.z;
    unsigned sum, cnt, mine, sp = 0u;
    for (;;) {
        sum = 0u; cnt = 0u; mine = 0u;
#pragma unroll
        for (unsigned j = 0; j < 16; ++j) { const unsigned c = xb_ld(&bar[XB_XCNT(j)]); sum += c; cnt += (c > 0u) ? 1u : 0u; mine = (j == x) ? c : mine; }
        if (sum == G) break;
        __builtin_amdgcn_s_sleep(1);
        if ((++sp & 255u) == 0u) { if (xb_ld(&bar[XB_TMO])) break; if (sp > XB_SPIN_CAP) { atomicAdd(&bar[XB_TMO], 1u); break; } }
    }
    nloc = mine > 0u ? mine : 1u; nx = cnt > 0u ? cnt : 1u;
}
__device__ __forceinline__ void xcd_barrier(const XcdBarrier& b, int wave) {
    asm volatile("s_waitcnt vmcnt(0)" ::: "memory");
    __syncthreads();
    if (wave == 0 && lane_opaque() == 0) {
        unsigned* bar = b.bar;
        __builtin_amdgcn_s_waitcnt(0);
        unsigned nloc = b.st[0], nx = b.st[1];
        if (nloc == 0u) { xcd_barrier_complete(bar, b.x, nloc, nx); b.st[0] = nloc; b.st[1] = nx; }
        const unsigned old = xb_add(&bar[XB_XSUB(b.x)], 1u);
        const unsigned gen = old / nloc;
        if (old + 1u == (gen + 1u) * nloc) {
            __builtin_amdgcn_fence(__ATOMIC_RELEASE, "agent");
            asm volatile("s_waitcnt vmcnt(0)" ::: "memory");
            const unsigned og = xb_add(&bar[XB_TOP], 1u);
            const unsigned tg = og / nx;
            if (og + 1u == (tg + 1u) * nx) xb_add(&bar[XB_TOPGEN], 1u);
            else XB_SPIN(xb_ld(&bar[XB_TOPGEN]) == tg, bar);
            __builtin_amdgcn_fence(__ATOMIC_ACQUIRE, "agent");
            xb_add(&bar[XB_XGEN(b.x)], 1u);
            asm volatile("s_waitcnt vmcnt(0)" ::: "memory");
        } else {
            XB_SPIN(xb_ld(&bar[XB_XGEN(b.x)]) == gen, bar);
            __builtin_amdgcn_fence(__ATOMIC_ACQUIRE, "agent");
            asm volatile("s_waitcnt vmcnt(0)" ::: "memory");
        }
    }
    __syncthreads();
}

namespace pg8 {
constexpr int BM = 256, BK = 64, HALF = 128, HTB = HALF * BK * 2, NXCD = 8, WGM = 8;
__host__ __device__ __forceinline__ int lds_byte(int r, int c) { const int st = (r >> 4) * 2 + (c >> 5), rr = r & 15, cc = c & 31, ob = rr * 64 + cc * 2; return st * 1024 + (ob ^ (((ob >> 9) & 1) << 5)); }
__host__ __device__ __forceinline__ void stage_rc(int b, int& R, int& C) { const int st = b / 1024, sb = b % 1024, swz = sb ^ (((sb >> 9) & 1) << 5); R = (st >> 1) * 16 + swz / 64; C = (st & 1) * 32 + (swz % 64) / 2; }
__host__ __device__ __forceinline__ int perm32(int rho) { const int n = rho >> 4, i = rho & 15; return 8 * (i >> 2) + 4 * n + (i & 3); }

struct Unit { int pm, pn, e, rt, slot; };

struct DenseSched {
    const char* A; const char* B; unsigned lda, ldb; int nM, nN, nwg, G, c;
    __device__ __forceinline__ void init(const void* A_, unsigned lda_, const void* B_, unsigned ldb_, int M, int N, int G_, int c_) { A = (const char*)A_; B = (const char*)B_; lda = lda_; ldb = ldb_; nM = M / BM; nN = N / BM; nwg = nM * nN; G = G_; c = c_; }
    __device__ __forceinline__ bool next(int i, Unit& u) const {
        const long L = (long)i * G + c; if (L >= nwg) return false;
        int wgid = (int)L; { const int q = nwg / NXCD, r = nwg % NXCD, xcd = wgid % NXCD, off = wgid / NXCD; wgid = (xcd < r ? xcd * (q + 1) : r * (q + 1) + (xcd - r) * q) + off; }
        const int nig = WGM * nN, gid = wgid / nig, fm = gid * WGM, gsz = (nM - fm) < WGM ? (nM - fm) : WGM;
        u.pm = fm + ((wgid % nig) % gsz); u.pn = (wgid % nig) / gsz; u.e = 0; u.rt = u.pm; u.slot = i; return true;
    }
    __device__ __forceinline__ const char* a_ubase(const Unit& u) const { return A + (size_t)u.pm * BM * lda; }
    __device__ __forceinline__ void a_off(const Unit& u, const int (&R)[2], const int (&C)[2], unsigned (&o)[2][2]) const {
#pragma unroll
        for (int h = 0; h < 2; ++h)
#pragma unroll
            for (int i = 0; i < 2; ++i) o[h][i] = (unsigned)(h * HALF + R[i]) * lda + (unsigned)C[i] * 2u;
    }
    __device__ __forceinline__ const char* b_base(const Unit& u) const { return B + (size_t)u.pn * BM * ldb; }
};

template <class Epi, class Sched, bool ALIGN_EPI, bool MIDHOOK = false>
__device__ __forceinline__ void gemm_phase(LAS unsigned char* lds, const Sched& S, const Epi& E, const int K, const int wid) {
    const int lane = lane_opaque(), tid = wid * 64 + lane, wr = wid >> 2, wc = wid & 3, fr = lane & 15, fq = lane >> 4;
    const int nt = K / BK;
    int Rr[2], Cc[2]; unsigned voffB[2];
#pragma unroll
    for (int i = 0; i < 2; ++i) { int R, C; stage_rc(tid * 16 + i * 8192, R, C); Rr[i] = R; Cc[i] = C; const int Rb = Epi::PERM ? ((R & ~31) + perm32(R & 31)) : R;
        voffB[i] = (unsigned)Rb * S.ldb + (unsigned)C * 2u; }
    const size_t kstep = (size_t)(BK * 2);
    const size_t hstepB = (size_t)HALF * S.ldb;
    const unsigned ldsw = (unsigned)wid * 1024u;
    const int aoff = lds_byte(wr * 64 + fr, fq * 8), boff = lds_byte(wc * 32 + fr, fq * 8);
#define PG8_SA(b, h) (((b) * 2 + (h)) * HTB)
#define PG8_SB(b, h) ((4 + (b) * 2 + (h)) * HTB)
#define PG8_STAGE(bufoff, gbase, voff) do { _Pragma("unroll") for (int _i = 0; _i < 2; ++_i) \
        __builtin_amdgcn_global_load_lds((const unsigned*)((const char*)(gbase) + (voff)[_i]), (LAS unsigned*)(lds + (bufoff) + ldsw + _i * 8192), 16, 0, 0); } while (0)
#define PG8_LDA(dst, b, h) do { _Pragma("unroll") for (int m = 0; m < 4; ++m) _Pragma("unroll") for (int k = 0; k < 2; ++k) dst[m][k] = *(const LAS bf16x8*)(lds + PG8_SA(b, h) + aoff + m * 2048 + k * 1024); } while (0)
#define PG8_LDB(dst, b, h) do { _Pragma("unroll") for (int n = 0; n < 2; ++n) _Pragma("unroll") for (int k = 0; k < 2; ++k) dst[n][k] = *(const LAS bf16x8*)(lds + PG8_SB(b, h) + boff + n * 2048 + k * 1024); } while (0)
#define PG8_MMA(ai, bj, At, Bt) do { __builtin_amdgcn_s_setprio(1); _Pragma("unroll") for (int m = 0; m < 4; ++m) _Pragma("unroll") for (int n = 0; n < 2; ++n) _Pragma("unroll") for (int k = 0; k < 2; ++k) \
        acc[ai][bj][m][n] = __builtin_amdgcn_mfma_f32_16x16x32_bf16(Bt[n][k], At[m][k], acc[ai][bj][m][n], 0, 0, 0); __builtin_amdgcn_s_setprio(0); } while (0)
#define PG8_WAIT_V(n) asm volatile("s_waitcnt vmcnt(" #n ")" ::: "memory")
#define PG8_WAIT_L(n) asm volatile("s_waitcnt lgkmcnt(" #n ")" ::: "memory")
#define PG8_BAR __builtin_amdgcn_s_barrier()
#define PG8_SCHED __builtin_amdgcn_sched_barrier(0)
    Unit cur, nxt; int ui = 0;
    if (!S.next(0, cur)) return;
    if constexpr (MIDHOOK) E.begin(cur, wid);
    f32x4 acc[2][2][4][2];
#pragma unroll
    for (int a = 0; a < 2; ++a)
#pragma unroll
        for (int b = 0; b < 2; ++b)
#pragma unroll
            for (int m = 0; m < 4; ++m)
#pragma unroll
                for (int n = 0; n < 2; ++n) acc[a][b][m][n] = (f32x4){0.f, 0.f, 0.f, 0.f};
    bf16x8 At[4][2], B0[2][2], B1[2][2];
    unsigned oc[2][2];
    S.a_off(cur, Rr, Cc, oc);
    const char* cA = S.a_ubase(cur);
    const char* cB = S.b_base(cur);
    PG8_STAGE(PG8_SB(0, 0), cB, voffB); PG8_STAGE(PG8_SB(0, 1), cB + hstepB, voffB); PG8_STAGE(PG8_SA(0, 0), cA, oc[0]); PG8_STAGE(PG8_SA(0, 1), cA, oc[1]);
    if (wr == 1) PG8_BAR;
    PG8_WAIT_V(2); PG8_BAR;
    PG8_STAGE(PG8_SB(1, 0), cB + kstep, voffB); PG8_STAGE(PG8_SA(1, 0), cA + kstep, oc[0]); PG8_STAGE(PG8_SB(1, 1), cB + hstepB + kstep, voffB);
    PG8_WAIT_V(6); PG8_BAR;
    for (;;) {
        const bool has_next = S.next(ui + 1, nxt);
        if constexpr (MIDHOOK) { if (has_next) E.begin(nxt, wid); }
        const char* nB = has_next ? S.b_base(nxt) : cB; const char* nA = has_next ? S.a_ubase(nxt) : cA;
#pragma nounroll
        for (int t = 0; t < nt; t += 2) {
            const bool last = (t == nt - 2);
            if constexpr (MIDHOOK) { if (t == nt / 2) E.mid(acc, cur, wr, fr); }
            const char* a1 = cA + (size_t)(t + 1) * kstep;
            const char* a2 = last ? nA : cA + (size_t)(t + 2) * kstep; const char* b2 = last ? nB : cB + (size_t)(t + 2) * kstep;
            const char* a3 = a2 + kstep; const char* b3 = b2 + kstep;
            PG8_LDB(B0, 0, 0); PG8_LDB(B1, 0, 1); PG8_SCHED; PG8_LDA(At, 0, 0); PG8_STAGE(PG8_SA(1, 1), a1, oc[1]);
            if (last && has_next) S.a_off(nxt, Rr, Cc, oc);
            PG8_WAIT_V(8); PG8_WAIT_L(0); PG8_BAR; PG8_MMA(0, 0, At, B0); PG8_MMA(0, 1, At, B1); PG8_BAR; PG8_SCHED;
            PG8_LDA(At, 0, 1); PG8_STAGE(PG8_SB(0, 0), b2, voffB); PG8_STAGE(PG8_SB(0, 1), b2 + hstepB, voffB); PG8_STAGE(PG8_SA(0, 0), a2, oc[0]);
            PG8_WAIT_V(8); PG8_WAIT_L(0); PG8_BAR; PG8_MMA(1, 0, At, B0); PG8_MMA(1, 1, At, B1); PG8_BAR; PG8_SCHED;
            PG8_LDB(B0, 1, 0); PG8_LDB(B1, 1, 1); PG8_SCHED; PG8_LDA(At, 1, 0); PG8_STAGE(PG8_SA(0, 1), a2, oc[1]);
            PG8_WAIT_V(8); PG8_WAIT_L(0); PG8_BAR; PG8_MMA(0, 0, At, B0); PG8_MMA(0, 1, At, B1); PG8_BAR; PG8_SCHED;
            PG8_LDA(At, 1, 1); PG8_STAGE(PG8_SB(1, 0), b3, voffB); PG8_STAGE(PG8_SB(1, 1), b3 + hstepB, voffB); PG8_STAGE(PG8_SA(1, 0), a3, oc[0]);
            PG8_WAIT_V(8); PG8_WAIT_L(0); PG8_BAR; PG8_MMA(1, 0, At, B0); PG8_MMA(1, 1, At, B1); PG8_BAR; PG8_SCHED;
        }
        if constexpr (ALIGN_EPI) { if (wr == 0) PG8_BAR; }
        E(acc, cur, wr, wc, fr, fq);
        if (!has_next) break;
#pragma unroll
        for (int a = 0; a < 2; ++a)
#pragma unroll
            for (int b = 0; b < 2; ++b)
#pragma unroll
                for (int m = 0; m < 4; ++m)
#pragma unroll
                    for (int n = 0; n < 2; ++n) acc[a][b][m][n] = (f32x4){0.f, 0.f, 0.f, 0.f};
        cur = nxt; cB = nB; cA = nA; ++ui;
        if constexpr (ALIGN_EPI) { if (wr == 1) PG8_BAR; }
    }
    PG8_WAIT_V(0);
    if constexpr (!ALIGN_EPI) { if (wr == 0) PG8_BAR; }
    PG8_BAR;
#undef PG8_SA
#undef PG8_SB
#undef PG8_STAGE
#undef PG8_LDA
#undef PG8_LDB
#undef PG8_MMA
#undef PG8_WAIT_V
#undef PG8_WAIT_L
#undef PG8_BAR
#undef PG8_SCHED
}

struct EpiProjFused {
    static constexpr bool PERM = true;
    bf16_t* QM; bf16_t* KM; bf16_t* VM; bf16_t* QD; bf16_t* CKV; float* SSQ; f16_t* QI; f16_t* KI; float* WI;
    const float* cosH; const float* sinH; const float* cosI; const float* sinI;
    __device__ __forceinline__ void operator()(const f32x4 (&acc)[2][2][4][2], const Unit& u, int wr, int wc, int fr, int fq) const {
        typedef _Float16 f16x8v __attribute__((ext_vector_type(8)));
        const int pn = u.pn, rowb = u.pm * BM + wr * 64 + fr;
        if (pn < 8) {
            const int sec = pn >> 1; bf16_t* dstb = sec == 0 ? QM : sec == 1 ? KM : sec == 2 ? VM : QD;
            const bool rope = (sec != 2) && (wc == 0);
            const int i0 = 8 * (fq & 1);
#define EPF_LD(it_, A0, A1, A2, A3) do { const int s_ = (rowb + ((it_) >> 2) * HALF + ((it_) & 3) * 16) & 4095; \
                A0 = *(const f32x4*)(cosH + s_ * 16 + i0); A1 = *(const f32x4*)(cosH + s_ * 16 + i0 + 4); A2 = *(const f32x4*)(sinH + s_ * 16 + i0); A3 = *(const f32x4*)(sinH + s_ * 16 + i0 + 4); } while (0)
            if (rope) {
                f32x4 n0, n1, n2, n3; EPF_LD(0, n0, n1, n2, n3);
#pragma unroll
                for (int it = 0; it < 8; ++it) { const int ai = it >> 2, m = it & 3; const int row = rowb + ai * HALF + m * 16, b = row >> 12, s = row & 4095;
                    const f32x4 c0 = n0, c1 = n1, s0 = n2, s1 = n3;
                    if (it < 7) { EPF_LD(it + 1, n0, n1, n2, n3); __builtin_amdgcn_sched_barrier(0); }
#pragma unroll
                    for (int bj = 0; bj < 2; ++bj) { f32x4 v0 = acc[ai][bj][m][0], v1 = acc[ai][bj][m][1]; f32x4 y0, y1;
#pragma unroll
                        for (int j = 0; j < 4; ++j) { y0[j] = __shfl_xor(v0[j], 32); y1[j] = __shfl_xor(v1[j], 32); }
                        const float sg = fq < 2 ? -1.f : 1.f;
                        v0 = v0 * c0 + sg * (y0 * s0); v1 = v1 * c1 + sg * (y1 * s1);
                        u32x4 w; w.x = pk2(v0[0], v0[1]); w.y = pk2(v0[2], v0[3]); w.z = pk2(v1[0], v1[1]); w.w = pk2(v1[2], v1[3]);
                        const int h = 2 * (pn & 1) + bj;
                        *(u32x4*)(dstb + ((size_t)(b * 4 + h) * SEQ + s) * 128 + wc * 32 + 8 * fq) = w; } }
            } else {
#pragma unroll
                for (int it = 0; it < 8; ++it) { const int ai = it >> 2, m = it & 3; const int row = rowb + ai * HALF + m * 16, b = row >> 12, s = row & 4095;
#pragma unroll
                    for (int bj = 0; bj < 2; ++bj) { const f32x4 v0 = acc[ai][bj][m][0], v1 = acc[ai][bj][m][1];
                        u32x4 w; w.x = pk2(v0[0], v0[1]); w.y = pk2(v0[2], v0[3]); w.z = pk2(v1[0], v1[1]); w.w = pk2(v1[2], v1[3]);
                        const int h = 2 * (pn & 1) + bj;
                        *(u32x4*)(dstb + ((size_t)(b * 4 + h) * SEQ + s) * 128 + wc * 32 + 8 * fq) = w; } }
            }
#undef EPF_LD
        } else if (pn == 8) {
#pragma unroll
            for (int ai = 0; ai < 2; ++ai)
#pragma unroll
                for (int m = 0; m < 4; ++m) { const int row = rowb + ai * HALF + m * 16; float ss = 0.f;
#pragma unroll
                    for (int bj = 0; bj < 2; ++bj) { const f32x4 v0 = acc[ai][bj][m][0], v1 = acc[ai][bj][m][1];
                        ss += (v0[0] * v0[0] + v0[1] * v0[1]) + (v0[2] * v0[2] + v0[3] * v0[3]) + (v1[0] * v1[0] + v1[1] * v1[1]) + (v1[2] * v1[2] + v1[3] * v1[3]);
                        u32x4 w; w.x = pk2(v0[0], v0[1]); w.y = pk2(v0[2], v0[3]); w.z = pk2(v1[0], v1[1]); w.w = pk2(v1[2], v1[3]);
                        *(u32x4*)(CKV + (size_t)row * 256 + bj * HALF + wc * 32 + 8 * fq) = w; }
                    ss += __shfl_xor(ss, 16); ss += __shfl_xor(ss, 32);
                    if (fq == 0) SSQ[(size_t)row * 4 + wc] = ss; }
        } else if (pn < 11) {
            const bool rope = (wc & 1) == 0;
#pragma unroll
            for (int ai = 0; ai < 2; ++ai)
#pragma unroll
                for (int m = 0; m < 4; ++m) { const int row = rowb + ai * HALF + m * 16, s = row & 4095;
                    f32x4 c0 = {0.f, 0.f, 0.f, 0.f}, c1 = c0, s0 = c0, s1 = c0;
                    if (rope) { c0 = *(const f32x4*)(cosI + s * 8); c1 = *(const f32x4*)(cosI + s * 8 + 4); s0 = *(const f32x4*)(sinI + s * 8); s1 = *(const f32x4*)(sinI + s * 8 + 4); }
#pragma unroll
                    for (int bj = 0; bj < 2; ++bj) { f32x4 v0 = acc[ai][bj][m][0], v1 = acc[ai][bj][m][1];
                        if (rope) { f32x4 y0, y1;
#pragma unroll
                            for (int j = 0; j < 4; ++j) { y0[j] = __shfl_xor(v0[j], 16); y1[j] = __shfl_xor(v1[j], 16); }
                            if (fq < 2) { const float sg = fq == 0 ? -1.f : 1.f; v0 = v0 * c0 + sg * (y0 * s0); v1 = v1 * c1 + sg * (y1 * s1); } }
                        f16x8v o; o[0] = (f16_t)v0[0]; o[1] = (f16_t)v0[1]; o[2] = (f16_t)v0[2]; o[3] = (f16_t)v0[3]; o[4] = (f16_t)v1[0]; o[5] = (f16_t)v1[1]; o[6] = (f16_t)v1[2]; o[7] = (f16_t)v1[3];
                        *(f16x8v*)(QI + (size_t)row * 512 + (pn - 9) * 256 + bj * HALF + wc * 32 + 8 * fq) = o; } }
        } else {
            if (wc < 2) {
#pragma unroll
                for (int ai = 0; ai < 2; ++ai)
#pragma unroll
                    for (int m = 0; m < 4; ++m) { const int row = rowb + ai * HALF + m * 16, s = row & 4095;
                        f32x4 v0 = acc[ai][0][m][0], v1 = acc[ai][0][m][1];
                        if (wc == 0) { f32x4 y0, y1;
#pragma unroll
                            for (int j = 0; j < 4; ++j) { y0[j] = __shfl_xor(v0[j], 16); y1[j] = __shfl_xor(v1[j], 16); }
                            if (fq < 2) { const f32x4 c0 = *(const f32x4*)(cosI + s * 8), c1 = *(const f32x4*)(cosI + s * 8 + 4), s0 = *(const f32x4*)(sinI + s * 8), s1 = *(const f32x4*)(sinI + s * 8 + 4);
                                const float sg = fq == 0 ? -1.f : 1.f; v0 = v0 * c0 + sg * (y0 * s0); v1 = v1 * c1 + sg * (y1 * s1); } }
                        f16x8v o; o[0] = (f16_t)v0[0]; o[1] = (f16_t)v0[1]; o[2] = (f16_t)v0[2]; o[3] = (f16_t)v0[3]; o[4] = (f16_t)v1[0]; o[5] = (f16_t)v1[1]; o[6] = (f16_t)v1[2]; o[7] = (f16_t)v1[3];
                        *(f16x8v*)(KI + (size_t)(row >> 5) * 2048 + (wc * 4 + fq) * 256 + (row & 31) * 8) = o; }
            } else if (wc == 2 && fq == 0) {
#pragma unroll
                for (int ai = 0; ai < 2; ++ai)
#pragma unroll
                    for (int m = 0; m < 4; ++m) { const int row = rowb + ai * HALF + m * 16; const float k = 0.35355339059327373f;
                        *(f32x4*)(WI + (size_t)row * 8) = acc[ai][0][m][0] * k; *(f32x4*)(WI + (size_t)row * 8 + 4) = acc[ai][0][m][1] * k; }
            }
        }
    }
};
struct EpiKV {
    static constexpr bool PERM = true;
    bf16_t* KD; bf16_t* VD; const float* SSQ; const float* cosH; const float* sinH;
    __device__ __forceinline__ void operator()(const f32x4 (&acc)[2][2][4][2], const Unit& u, int wr, int wc, int fr, int fq) const {
        const int rowb = u.pm * BM + wr * 64 + fr;
        float rs[8];
        { f32x4 q[8];
#pragma unroll
          for (int it = 0; it < 8; ++it) q[it] = *(const f32x4*)(SSQ + (size_t)(rowb + (it >> 2) * HALF + (it & 3) * 16) * 4);
#pragma unroll
          for (int it = 0; it < 8; ++it) rs[it] = 1.f / sqrtf(((q[it][0] + q[it][1]) + (q[it][2] + q[it][3])) * (1.f / 256.f) + EPS); }
        const int i0 = 8 * (fq & 1);
#define EKV_LD(it_, A0, A1, A2, A3) do { const int s_ = (rowb + ((it_) >> 2) * HALF + ((it_) & 3) * 16) & 4095; \
            A0 = *(const f32x4*)(cosH + s_ * 16 + i0); A1 = *(const f32x4*)(cosH + s_ * 16 + i0 + 4); A2 = *(const f32x4*)(sinH + s_ * 16 + i0); A3 = *(const f32x4*)(sinH + s_ * 16 + i0 + 4); } while (0)
#define EKV_ST(v0_, v1_) do { u32x4 w; w.x = pk2(v0_[0], v0_[1]); w.y = pk2(v0_[2], v0_[3]); w.z = pk2(v1_[0], v1_[1]); w.w = pk2(v1_[2], v1_[3]); \
            *(u32x4*)(KD + (size_t)row * 128 + wc * 32 + 8 * fq) = w; \
            const f32x4 u0 = acc[ai][1][m][0] * rstd, u1 = acc[ai][1][m][1] * rstd; \
            u32x4 x; x.x = pk2(u0[0], u0[1]); x.y = pk2(u0[2], u0[3]); x.z = pk2(u1[0], u1[1]); x.w = pk2(u1[2], u1[3]); \
            *(u32x4*)(VD + (size_t)row * 128 + wc * 32 + 8 * fq) = x; } while (0)
        if (wc == 0) {
            f32x4 n0, n1, n2, n3; EKV_LD(0, n0, n1, n2, n3);
#pragma unroll
            for (int it = 0; it < 8; ++it) { const int ai = it >> 2, m = it & 3; const int row = rowb + ai * HALF + m * 16; const float rstd = rs[it];
                const f32x4 c0 = n0, c1 = n1, s0 = n2, s1 = n3;
                if (it < 7) { EKV_LD(it + 1, n0, n1, n2, n3); __builtin_amdgcn_sched_barrier(0); }
                f32x4 v0 = acc[ai][0][m][0] * rstd, v1 = acc[ai][0][m][1] * rstd; f32x4 y0, y1;
#pragma unroll
                for (int j = 0; j < 4; ++j) { y0[j] = __shfl_xor(v0[j], 32); y1[j] = __shfl_xor(v1[j], 32); }
                const float sg = fq < 2 ? -1.f : 1.f; v0 = v0 * c0 + sg * (y0 * s0); v1 = v1 * c1 + sg * (y1 * s1);
                EKV_ST(v0, v1); }
        } else {
#pragma unroll
            for (int it = 0; it < 8; ++it) { const int ai = it >> 2, m = it & 3; const int row = rowb + ai * HALF + m * 16; const float rstd = rs[it];
                const f32x4 v0 = acc[ai][0][m][0] * rstd, v1 = acc[ai][0][m][1] * rstd;
                EKV_ST(v0, v1); }
        }
#undef EKV_LD
#undef EKV_ST
    }
};
struct EpiF32 {
    static constexpr bool PERM = true;
    float* O; int ldc;
    __device__ __forceinline__ void operator()(const f32x4 (&acc)[2][2][4][2], const Unit& u, int wr, int wc, int fr, int fq) const {
        const int row0 = u.pm * BM + wr * 64 + fr, col0 = u.pn * BM + wc * 32 + 8 * fq;
#pragma unroll
        for (int ai = 0; ai < 2; ++ai)
#pragma unroll
            for (int m = 0; m < 4; ++m) { float* rowp = O + (size_t)(row0 + ai * HALF + m * 16) * ldc + col0;
#pragma unroll
                for (int bj = 0; bj < 2; ++bj) { *(f32x4*)(rowp + bj * HALF) = acc[ai][bj][m][0]; *(f32x4*)(rowp + bj * HALF + 4) = acc[ai][bj][m][1]; } }
    }
};

struct EpiResidNorm {
    static constexpr bool PERM = true;
    const float* X; bf16_t* O; const float* mod; const float* SSQO; LAS float* tab;
    __device__ __forceinline__ void begin(const Unit& u, int wid) const {
        const int tid = wid * 64 + lane_opaque();
        if (tid < BM) { const float* p = SSQO + (size_t)(u.pm * BM + tid) * 8; const f32x4 a = *(const f32x4*)p, b = *(const f32x4*)(p + 4);
            const float rm = 1.f / sqrtf(((a[0] + a[1]) + (a[2] + a[3])) * (1.f / 512.f) + EPS), rd = 1.f / sqrtf(((b[0] + b[1]) + (b[2] + b[3])) * (1.f / 512.f) + EPS);
            *(LAS f32x2*)(tab + (u.slot % 3) * 512 + tid * 2) = (f32x2){rm / rd, rd}; }
    }
    __device__ __forceinline__ void mid(f32x4 (&acc)[2][2][4][2], const Unit& u, int wr, int fr) const {
        const LAS float* t = tab + (u.slot % 3) * 512 + (wr * 64 + fr) * 2;
#pragma unroll
        for (int ai = 0; ai < 2; ++ai)
#pragma unroll
            for (int m = 0; m < 4; ++m) { const float q = t[(ai * HALF + m * 16) * 2];
#pragma unroll
                for (int bj = 0; bj < 2; ++bj) { acc[ai][bj][m][0] = acc[ai][bj][m][0] * q; acc[ai][bj][m][1] = acc[ai][bj][m][1] * q; } }
    }
    __device__ __forceinline__ void operator()(const f32x4 (&acc)[2][2][4][2], const Unit& u, int wr, int wc, int fr, int fq) const {
        const int row0 = u.pm * BM + wr * 64 + fr, col0 = u.pn * BM + wc * 32 + 8 * fq;
        const float* g = mod + (size_t)((u.pm * BM) >> 12) * 6144 + 2048 + col0;
        const LAS float* t = tab + (u.slot % 3) * 512 + (wr * 64 + fr) * 2 + 1;
        f32x4 gg[2][2];
#pragma unroll
        for (int bj = 0; bj < 2; ++bj) { gg[bj][0] = *(const f32x4*)(g + bj * HALF); gg[bj][1] = *(const f32x4*)(g + bj * HALF + 4); }
#pragma unroll
        for (int ai = 0; ai < 2; ++ai)
#pragma unroll
            for (int m = 0; m < 4; ++m) { const float rd = t[(ai * HALF + m * 16) * 2];
                f32x4 xx[2][2];
#pragma unroll
                for (int bj = 0; bj < 2; ++bj) { const size_t o = (size_t)(row0 + ai * HALF + m * 16) * DM + col0 + bj * HALF; xx[bj][0] = *(const f32x4*)(X + o); xx[bj][1] = *(const f32x4*)(X + o + 4); }
#pragma unroll
                for (int bj = 0; bj < 2; ++bj) { const size_t o = (size_t)(row0 + ai * HALF + m * 16) * DM + col0 + bj * HALF;
                    const f32x4 r0 = xx[bj][0] + gg[bj][0] * rd * acc[ai][bj][m][0], r1 = xx[bj][1] + gg[bj][1] * rd * acc[ai][bj][m][1];
                    u32x4 w; w.x = pk2(r0[0], r0[1]); w.y = pk2(r0[2], r0[3]); w.z = pk2(r1[0], r1[1]); w.w = pk2(r1[2], r1[3]);
                    *(u32x4*)(O + o) = w; } }
    }
};
struct MoeTab { const LAS int* cnt; const LAS int* tstart; };
constexpr int UT_MAX = 32;
__device__ __forceinline__ int moe_find(const MoeTab& tb, int rt) {
    int lo = 0, hi = NEX;
    while (hi - lo > 1) { const int mid = (lo + hi) >> 1; if (tb.tstart[mid] <= rt) lo = mid; else hi = mid; }
    return lo;
}
struct MoeUpSched {
    MoeTab tb; const char* H2; const LAS int* tokl; const char* WGU; unsigned ldb; int total, G, c; const LAS int* utab;
    __device__ __forceinline__ bool next(int i, Unit& u) const {
        if (i < UT_MAX) { const u32x4 v = *(const LAS u32x4*)(utab + 4 * i); if ((int)v.x < 0) return false; u.e = (int)v.x; u.rt = (int)v.y; u.pn = (int)v.z & 0xff; u.pm = (int)v.w; u.slot = i | (((int)v.z >> 8) << 16); return true; }
        return compute(i, u);
    }
    __device__ __forceinline__ bool compute(int i, Unit& u) const {
        if (G == 256) { const int xcd = c & 7, k = c >> 3; u.rt = i * 128 + xcd * 16 + (k >> 1); u.pn = k & 1; if (u.rt * 2 >= total) return false; }
        else { const int L = i * G + c; if (L >= total) return false; u.rt = L >> 1; u.pn = L & 1; }
        u.e = moe_find(tb, u.rt); u.pm = u.rt - tb.tstart[u.e]; u.slot = i | (256 << 16); return true;
    }
    __device__ __forceinline__ const char* a_ubase(const Unit&) const { return H2; }
    __device__ __forceinline__ void a_off(const Unit& u, const int (&R)[2], const int (&C)[2], unsigned (&o)[2][2]) const {
#pragma unroll
        for (int h = 0; h < 2; ++h)
#pragma unroll
            for (int i = 0; i < 2; ++i) o[h][i] = (unsigned)(tokl[(u.slot & 0xffff) * BM + h * HALF + R[i]] & 0x7fff) * 4096u + (unsigned)C[i] * 2u;
    }
    __device__ __forceinline__ const char* b_base(const Unit& u) const { return WGU + ((size_t)u.e * 512 + (size_t)u.pn * 256) * 2048; }
};
struct EpiAct {
    static constexpr bool PERM = true;
    bf16_t* ACT; const LAS int* tokl;
    __device__ __forceinline__ void operator()(const f32x4 (&acc)[2][2][4][2], const Unit& u, int wr, int wc, int fr, int fq) const {
        const int row0 = u.rt * BM + wr * 64 + fr, col0 = u.pn * 128 + wc * 32 + 8 * fq;
#pragma unroll
        for (int ai = 0; ai < 2; ++ai)
#pragma unroll
            for (int m = 0; m < 4; ++m) { float a[8];
                const unsigned tw = (unsigned)tokl[(u.slot & 0xffff) * BM + ai * HALF + wr * 64 + m * 16 + fr];
                const float gw = (float)__builtin_bit_cast(f16_t, (unsigned short)(tw >> 16));
#pragma unroll
                for (int n = 0; n < 2; ++n)
#pragma unroll
                    for (int j = 0; j < 4; ++j) { const float gt = acc[ai][0][m][n][j], up = acc[ai][1][m][n][j]; a[n * 4 + j] = gt * __builtin_amdgcn_rcpf(1.f + __expf(-gt)) * up * gw; }
                u32x4 w; w.x = pk2(a[0], a[1]); w.y = pk2(a[2], a[3]); w.z = pk2(a[4], a[5]); w.w = pk2(a[6], a[7]);
                if (ai * HALF + wr * 64 + m * 16 + fr < (u.slot >> 16)) *(u32x4*)(ACT + (size_t)(row0 + ai * HALF + m * 16) * 256 + col0) = w; }
    }
};
struct MoeDownSched {
    MoeTab tb; const char* ACT; const char* WD; unsigned ldb; int total, G, c; const LAS int* utab;
    __device__ __forceinline__ bool next(int i, Unit& u) const {
        if (i < UT_MAX) { const u32x4 v = *(const LAS u32x4*)(utab + 4 * i); if ((int)v.x < 0) return false; u.e = (int)v.x; u.rt = (int)v.y; u.pn = (int)v.z & 0xff; u.pm = (int)v.w; u.slot = i | (((int)v.z >> 8) << 16); return true; }
        return compute(i, u);
    }
    __device__ __forceinline__ bool compute(int i, Unit& u) const {
        if (G == 256) { const int xcd = c & 7, k = c >> 3; u.rt = i * 64 + xcd * 8 + (k >> 2); u.pn = k & 3; if (u.rt * 4 >= total) return false; }
        else { const int L = i * G + c; if (L >= total) return false; u.rt = L >> 2; u.pn = L & 3; }
        u.e = moe_find(tb, u.rt); u.pm = u.rt - tb.tstart[u.e]; u.slot = i | (256 << 16); return true;
    }
    __device__ __forceinline__ const char* a_ubase(const Unit& u) const { return ACT + (size_t)u.rt * BM * 512; }
    __device__ __forceinline__ void a_off(const Unit& u, const int (&R)[2], const int (&C)[2], unsigned (&o)[2][2]) const {
#pragma unroll
        for (int h = 0; h < 2; ++h)
#pragma unroll
            for (int i = 0; i < 2; ++i) o[h][i] = (unsigned)(h * HALF + R[i]) * 512u + (unsigned)C[i] * 2u;
    }
    __device__ __forceinline__ const char* b_base(const Unit& u) const { return WD + ((size_t)u.e * 1024 + (size_t)u.pn * 256) * 512; }
};
struct EpiDown {
    static constexpr bool PERM = true;
    bf16_t* CA; bf16_t* SH;
    __device__ __forceinline__ void operator()(const f32x4 (&acc)[2][2][4][2], const Unit& u, int wr, int wc, int fr, int fq) const {
        const int col0 = u.pn * BM + wc * 32 + 8 * fq;
        {
            const bool shd = u.e == NE; const float fsc = shd ? 4.f : 16.f;
            unsigned char* base = (shd ? (unsigned char*)SH + ((size_t)u.pm * BM + wr * 64 + fr) * DM : (unsigned char*)CA + ((size_t)u.rt * BM + wr * 64 + fr) * DM) + (col0 - 8 * (fq & 1));
#pragma unroll
            for (int ai = 0; ai < 2; ++ai)
#pragma unroll
                for (int mp = 0; mp < 4; mp += 2)
#pragma unroll
                    for (int bj = 0; bj < 2; ++bj) { unsigned wx[2], wy[2];
#pragma unroll
                        for (int q = 0; q < 2; ++q) { f32x4 v0 = acc[ai][bj][mp + q][0] * fsc, v1 = acc[ai][bj][mp + q][1] * fsc;
#pragma unroll
                            for (int j2 = 0; j2 < 4; ++j2) { v0[j2] = __builtin_amdgcn_fmed3f(v0[j2], -448.f, 448.f); v1[j2] = __builtin_amdgcn_fmed3f(v1[j2], -448.f, 448.f); }
                            int t = 0;
                            t = __builtin_amdgcn_cvt_pk_fp8_f32(v0[0], v0[1], t, false); t = __builtin_amdgcn_cvt_pk_fp8_f32(v0[2], v0[3], t, true); wx[q] = (unsigned)t;
                            t = __builtin_amdgcn_cvt_pk_fp8_f32(v1[0], v1[1], t, false); t = __builtin_amdgcn_cvt_pk_fp8_f32(v1[2], v1[3], t, true); wy[q] = (unsigned)t; }
                        const auto sx = __builtin_amdgcn_permlane16_swap(wx[0], wx[1], false, false), sy = __builtin_amdgcn_permlane16_swap(wy[0], wy[1], false, false);
                        u32x4 w; w.x = sx[0]; w.y = sy[0]; w.z = sx[1]; w.w = sy[1];
                        if (ai * HALF + wr * 64 + (mp + (fq & 1)) * 16 + fr < (u.slot >> 16)) *(u32x4*)(base + (size_t)(ai * HALF + (mp + (fq & 1)) * 16) * DM + bj * HALF) = w; }
        }
    }
};
}

__constant__ float c_invH[16] = {1.000000000e+00f, 4.403665960e-01f, 1.939227432e-01f, 8.539710194e-02f, 3.760603070e-02f, 1.656044088e-02f, 7.292664610e-03f, 3.211446106e-03f,
                                 1.414213562e-03f, 6.227724371e-04f, 2.742481884e-04f, 1.207697351e-04f, 5.318295734e-05f, 2.341999971e-05f, 1.031338525e-05f, 4.541670478e-06f};
__constant__ float c_invI[8] = {1.000000000e+00f, 1.939227432e-01f, 3.760603070e-02f, 7.292664610e-03f, 1.414213562e-03f, 2.742481884e-04f, 5.318295734e-05f, 1.031338525e-05f};

struct TrJob { const float* W; int ldn, nvalid; bf16_t* WT; int dld, dcol, rmode, rbase, vmode, k0, n0; const float* kgain; };
template <bool CHECK = true>
__device__ __forceinline__ void tr_load(const TrJob& J, int lane, f32x4 (&v)[8]) {
    const int n4 = (lane & 7) * 4; const bool ok = !CHECK || J.n0 + n4 < J.nvalid;
#pragma unroll
    for (int i = 0; i < 8; ++i) { const int kk = 8 * i + (lane >> 3); v[i] = ok ? *(const f32x4*)(J.W + (size_t)(J.k0 + kk) * J.ldn + J.n0 + n4) : (f32x4){0.f, 0.f, 0.f, 0.f}; }
}
__device__ __forceinline__ void tr_finish(const TrJob& J, int lane, const f32x4 (&v)[8], LAS float* scr) {
    const int n4 = (lane & 7) * 4;
    float kg[8];
    { const float* kp = (J.kgain ? J.kgain + J.k0 : c_invH) + 8 * (lane & 7) * (J.kgain ? 1 : 0);
#pragma unroll
      for (int q = 0; q < 8; ++q) kg[q] = kp[q];
      if (!J.kgain) {
#pragma unroll
          for (int q = 0; q < 8; ++q) kg[q] = 1.f; } }
#pragma unroll
    for (int i = 0; i < 8; ++i) { const int kk = 8 * i + (lane >> 3); LAS float* d = scr + kk * 33 + n4; d[0] = v[i][0]; d[1] = v[i][1]; d[2] = v[i][2]; d[3] = v[i][3]; }
    LDS_WAIT(); asm volatile("" ::: "memory");
    const int c = lane & 7;
#pragma unroll
    for (int j = 0; j < 4; ++j) { const int n = (lane >> 3) + 8 * j; const LAS float* s = scr + (8 * c) * 33 + n;
        float x[8];
#pragma unroll
        for (int q = 0; q < 8; ++q) { x[q] = s[q * 33] * kg[q]; if (J.vmode == 2) x[q] = x[q] - bf2f(f2bf(x[q])); }
        u32x4 o; o.x = pk2(x[0], x[1]); o.y = pk2(x[2], x[3]); o.z = pk2(x[4], x[5]); o.w = pk2(x[6], x[7]);
        const int ng = J.n0 + n; const int drow = J.rmode ? ((ng >> 7) * 256 + (ng & 127) + J.rbase) : (J.rbase + ng);
        *(u32x4*)(J.WT + (size_t)drow * J.dld + J.dcol + J.k0 + 8 * c) = o; }
    LDS_WAIT(); asm volatile("" ::: "memory");
}
__device__ __forceinline__ void tr_item(const float* W, int ldn, int nvalid, bf16_t* WT, int dld, int dcol, int rmode, int rbase, int vmode, int k0, int n0, LAS float* scr, int lane, const float* kgain = nullptr) {
    const TrJob J{W, ldn, nvalid, WT, dld, dcol, rmode, rbase, vmode, k0, n0, kgain}; f32x4 v[8]; tr_load(J, lane, v); tr_finish(J, lane, v, scr);
}

__device__ __forceinline__ void phase0(const Args& A, unsigned char* lds_, const int wave) {
    LAS unsigned char* lds = (LAS unsigned char*)lds_;
    const int lane = lane_opaque(), tid = wave * 64 + lane, G = gridDim.x;
    unsigned char* ws = A.ws;
    {
        LAS float* cact = (LAS float*)lds;
        LAS float* part = cact + 8192;
        const float* c = A.in[1]; const float* w_ada = A.in[2]; const float* b_ada = A.in[3]; float* mod = (float*)(ws + WS_MOD);
        for (int i = tid; i < 8192; i += NTHR) { const float v = c[i]; cact[i] = v / (1.f + expf(-v)); }
        __syncthreads();
        for (int chunk = blockIdx.x; chunk < 256; chunk += G) {
            const int n0 = chunk * 24, j = tid % 24, q = tid / 24;
            float a0 = 0.f, a1 = 0.f, a2 = 0.f, a3 = 0.f, a4 = 0.f, a5 = 0.f, a6 = 0.f, a7 = 0.f;
            if (tid < 504) {
                float wv[49];
#pragma unroll
                for (int i = 0; i < 49; ++i) { const int k = q + 21 * i; wv[i] = k < 1024 ? w_ada[(size_t)k * 6144 + n0 + j] : 0.f; }
#pragma unroll
                for (int i = 0; i < 49; ++i) { const int k = q + 21 * i < 1024 ? q + 21 * i : 1023; const float w = wv[i];
                    a0 += cact[k] * w; a1 += cact[1024 + k] * w; a2 += cact[2048 + k] * w; a3 += cact[3072 + k] * w;
                    a4 += cact[4096 + k] * w; a5 += cact[5120 + k] * w; a6 += cact[6144 + k] * w; a7 += cact[7168 + k] * w; } }
            if (tid < 504) { LAS float* p = part + (q * 8) * 24 + j; p[0] = a0; p[24] = a1; p[48] = a2; p[72] = a3; p[96] = a4; p[120] = a5; p[144] = a6; p[168] = a7; }
            __syncthreads();
            if (tid < 192) { const int b = tid / 24, jj = tid % 24; float s = b_ada[n0 + jj];
                for (int qq = 0; qq < 21; ++qq) s += part[(qq * 8 + b) * 24 + jj];
                mod[b * 6144 + n0 + jj] = s; }
            __syncthreads();
        }
    }
    {
        float* cosH = (float*)(ws + WS_COSH); float* sinH = (float*)(ws + WS_SINH); float* cosI = (float*)(ws + WS_COSI); float* sinI = (float*)(ws + WS_SINI);
        for (int i = blockIdx.x * NTHR + tid; i < SEQ * 24; i += G * NTHR) {
            int pos, f; float inv; bool isH = i < SEQ * 16;
            if (isH) { pos = i >> 4; f = i & 15; inv = c_invH[f]; } else { const int k = i - SEQ * 16; pos = k >> 3; f = k & 7; inv = c_invI[f]; }
            const float ang = (float)pos * inv;
            double t = (double)ang * 0.15915494309189533577; t -= rint(t);
            const float rev = (float)t;
            const float cs = __builtin_amdgcn_cosf(rev), sn = __builtin_amdgcn_sinf(rev);
            if (isH) { cosH[i] = cs; sinH[i] = sn; } else { cosI[i - SEQ * 16] = cs; sinI[i - SEQ * 16] = sn; }
        }
    }
    {
        LAS float* scr = (LAS float*)(lds + 65536 + wave * 8448);
        const int gw = blockIdx.x * NWAVES + wave, NGW = G * NWAVES;
        bf16_t* WIN = (bf16_t*)(ws + WS_WIN); bf16_t* WOUT = (bf16_t*)(ws + WS_WOUT); bf16_t* WR = (bf16_t*)(ws + WS_WR); bf16_t* WKV = (bf16_t*)(ws + WS_WKV);
        constexpr int I_IN = 16 * 96, I_KV = 4 * 8, I_OUT = 16 * 32, I_R = 16 * 8;
        constexpr int NITEMS = I_IN + I_KV + I_OUT + 3 * I_R;
        for (int it = gw; it < NITEMS; it += NGW) {
            int r = it;
            if (r < I_IN) { tr_item(A.in[5], NPROJ, NPROJ, WIN, 1024, 0, 0, 0, 0, 64 * (r / 96), 32 * (r % 96), scr, lane); continue; } r -= I_IN;
            if (r < I_KV) { tr_item(A.in[7], 256, 256, WKV, 256, 0, 0, 0, 0, 64 * (r / 8), 32 * (r % 8), scr, lane, A.in[6]); continue; } r -= I_KV;
            if (r < I_OUT) { const int k0_ = 64 * (r / 32); tr_item(A.in[10], 1024, 1024, WOUT, 1024, 0, 0, 0, 0, k0_, 32 * (r % 32), scr, lane, k0_ < 512 ? A.in[8] : A.in[9] - 512); continue; } r -= I_OUT;
            if (r < I_R) { tr_item(A.in[12], 256, 256, WR, 2048, 0, 0, 0, 1, 64 * (r / 8), 32 * (r % 8), scr, lane); continue; } r -= I_R;
            if (r < I_R) { tr_item(A.in[12], 256, 256, WR, 2048, 1024, 0, 0, 1, 64 * (r / 8), 32 * (r % 8), scr, lane); continue; } r -= I_R;
            tr_item(A.in[12], 256, 256, WR, 2048, 0, 0, 256, 2, 64 * (r / 8), 32 * (r % 8), scr, lane);
        }
        for (int i = blockIdx.x * NTHR + tid; i < 256 * 128; i += G * NTHR) { const int rr = 256 + (i >> 7), cc = 1024 + (i & 127) * 8; *(u32x4*)(WR + (size_t)rr * 2048 + cc) = (u32x4){0u, 0u, 0u, 0u}; }
    }
}


__device__ __forceinline__ void convert_experts(const Args& A, unsigned char* lds_, const int wave) {
    LAS unsigned char* lds = (LAS unsigned char*)lds_;
    const int lane = lane_opaque();
    unsigned char* ws = A.ws;
    LAS float* scr = (LAS float*)(lds + wave * 8448);
    const int gw = blockIdx.x * NWAVES + wave, NGW = gridDim.x * NWAVES;
    bf16_t* WD = (bf16_t*)(ws + WS_WD); bf16_t* WGU = (bf16_t*)(ws + WS_WGU);
    struct XJob { const char* src; char* dst; unsigned ldnB, dldB; };
    auto job = [&](int r) -> XJob {
        const int e = r / 384, q = r % 384; const bool sh_ = (e == NE);
        if (q < 256) { const int q2 = q & 127, k0 = 64 * (q2 >> 3), n0 = 32 * (q2 & 7), up = q >> 7;
            const float* w = up ? (!sh_ ? A.in[15] + (size_t)e * 1024 * 256 : A.in[18]) : (!sh_ ? A.in[14] + (size_t)e * 1024 * 256 : A.in[17]);
            const int drow0 = (n0 >> 7) * 256 + (n0 & 127) + 128 * up;
            return XJob{(const char*)(w + (size_t)k0 * 256 + n0), (char*)(WGU + (size_t)e * 512 * 1024 + (size_t)drow0 * 1024 + k0), 256u * 4u, 1024u * 2u}; }
        const int q3 = q - 256, k0 = 64 * (q3 >> 5), n0 = 32 * (q3 & 31);
        const float* w = !sh_ ? A.in[16] + (size_t)e * 256 * 1024 : A.in[19];
        return XJob{(const char*)(w + (size_t)k0 * 1024 + n0), (char*)(WD + (size_t)e * 1024 * 256 + (size_t)n0 * 256 + k0), 1024u * 4u, 256u * 2u};
    };
    auto xload = [&](const XJob& J, f32x4 (&v)[8]) {
        const unsigned vo = (unsigned)(lane >> 3) * J.ldnB + (unsigned)(lane & 7) * 16u;
#pragma unroll
        for (int i = 0; i < 8; ++i) v[i] = *(const f32x4*)(J.src + (size_t)(8 * i) * J.ldnB + vo);
    };
    auto xfinish = [&](const XJob& J, const f32x4 (&v)[8]) {
        const int n4 = (lane & 7) * 4;
#pragma unroll
        for (int i = 0; i < 8; ++i) { const int kk = 8 * i + (lane >> 3); LAS float* d = scr + kk * 33 + n4; d[0] = v[i][0]; d[1] = v[i][1]; d[2] = v[i][2]; d[3] = v[i][3]; }
        LDS_WAIT(); asm volatile("" ::: "memory");
        const int c = lane & 7; const unsigned vo2 = (unsigned)(lane >> 3) * J.dldB + (unsigned)c * 16u;
#pragma unroll
        for (int jx = 0; jx < 4; ++jx) { const int n = (lane >> 3) + 8 * jx; const LAS float* sp = scr + (8 * c) * 33 + n;
            float x[8];
#pragma unroll
            for (int q = 0; q < 8; ++q) x[q] = sp[q * 33];
            u32x4 o; o.x = pk2(x[0], x[1]); o.y = pk2(x[2], x[3]); o.z = pk2(x[4], x[5]); o.w = pk2(x[6], x[7]);
            *(u32x4*)(J.dst + (size_t)(8 * jx) * J.dldB + vo2) = o; }
        LDS_WAIT(); asm volatile("" ::: "memory");
    };
    constexpr int NIT = 384 * NEX;
    int r = gw;
    if (r >= NIT) return;
    f32x4 va[8], vb[8], vc[8], vd[8];
#define CE_LD(dst, rr) do { const int r_ = (rr) < NIT ? (rr) : last; const XJob J_ = job(r_); xload(J_, dst); __builtin_amdgcn_fence(__ATOMIC_RELEASE, "wavefront"); } while (0)
#define CE_FIN(src, rr) do { if ((rr) < NIT) { const XJob J_ = job(rr); xfinish(J_, src); } } while (0)
    const int last = gw + ((NIT - 1 - gw) / NGW) * NGW;
    CE_LD(va, r); CE_LD(vb, r + NGW); CE_LD(vc, r + 2 * NGW);
    for (; r < NIT; r += 4 * NGW) {
        CE_LD(vd, r + 3 * NGW); CE_FIN(va, r);
        CE_LD(va, r + 4 * NGW); CE_FIN(vb, r + NGW);
        CE_LD(vb, r + 5 * NGW); CE_FIN(vc, r + 2 * NGW);
        CE_LD(vc, r + 6 * NGW); CE_FIN(vd, r + 3 * NGW);
    }
#undef CE_LD
#undef CE_FIN
}

template <bool BF16IN = false>
__device__ __forceinline__ void modnorm_row(const void* xrow_, const float* gain, const float* shift, const float* scale, int lane, f32x4 (&v)[4]) {
    float s = 0.f;
#pragma unroll
    for (int j = 0; j < 4; ++j) {
        if constexpr (BF16IN) { const u32x2 w = *((const u32x2*)xrow_ + lane + 64 * j); v[j] = (f32x4){bflo(w.x), bfhi(w.x), bflo(w.y), bfhi(w.y)}; }
        else v[j] = *((const f32x4*)xrow_ + lane + 64 * j);
        s += (v[j].x * v[j].x + v[j].y * v[j].y) + (v[j].z * v[j].z + v[j].w * v[j].w); }
    const float rstd = 1.f / sqrtf(wave_sum_dpp(s) * (1.f / DM) + EPS);
#pragma unroll
    for (int j = 0; j < 4; ++j) { const f32x4 g = *((const f32x4*)gain + lane + 64 * j), sh = *((const f32x4*)shift + lane + 64 * j), sc = *((const f32x4*)scale + lane + 64 * j);
        v[j] = (v[j] * rstd * g) * (sc + 1.f) + sh; }
}
__device__ __forceinline__ void phase1(const Args& A, const int wave) {
    const int lane = lane_opaque();
    const int gw = blockIdx.x * NWAVES + wave, NGW = gridDim.x * NWAVES;
    const float* x = A.in[0]; const float* mod = (const float*)(A.ws + WS_MOD); bf16_t* H = (bf16_t*)(A.ws + WS_H);
    for (int row = gw; row < T; row += NGW) {
        const float* mb = mod + (size_t)(row >> 12) * 6144; f32x4 v[4];
        modnorm_row(x + (size_t)row * DM, A.in[4], mb, mb + 1024, lane, v);
#pragma unroll
        for (int j = 0; j < 4; ++j) { u32x2 o; o.x = pk2(v[j].x, v[j].y); o.y = pk2(v[j].z, v[j].w); *((u32x2*)(H + (size_t)row * DM) + lane + 64 * j) = o; }
    }
}

__device__ __forceinline__ void kmean_units(const Args& A, unsigned char* lds_, const int wave, int u0, int ustep) {
    const int lane = lane_opaque(), tid = wave * 64 + lane;
    const bf16_t* KM = (const bf16_t*)(A.ws + WS_KM); float* KMEAN = (float*)(A.ws + WS_KMEAN);
    LAS float* part = (LAS float*)lds_;
    constexpr int NU = NB * 4 * 16;
    const int r4 = lane >> 4, c8 = (lane & 15) * 8;
#define KMU_LD(u_, v_) do { const bf16_t* base_ = KM + ((size_t)((u_) >> 4) * SEQ + ((u_) & 15) * 256 + wave * 32 + r4) * 128 + c8; \
        _Pragma("unroll") for (int j = 0; j < 8; ++j) v_[j] = *(const u32x4*)(base_ + (size_t)(4 * j) * 128); } while (0)
    u32x4 cur[8], nxt[8];
    if (u0 < NU) KMU_LD(u0, cur);
    for (int u = u0; u < NU; u += ustep) {
        const int un = u + ustep < NU ? u + ustep : u;
        KMU_LD(un, nxt);
        float a[8];
#pragma unroll
        for (int q = 0; q < 8; ++q) a[q] = 0.f;
#pragma unroll
        for (int j = 0; j < 8; ++j)
#pragma unroll
            for (int d = 0; d < 4; ++d) { a[2 * d] += bflo(cur[j][d]); a[2 * d + 1] += bfhi(cur[j][d]); }
#pragma unroll
        for (int q = 0; q < 8; ++q) { a[q] += __shfl_xor(a[q], 16); a[q] += __shfl_xor(a[q], 32); }
        if (lane < 16) { *(LAS f32x4*)(part + wave * 128 + c8) = (f32x4){a[0], a[1], a[2], a[3]}; *(LAS f32x4*)(part + wave * 128 + c8 + 4) = (f32x4){a[4], a[5], a[6], a[7]}; }
        __syncthreads();
        if (tid < 128) { float sm = 0.f; for (int p = 0; p < 8; ++p) sm += part[p * 128 + tid]; KMEAN[(size_t)u * 128 + tid] = sm * (1.f / 256.f); }
        __syncthreads();
#pragma unroll
        for (int j = 0; j < 8; ++j) cur[j] = nxt[j];
    }
#undef KMU_LD
}

namespace att {
typedef short s16x4 __attribute__((ext_vector_type(4)));
typedef float f32x16 __attribute__((ext_vector_type(16)));
constexpr int D = 128, NW = 8, QBLK = 32, KVBLK = 64;
constexpr int SHM_V = KVBLK * D * 2, SHM_K = KVBLK * D * 2;
constexpr int LDS_ATT = 2 * SHM_V + 2 * SHM_K + NW * 128 * 4;
constexpr float SCALE = 0.08838834764831845f, THR = 8.f;
#define KSWZ(row, colB) ((row) * 256 + ((colB) ^ (((row) & 7) << 4)))
#define SBAR() __builtin_amdgcn_sched_barrier(0)
__device__ __forceinline__ int v_st(int k, int c) { const int kk = (k & ~0xC) | ((k & 4) << 1) | ((k & 8) >> 1); return ((kk >> 3) * 4 + (c >> 5)) * 512 + ((kk & 7) * 32 + (c & 31)) * 2; }
__device__ __forceinline__ int v_rd_base(int lane) { return ((lane & 3) << 3) | (((lane >> 2) & 3) << 6) | (((lane >> 4) & 1) << 5) | (((lane >> 5) & 1) << 8); }
constexpr int v_rd_off(int d0, int ks, int half) { return d0 * 512 + ks * 4096 + half * 2048; }
__device__ __forceinline__ int crow(int r, int hi) { return (r & 3) + 8 * (r >> 2) + 4 * hi; }
__device__ __forceinline__ unsigned cvtpk(float lo, float hi) { unsigned r; asm volatile("v_cvt_pk_bf16_f32 %0, %1, %2" : "=v"(r) : "v"(lo), "v"(hi)); return r; }
__device__ __forceinline__ void mask_tile(f32x16& p0, f32x16& p1, int dq) {
    const float NEG = -__builtin_inff();
#pragma unroll
    for (int r = 0; r < 16; ++r) { const int c = (r & 3) + 8 * (r >> 2); if (dq - c < 0) p0[r] = NEG; if (dq - c - 32 < 0) p1[r] = NEG; }
}
__device__ __forceinline__ void bias_tile(f32x16& p0, f32x16& p1, unsigned long long mw, int hi) {
    const unsigned lo = (unsigned)mw >> (4 * hi), hh = (unsigned)(mw >> 32) >> (4 * hi);
#pragma unroll
    for (int r = 0; r < 16; ++r) { const int c = (r & 3) + 8 * (r >> 2);
        const unsigned x0 = (unsigned)__builtin_amdgcn_sbfe((int)lo, c, 1), x1 = (unsigned)__builtin_amdgcn_sbfe((int)hh, c, 1);
        p0[r] = __builtin_bit_cast(float, ~x0 & 0xFF800000u); p1[r] = __builtin_bit_cast(float, ~x1 & 0xFF800000u); }
}
__device__ __forceinline__ void partialSM(f32x16& p0, f32x16& p1, float& m_reg, float& mn, float& alpha, bool keep) {
    float pmax = p0[0];
#pragma unroll
    for (int r = 1; r < 16; ++r) pmax = fmaxf(pmax, p0[r]);
#pragma unroll
    for (int r = 0; r < 16; ++r) pmax = fmaxf(pmax, p1[r]);
    { auto rr = __builtin_amdgcn_permlane32_swap(__float_as_uint(pmax), __float_as_uint(pmax), false, false);
      pmax = fmaxf(__uint_as_float(rr[0]), __uint_as_float(rr[1])); }
    pmax = keep ? pmax : -__builtin_inff();
    constexpr float C2 = 1.4426950408889634f * SCALE;
    if (__builtin_expect(__all((pmax - m_reg) * SCALE <= THR), 1)) { mn = m_reg; alpha = 1.f; }
    else { mn = fmaxf(m_reg, pmax); alpha = __builtin_amdgcn_exp2f((m_reg - mn) * C2); m_reg = mn; }
    const float mnL = keep ? -mn * C2 : -__builtin_inff();
#pragma unroll
    for (int r = 0; r < 16; ++r) p0[r] = fmaf(p0[r], C2, mnL);
#pragma unroll
    for (int r = 0; r < 16; ++r) p1[r] = fmaf(p1[r], C2, mnL);
#pragma unroll
    for (int r = 0; r < 16; ++r) p0[r] = __builtin_amdgcn_exp2f(p0[r]);
}
__device__ __forceinline__ void finishSM(f32x16& p0, f32x16& p1, float alpha, float& l_reg, bf16x8& pa0, bf16x8& pa1, bf16x8& pa2, bf16x8& pa3) {
#pragma unroll
    for (int r = 0; r < 16; ++r) p1[r] = __builtin_amdgcn_exp2f(p1[r]);
    float ps = 0;
#pragma unroll
    for (int r = 0; r < 16; ++r) ps += p0[r];
#pragma unroll
    for (int r = 0; r < 16; ++r) ps += p1[r];
    { auto rr = __builtin_amdgcn_permlane32_swap(__float_as_uint(ps), __float_as_uint(ps), false, false);
      ps = __uint_as_float(rr[0]) + __uint_as_float(rr[1]); }
    l_reg = l_reg * alpha + ps;
#define PK4(P, B_, OUT) do { unsigned a0 = cvtpk(P[B_+0], P[B_+1]), a1 = cvtpk(P[B_+2], P[B_+3]);                          \
        unsigned b0 = cvtpk(P[B_+4], P[B_+5]), b1 = cvtpk(P[B_+6], P[B_+7]);                                             \
        auto r0 = __builtin_amdgcn_permlane32_swap(a0, b0, false, false); auto r1 = __builtin_amdgcn_permlane32_swap(a1, b1, false, false); \
        u32x4 w = {r0[0], r1[0], r0[1], r1[1]}; OUT = *reinterpret_cast<bf16x8*>(&w); } while (0)
    PK4(p0, 0, pa0); PK4(p0, 8, pa1); PK4(p1, 0, pa2); PK4(p1, 8, pa3);
#undef PK4
}
template <int KB>
__device__ __forceinline__ void qkt(f32x16& p0, f32x16& p1, const char* K_lds, int r32, int hi, const bf16x8* qr) {
    const char* kb[4];
#pragma unroll
    for (int dd = 0; dd < 4; ++dd) kb[dd] = K_lds + KB * SHM_K + KSWZ(r32, (dd * 16 + hi * 8) * 2);
#pragma unroll
    for (int d0 = 0; d0 < 8; ++d0) { const char* a = kb[d0 & 3] + (d0 >> 2) * 128;
        bf16x8 b0 = *reinterpret_cast<const bf16x8*>(a);
        bf16x8 b1 = *reinterpret_cast<const bf16x8*>(a + 32 * 256);
        p0 = __builtin_amdgcn_mfma_f32_32x32x16_bf16(b0, qr[d0], p0, 0, 0, 0);
        p1 = __builtin_amdgcn_mfma_f32_32x32x16_bf16(b1, qr[d0], p1, 0, 0, 0); }
}
template <int VB>
__device__ __forceinline__ void pv_tile(f32x16* o, int vb0, bf16x8 pa0, bf16x8 pa1, bf16x8 pa2, bf16x8 pa3) {
#define TRRD(dst, off) asm volatile("ds_read_b64_tr_b16 %0, %1 offset:%2" : "=&v"(dst) : "v"(vb0), "i"(off) : "memory")
#define PV_D0(d0) do { s16x4 l0, l1, l2, l3, h0, h1, h2, h3; constexpr int b_ = VB * SHM_V + v_rd_off(d0, 0, 0); \
        TRRD(l0, b_); TRRD(h0, b_ + 2048); TRRD(l1, b_ + 4096); TRRD(h1, b_ + 6144); TRRD(l2, b_ + 8192); TRRD(h2, b_ + 10240); TRRD(l3, b_ + 12288); TRRD(h3, b_ + 14336); \
        asm volatile("s_waitcnt lgkmcnt(0)" ::: "memory"); SBAR();   \
        o[d0] = __builtin_amdgcn_mfma_f32_32x32x16_bf16(pa0, (bf16x8){l0[0], l0[1], l0[2], l0[3], h0[0], h0[1], h0[2], h0[3]}, o[d0], 0, 0, 0);   \
        o[d0] = __builtin_amdgcn_mfma_f32_32x32x16_bf16(pa1, (bf16x8){l1[0], l1[1], l1[2], l1[3], h1[0], h1[1], h1[2], h1[3]}, o[d0], 0, 0, 0);   \
        o[d0] = __builtin_amdgcn_mfma_f32_32x32x16_bf16(pa2, (bf16x8){l2[0], l2[1], l2[2], l2[3], h2[0], h2[1], h2[2], h2[3]}, o[d0], 0, 0, 0);   \
        o[d0] = __builtin_amdgcn_mfma_f32_32x32x16_bf16(pa3, (bf16x8){l3[0], l3[1], l3[2], l3[3], h3[0], h3[1], h3[2], h3[3]}, o[d0], 0, 0, 0); } while (0)
    PV_D0(0); PV_D0(1); PV_D0(2); PV_D0(3);
#undef PV_D0
#undef TRRD
}
__device__ __forceinline__ __amdgpu_buffer_rsrc_t mkrsrc(const void* p, int bytes) {
    const unsigned long long a = (unsigned long long)p; const unsigned lo = __builtin_amdgcn_readfirstlane((unsigned)a), hi = __builtin_amdgcn_readfirstlane((unsigned)(a >> 32));
    return __builtin_amdgcn_make_buffer_rsrc((void*)(((unsigned long long)hi << 32) | lo), (short)0, bytes, 0x00020000);
}
#define BLD16(rs, vo, so) __builtin_bit_cast(bf16x8, __builtin_amdgcn_raw_buffer_load_b128((rs), (int)(vo), (int)(so), 0))
struct Blk { const bf16_t* Qw; const bf16_t* K; const bf16_t* V; bf16_t* Ow; float* Sq; int NT, qpos, own_t0; const unsigned long long* mrow; };
struct Seam { bf16x8 qr[8]; bf16x8 st0, st1; };
constexpr int OST = 1024;
#define VMW() asm volatile("s_waitcnt vmcnt(0)" ::: "memory")
#define VMWN(n) asm volatile("s_waitcnt vmcnt(%0)" :: "i"(n) : "memory")
#define SLOAD(rs, k0) do { S.st0 = BLD16(rs, kvoff, (k0) * 256); S.st1 = BLD16(rs, kvoff, (k0) * 256 + 8192); } while (0)
#define SWRITE_K(bf) do { *(bf16x8*)(K_lds + (bf) * SHM_K + kws) = S.st0; *(bf16x8*)(K_lds + (bf) * SHM_K + kws + 32 * 256) = S.st1; } while (0)
#define SWRITE_V(bf) do { *(bf16x8*)(V_lds + (bf) * SHM_V + vst0) = S.st0; *(bf16x8*)(V_lds + (bf) * SHM_V + vst1) = S.st1; } while (0)
__device__ __forceinline__ void att_prime(const Blk& cur, char* lds, Seam& S, int wid) {
    const int lane = lane_opaque(), tid = wid * 64 + lane, r32 = lane & 31, hi = lane >> 5;
    const int sr = tid >> 4, sc = (tid & 15) * 8, kws = KSWZ(sr, sc * 2); char* K_lds = lds + 2 * SHM_V;
    const unsigned kvoff = (unsigned)(sr * 256 + sc * 2), qoff = (unsigned)(r32 * 256 + hi * 16);
    const __amdgpu_buffer_rsrc_t rQ = mkrsrc(cur.Qw, 32 * 256), rK = mkrsrc(cur.K, SEQ * 256), rV = mkrsrc(cur.V, SEQ * 256);
#pragma unroll
    for (int d0 = 0; d0 < 8; ++d0) S.qr[d0] = BLD16(rQ, qoff + d0 * 32, 0);
    SLOAD(rK, 0); VMW(); SWRITE_K(0); SBAR(); SLOAD(rV, 0);
    __syncthreads();
}
template <int MODE>
__device__ __forceinline__ void att_block(const Blk& cur, const Blk& nxt, char* lds, Seam& S, int wid) {
    const int lane = lane_opaque(), tid = wid * 64 + lane, r32 = lane & 31, hi = lane >> 5;
    const int NT = cur.NT;
    const int qlo = cur.qpos, qm = qlo + r32 - 4 * hi;
    char* V_lds = lds; char* K_lds = lds + 2 * SHM_V;
    float* ws = (float*)(lds + 2 * SHM_V + 2 * SHM_K) + wid * 128; float* li_l = ws, * al_l = ws + 32; const unsigned* sel_l = (const unsigned*)(ws + 64);
    float m_reg = -1e30f, l_reg = 0; f32x16 o[4] = {};
    const int sr = tid >> 4, sc = (tid & 15) * 8, vst0 = v_st(sr, sc), vst1 = v_st(32 + sr, sc), kws = KSWZ(sr, sc * 2);
    const int vb0 = (int)(uintptr_t)V_lds + v_rd_base(lane);
    const unsigned kvoff = (unsigned)(sr * 256 + sc * 2), qoff = (unsigned)(r32 * 256 + hi * 16);
    const __amdgpu_buffer_rsrc_t Kh = mkrsrc(cur.K, SEQ * 256), Vh = mkrsrc(cur.V, SEQ * 256);
    const __amdgpu_buffer_rsrc_t rM = mkrsrc(MODE == 1 ? (const void*)cur.mrow : (const void*)cur.K, 64 * 512);
#define MLD(t) __builtin_bit_cast(unsigned long long, __builtin_amdgcn_raw_buffer_load_b64(rM, (int)((32 * (wid >> 2) + r32) * 8), (int)((t) * 512), 0))
#define RESC(a) do { if (__any((a) < 1.f)) { if (hi == 0) al_l[r32] = (a); asm volatile("s_waitcnt lgkmcnt(0)" ::: "memory");              \
                     for (int d_ = 0; d_ < 4; ++d_) for (int r = 0; r < 16; ++r) o[d_][r] *= al_l[crow(r, hi)]; } } while (0)
#define KBASE(t) ((t) * KVBLK)
#define MASKT(P0_, P1_, t) do { if (MODE == 0) { const int kb_ = KBASE(t); if ((t) >= cur.own_t0 && kb_ + KVBLK - 1 > qlo) mask_tile(P0_, P1_, qm - kb_); } } while (0)
#define KEEP(t) ((MODE == 0) ? (((t) >= cur.own_t0) || ((sel_l[r32] >> ((t) >> 2)) & 1u)) : true)
#define PINIT(P0_, P1_, t) do { if (MODE == 1) { bias_tile(P0_, P1_, mwq, hi); mwq = MLD(((t) + 1 < NT) ? (t) + 1 : (t)); } else { P0_ = f32x16{}; P1_ = f32x16{}; } } while (0)
#define SEAM_K0() do { VMWN(8); SWRITE_K(0); SBAR(); { const __amdgpu_buffer_rsrc_t rVn = mkrsrc(nxt.V, SEQ * 256); SLOAD(rVn, 0); } SBAR(); } while (0)
    f32x16 pA0, pA1, pB0, pB1; float mnA, mnB, alA, alB; bf16x8 pa0, pa1, pa2, pa3;
    unsigned long long mwq = 0ull; if (MODE == 1) mwq = MLD(0);
    VMW(); SWRITE_V(0); SBAR();
    if (NT > 1) SLOAD(Kh, KBASE(1));
    PINIT(pA0, pA1, 0);
    SBAR(); qkt<0>(pA0, pA1, K_lds, r32, hi, S.qr);
    if (NT > 1) { VMW(); SWRITE_K(1); SBAR(); SLOAD(Vh, KBASE(1)); }
    MASKT(pA0, pA1, 0); partialSM(pA0, pA1, m_reg, mnA, alA, KEEP(0));
    if (NT > 1) { VMW(); SWRITE_V(1); SBAR(); if (NT > 2) SLOAD(Kh, KBASE(2)); }
    __syncthreads();
#define HALF_STEP(PX0, PX1, mnX, alX, PY0, PY1, alY, t, KB, VB, SB) do {                                                      \
        PINIT(PX0, PX1, t);                                                                                                   \
        SBAR(); qkt<KB>(PX0, PX1, K_lds, r32, hi, S.qr);                                                                      \
        finishSM(PY0, PY1, alY, l_reg, pa0, pa1, pa2, pa3); SBAR();                                                           \
        if ((t) + 1 < NT) { VMW(); SWRITE_K(SB); SBAR(); SLOAD(Vh, KBASE((t) + 1)); SBAR(); }                                 \
        pv_tile<VB>(o, vb0, pa0, pa1, pa2, pa3); MASKT(PX0, PX1, (t)); partialSM(PX0, PX1, m_reg, mnX, alX, KEEP(t));        \
        __syncthreads();                                                                                                      \
        if ((t) + 1 < NT) { VMW(); SWRITE_V(SB); SBAR(); if ((t) + 2 < NT) SLOAD(Kh, KBASE((t) + 2)); }                       \
        RESC(alX); __syncthreads(); } while (0)
    for (int t = 1; t + 1 < NT; t += 2) {
        HALF_STEP(pB0, pB1, mnB, alB, pA0, pA1, alA, t, 1, 0, 0);
        HALF_STEP(pA0, pA1, mnA, alA, pB0, pB1, alB, t + 1, 0, 1, 1);
    }
    const bool even = (NT & 1) == 0;
    if (even) { PINIT(pB0, pB1, NT - 1); SBAR(); qkt<1>(pB0, pB1, K_lds, r32, hi, S.qr); SBAR(); }
    { const __amdgpu_buffer_rsrc_t rKn = mkrsrc(nxt.K, SEQ * 256); SLOAD(rKn, 0); } SBAR();
    { const __amdgpu_buffer_rsrc_t rQn = mkrsrc(nxt.Qw, 32 * 256);
#pragma unroll
      for (int d0 = 0; d0 < 8; ++d0) S.qr[d0] = BLD16(rQn, qoff + d0 * 32, 0); }
    SBAR();
    finishSM(pA0, pA1, alA, l_reg, pa0, pa1, pa2, pa3); SBAR();
    pv_tile<0>(o, vb0, pa0, pa1, pa2, pa3);
    if (even) { MASKT(pB0, pB1, NT - 1); partialSM(pB0, pB1, m_reg, mnB, alB, KEEP(NT - 1)); __syncthreads(); RESC(alB);
        finishSM(pB0, pB1, alB, l_reg, pa0, pa1, pa2, pa3); SBAR(); pv_tile<1>(o, vb0, pa0, pa1, pa2, pa3); }
    SBAR(); SEAM_K0();
    if (hi == 0) li_l[r32] = l_reg; asm volatile("s_waitcnt lgkmcnt(0)" ::: "memory");
    float rli[16];
#pragma unroll
    for (int r = 0; r < 16; ++r) rli[r] = __builtin_amdgcn_rcpf(li_l[crow(r, hi)]);
    bf16_t* Ow = cur.Ow;
#pragma unroll
    for (int r = 0; r < 16; ++r) { const int orow = crow(r, hi); float ss = 0.f;
#pragma unroll
        for (int d0 = 0; d0 < 4; ++d0) { const float v = o[d0][r] * rli[r]; ss += v * v;
            const float vn = __shfl_xor(v, 1);
            if ((r32 & 1) == 0) *(unsigned*)(Ow + (size_t)orow * OST + d0 * 32 + r32) = cvtpk(v, vn); }
        ss += __shfl_xor(ss, 1); ss += __shfl_xor(ss, 2); ss += __shfl_xor(ss, 4); ss += __shfl_xor(ss, 8); ss += __shfl_xor(ss, 16);
        if (r32 == 0) cur.Sq[(size_t)orow * 8] = ss; }
    __syncthreads();
#undef RESC
#undef KBASE
#undef MASKT
#undef KEEP
#undef PINIT
#undef SEAM_K0
#undef HALF_STEP
#undef MLD
}
__device__ __forceinline__ void moba_gate(const Seam& S, const float* km  , int own, char* lds, int wid) {
    const int lane = lane_opaque(), r32 = lane & 31, hi = lane >> 5;
    unsigned* sel_l = (unsigned*)((float*)(lds + 2 * SHM_V + 2 * SHM_K) + wid * 128 + 64);
    float* kl = (float*)(lds + 73728 + wid * 8192);
    { f32x4 t[8];
#pragma unroll
      for (int i = 0; i < 8; ++i) t[i] = *((const f32x4*)km + lane + 64 * i);
#pragma unroll
      for (int i = 0; i < 8; ++i) *((f32x4*)kl + lane + 64 * i) = t[i]; }
    float g[15];
#pragma unroll
    for (int n = 0; n < 15; ++n) { g[n] = -__builtin_inff();
        if (n < own) { float a = 0.f;
#pragma unroll
            for (int d0 = 0; d0 < 8; ++d0) { const float* kp = kl + n * 128 + d0 * 16 + hi * 8; const f32x4 k0 = *(const f32x4*)kp, k1 = *(const f32x4*)(kp + 4); const bf16x8 q = S.qr[d0];
                a += bf2f((unsigned short)q[0]) * k0[0] + bf2f((unsigned short)q[1]) * k0[1] + bf2f((unsigned short)q[2]) * k0[2] + bf2f((unsigned short)q[3]) * k0[3]
                   + bf2f((unsigned short)q[4]) * k1[0] + bf2f((unsigned short)q[5]) * k1[1] + bf2f((unsigned short)q[6]) * k1[2] + bf2f((unsigned short)q[7]) * k1[3]; }
            g[n] = a + __shfl_xor(a, 32); } }
    unsigned sel = 0u;
#pragma unroll
    for (int r = 0; r < 3; ++r) { int best = -1; float bv = -__builtin_inff();
#pragma unroll
        for (int n = 0; n < 15; ++n) if (n < own && !((sel >> n) & 1u) && g[n] > bv) { bv = g[n]; best = n; }
        if (best >= 0) sel |= 1u << best; }
    if (hi == 0) sel_l[r32] = sel;
    asm volatile("s_waitcnt lgkmcnt(0)" ::: "memory");
}

#undef ROW
#undef VMW
#undef VMWN
#undef SLOAD
#undef SWRITE_K
#undef SWRITE_V
}

namespace idx {
typedef _Float16 f16x8 __attribute__((ext_vector_type(8)));
typedef float f32x16 __attribute__((ext_vector_type(16)));
constexpr int HIST_OFF = 0, MASKL_OFF = 131072, META_OFF = 139264, CAP = 1024;
__device__ __forceinline__ unsigned fkey(float v) { const unsigned u = __builtin_bit_cast(unsigned, v); return u ^ ((unsigned)((int)u >> 31) | 0x80000000u); }
template <int CTRL> __device__ __forceinline__ int dpp_i0(int v) { return __builtin_amdgcn_update_dpp(0, v, CTRL, 0xF, 0xF, true); }
__device__ __forceinline__ int suffix_sum64(int v, int lane) {
    int s = v;
    s += dpp_i0<0x101>(s); s += dpp_i0<0x102>(s); s += dpp_i0<0x104>(s); s += dpp_i0<0x108>(s);
    const int t1 = __builtin_amdgcn_readlane(s, 16), t2 = __builtin_amdgcn_readlane(s, 32), t3 = __builtin_amdgcn_readlane(s, 48);
    const int r = lane >> 4;
    return s + (r == 0 ? t1 + t2 + t3 : r == 1 ? t2 + t3 : r == 2 ? t3 : 0);
}
__device__ __forceinline__ int kbin(unsigned key) {
    const unsigned nt = ~(unsigned)((int)key >> 31);
    const unsigned mag = (key ^ nt) & 0x7fffffffu;
    int e6 = (int)(mag >> 17) - 107 * 64; e6 = e6 < 0 ? 0 : e6; e6 = e6 > 2047 ? 2047 : e6;
    return 2048 + (int)((unsigned)e6 ^ nt);
}
__device__ __forceinline__ float fadd1(float a, float b) { float r; asm("v_add_f32_e32 %0, %1, %2" : "=v"(r) : "v"(a), "v"(b)); return r; }
#define IDX_LATOM_ADD(p, v) __hip_atomic_fetch_add((LAS unsigned*)(p), (v), __ATOMIC_RELAXED, __HIP_MEMORY_SCOPE_WORKGROUP)
#define IDX_LATOM_OR(p, v) __hip_atomic_fetch_or((LAS unsigned*)(p), (v), __ATOMIC_RELAXED, __HIP_MEMORY_SCOPE_WORKGROUP)
template <bool CHECK>
__device__ __forceinline__ void tile1(const f16x8 (&b)[4], const int t, const f16x8 (&a)[2][4], const float (&sg)[2][16], int q0, int qh, int lane, LAS unsigned* hist, unsigned* ks) {
    const int c = lane & 31, hi = lane >> 5;
    f32x16 acc[2] = {};
#pragma unroll
    for (int kk = 0; kk < 4; ++kk) { acc[0] = __builtin_amdgcn_mfma_f32_32x32x16_f16(a[0][kk], b[kk], acc[0], 0, 0, 0); acc[1] = __builtin_amdgcn_mfma_f32_32x32x16_f16(a[1][kk], b[kk], acc[1], 0, 0, 0); }
    const int s = t * 32 + c;
#pragma unroll
    for (int m = 0; m < 2; ++m)
#pragma unroll
        for (int k = 0; k < 2; ++k) { const int ql = 8 * qh + 4 * m + 2 * hi + k;
            float e_[8];
#pragma unroll
            for (int r = 0; r < 8; ++r) e_[r] = __builtin_amdgcn_fmed3f(acc[m][8 * k + r], 0.f, sg[m][8 * k + r]);
            const float v = fadd1(fadd1(fadd1(e_[0], e_[1]), fadd1(e_[2], e_[3])), fadd1(fadd1(e_[4], e_[5]), fadd1(e_[6], e_[7])));
            const unsigned key = fkey(v);
            ks[(2 * m + k) * 64] = key;
            const int bin = kbin(key);
            IDX_LATOM_ADD(hist + ql * 2048 + (bin >> 1), (!CHECK || s <= q0 + ql) ? (1u << (16 * (bin & 1))) : 0u); }
}
__device__ __forceinline__ void pass1(const f16_t* KIb  , const f16x8 (&a)[2][4], const float (&sg)[2][16], int q0, int qh, int kp, int lane, LAS unsigned char* lds, unsigned* ks  ) {
    LAS unsigned* hist = (LAS unsigned*)(lds + HIST_OFF);
    const int tmax = (q0 + 15) >> 5;
    if (kp > tmax) return;
    int tl = kp + ((tmax - kp) & ~3);
    const bool own = tl == tmax;
    const f16_t* kr = KIb + lane * 8;
    f16x8 b0[4], b1[4], b2[4], b3[4];
#define IDX_LD(dst, t_) do { const int tt_ = (t_) < tmax ? (t_) : tmax; const f16_t* p_ = kr + (size_t)tt_ * 2048; _Pragma("unroll") for (int kk = 0; kk < 4; ++kk) dst[kk] = *(const f16x8*)(p_ + kk * 512); __builtin_amdgcn_fence(__ATOMIC_RELEASE, "wavefront"); } while (0)
#define IDX_TILE(bb, tt) do { tile1<false>(bb, tt, a, sg, q0, qh, lane, hist, ks); ks += 256; } while (0)
    int t = kp;
    if (own) IDX_LD(b3, tmax);
    IDX_LD(b0, t); IDX_LD(b1, t + 4); IDX_LD(b2, t + 8);
    if (own) { tile1<true>(b3, tmax, a, sg, q0, qh, lane, hist, ks + ((tmax - kp) >> 2) * 256); tl -= 4; }
    for (; t + 12 <= tl; t += 16) {
        IDX_LD(b3, t + 12); IDX_TILE(b0, t);
        IDX_LD(b0, t + 16); IDX_TILE(b1, t + 4);
        IDX_LD(b1, t + 20); IDX_TILE(b2, t + 8);
        IDX_LD(b2, t + 24); IDX_TILE(b3, t + 12);
    }
    if (t <= tl) { IDX_TILE(b0, t); if (t + 4 <= tl) { IDX_TILE(b1, t + 4); if (t + 8 <= tl) IDX_TILE(b2, t + 8); } }
#undef IDX_LD
#undef IDX_TILE
}
__device__ __forceinline__ void pass2(int q0, int qh, int kp, int lane, LAS unsigned char* lds, const unsigned* ks) {
    const int c = lane & 31, hi = lane >> 5;
    LAS unsigned* hist = (LAS unsigned*)(lds + HIST_OFF); LAS unsigned* maskl = (LAS unsigned*)(lds + MASKL_OFF); LAS int* meta = (LAS int*)(lds + META_OFF);
    const int tmax = (q0 + 15) >> 5;
    if (kp > tmax) return;
    const int n = ((tmax - kp) >> 2) + 1;
    int thr[4];
#pragma unroll
    for (int j = 0; j < 4; ++j) thr[j] = meta[(8 * qh + 4 * (j >> 1) + 2 * hi + (j & 1)) * 4];
    unsigned ka[16], kb[16];
#define IDX_LDG(dst, g_) do { _Pragma("unroll") for (int u = 0; u < 4; ++u) { const int i_ = 4 * (g_) + u < n ? n - 1 - (4 * (g_) + u) : 0; _Pragma("unroll") for (int j = 0; j < 4; ++j) dst[4 * u + j] = ks[i_ * 256 + j * 64]; } \
        __builtin_amdgcn_fence(__ATOMIC_RELEASE, "wavefront"); } while (0)
#define IDX_PRG(src, g_) do { _Pragma("unroll") for (int u = 0; u < 4; ++u) { const int io_ = 4 * (g_) + u; if (io_ < n) { const int i_ = n - 1 - io_, t = kp + 4 * i_, s = t * 32 + c; \
        _Pragma("unroll") for (int m = 0; m < 2; ++m) { unsigned long long bal[2]; \
            _Pragma("unroll") for (int k = 0; k < 2; ++k) { const int ql = 8 * qh + 4 * m + 2 * hi + k; const unsigned key = src[4 * u + 2 * m + k]; const int bin = kbin(key); const bool valid = s <= q0 + ql; \
                bal[k] = __ballot(valid && bin > thr[2 * m + k]); \
                if (valid && bin == thr[2 * m + k]) { const unsigned p = IDX_LATOM_ADD((LAS unsigned*)(meta + ql * 4 + 2), 1u); \
                    if (p < (unsigned)CAP) { LAS unsigned* e = hist + ql * 2048 + 2 * p; e[0] = key; e[1] = (unsigned)s; } } } \
            if (lane == 0) { const int qb = 8 * qh + 4 * m; \
                maskl[(qb + 0) * 128 + t] = (unsigned)bal[0]; maskl[(qb + 2) * 128 + t] = (unsigned)(bal[0] >> 32); \
                maskl[(qb + 1) * 128 + t] = (unsigned)bal[1]; maskl[(qb + 3) * 128 + t] = (unsigned)(bal[1] >> 32); } } } } } while (0)
    const int ng = (n + 3) >> 2;
    IDX_LDG(ka, 0);
    for (int g = 0; g < ng; g += 2) {
        IDX_LDG(kb, g + 1); IDX_PRG(ka, g);
        IDX_LDG(ka, g + 2); IDX_PRG(kb, g + 1);
    }
#undef IDX_LDG
#undef IDX_PRG
}
struct Ops { f16x8 q[2][4]; float w[2]; f32x4 s[2][2][2]; };
__device__ __forceinline__ void load_raw(int b, int q0, const f16_t* QI, const float* WI, int wid, Ops& o) {
    const int lane = lane_opaque(), c = lane & 31, hi = lane >> 5, qh = wid & 1;
#pragma unroll
    for (int m = 0; m < 2; ++m) { const int qq = 2 * ((c >> 2) & 1) + (c >> 4), hd = 4 * ((c >> 3) & 1) + (c & 3);
        const size_t row = (size_t)b * SEQ + q0 + 8 * qh + 4 * m + qq;
        const f16_t* qr = QI + row * 512 + hd * 64 + hi * 8; o.w[m] = WI[row * 8 + hd];
#pragma unroll
        for (int kk = 0; kk < 4; ++kk) o.q[m][kk] = *(const f16x8*)(qr + kk * 16);
#pragma unroll
        for (int k = 0; k < 2; ++k) { const float* wp = WI + ((size_t)b * SEQ + q0 + 8 * qh + 4 * m + 2 * hi + k) * 8; o.s[m][k][0] = *(const f32x4*)wp; o.s[m][k][1] = *(const f32x4*)(wp + 4); } }
}
__device__ __forceinline__ void unit(int b, int q0, bool has_next, const f16_t* QI, const f16_t* KI, const float* WI, unsigned long long* MASK, unsigned* KS  , unsigned char* lds_, int wid, Ops& ops) {
    LAS unsigned char* lds = (LAS unsigned char*)lds_;
    const int lane = lane_opaque(), tid = wid * 64 + lane, c = lane & 31, hi = lane >> 5, qh = wid & 1, kp = wid >> 1;
    LAS unsigned* hist = (LAS unsigned*)(lds + HIST_OFF); LAS unsigned* maskl = (LAS unsigned*)(lds + MASKL_OFF); LAS int* meta = (LAS int*)(lds + META_OFF);
    for (int i = tid; i < 8192 + 512; i += NTHR) ((LAS u32x4*)hist)[i] = (u32x4){0u, 0u, 0u, 0u};
    if (tid < 64) meta[tid] = 0;
    f16x8 a[2][4]; float sg[2][16];
#pragma unroll
    for (int m = 0; m < 2; ++m) { const f16_t w = (f16_t)ops.w[m];
#pragma unroll
        for (int kk = 0; kk < 4; ++kk) a[m][kk] = ops.q[m][kk] * w;
#pragma unroll
        for (int r = 0; r < 16; ++r) { const float w2 = ops.s[m][r >> 3][(r >> 2) & 1][r & 3];
            sg[m][r] = (float)(f16_t)w2 < 0.f ? -__builtin_inff() : __builtin_inff(); } }
    const f16_t* KIb = KI + (size_t)b * SEQ * 64;
    __syncthreads();
    unsigned* ks = KS + (size_t)wid * 8192 + lane;
    pass1(KIb, a, sg, q0, qh, kp, lane, lds, ks);
    load_raw(b, has_next ? q0 + 16 : q0, QI, WI, wid, ops);
    __syncthreads();
#pragma unroll
    for (int k = 0; k < 2; ++k) { const int qi = 2 * wid + k, N = q0 + qi + 1;
        if (N > 256) {
            const LAS u32x4* h4 = (const LAS u32x4*)(hist + qi * 2048 + lane * 32);
            u32x4 hv[8];
#pragma unroll
            for (int i = 0; i < 8; ++i) hv[i] = h4[(i + lane) & 7];
            int tot = 0;
#pragma unroll
            for (int i = 0; i < 8; ++i)
#pragma unroll
                for (int d = 0; d < 4; ++d) { const unsigned w = hv[i][d]; tot += (int)(w & 0xffffu) + (int)(w >> 16); }
            const int suf = suffix_sum64(tot, lane);
            const unsigned long long ge = __ballot(suf >= 256);
            const int L = 63 - __clzll((long long)ge);
            const int above = __builtin_amdgcn_readlane(suf - tot, L);
            const unsigned w = hist[qi * 2048 + L * 32 + (lane >> 1)]; const int cnt = (lane & 1) ? (int)(w >> 16) : (int)(w & 0xffffu);
            const int sb = suffix_sum64(cnt, lane);
            const unsigned long long g2 = __ballot(above + sb >= 256);
            const int Bn = 63 - __clzll((long long)g2);
            if (lane == Bn) { meta[qi * 4] = L * 64 + Bn; meta[qi * 4 + 1] = 256 - (above + sb - cnt); }
        } else if (lane == 0) { meta[qi * 4] = -1; meta[qi * 4 + 1] = 0; }
    }
    __syncthreads();
    VM_WAIT();
    pass2(q0, qh, kp, lane, lds, ks);
    __syncthreads();
#pragma unroll
    for (int k = 0; k < 2; ++k) { const int qi = 2 * wid + k; const int need = __builtin_amdgcn_readfirstlane(meta[qi * 4 + 1]); int n = __builtin_amdgcn_readfirstlane(meta[qi * 4 + 2]); n = n < CAP ? n : CAP;
        const LAS unsigned* cl = hist + qi * 2048;
        if (n <= 64) {
            unsigned lo = 0u, hi2 = 0u;
            if (lane < n) { const u32x2 w = *(const LAS u32x2*)(cl + 2 * lane); lo = (w.x << 12) | (4095u - w.y); hi2 = w.x >> 20; }
            const unsigned long long mine = ((unsigned long long)hi2 << 32) | lo; int rank = 0;
            for (int j = 0; j < n; ++j) { const unsigned long long cj = ((unsigned long long)(unsigned)__builtin_amdgcn_readlane((int)hi2, j) << 32) | (unsigned)__builtin_amdgcn_readlane((int)lo, j); rank += cj > mine ? 1 : 0; }
            if (lane < n && rank < need) { const unsigned si = 4095u - (lo & 0xfffu); IDX_LATOM_OR(maskl + qi * 128 + (si >> 5), 1u << (si & 31)); }
        } else if (n <= 256) {
            unsigned long long cv[4];
#pragma unroll
            for (int e = 0; e < 4; ++e) { const int i = lane + 64 * e; cv[e] = 0ull;
                if (i < n) { const u32x2 w = *(const LAS u32x2*)(cl + 2 * i); cv[e] = ((unsigned long long)w.x << 12) | (unsigned long long)(4095u - w.y); } }
            unsigned long long Tv = 0ull;
            if (n > 0) for (int b = 43; b >= 0; --b) { const unsigned long long t = Tv | (1ull << b); int cnt = 0;
#pragma unroll
                for (int e = 0; e < 4; ++e) cnt += __popcll(__ballot(cv[e] >= t));
                if (cnt >= need) Tv = t; }
#pragma unroll
            for (int e = 0; e < 4; ++e) { const int i = lane + 64 * e; if (i < n && cv[e] >= Tv) { const unsigned si = 4095u - (unsigned)(cv[e] & 0xfffull); IDX_LATOM_OR(maskl + qi * 128 + (si >> 5), 1u << (si & 31)); } }
        } else {
            for (int i0 = 0; i0 < n; i0 += 64) { const int i = i0 + lane; const bool act = i < n; const unsigned ki = act ? cl[2 * i] : 0u, si = act ? cl[2 * i + 1] : 0u; int rank = 0;
                for (int j = 0; j < n; j += 2) { const u32x4 e = *(const LAS u32x4*)(cl + 2 * j);
                    rank += (e.x > ki || (e.x == ki && e.y < si)) ? 1 : 0; if (j + 1 < n) rank += (e.z > ki || (e.z == ki && e.w < si)) ? 1 : 0; }
                if (act && rank < need) IDX_LATOM_OR(maskl + qi * 128 + (si >> 5), 1u << (si & 31)); }
        }
    }
    __syncthreads();
    { const int qi = tid >> 5, w4 = tid & 31;
      const u32x4 v = *(const LAS u32x4*)(maskl + qi * 128 + w4 * 4);
      unsigned long long* tb_ = MASK + ((size_t)b * SEQ + (q0 & ~63)) * 64 + (q0 & 63) + qi;
      *(u32x2*)(tb_ + (size_t)(2 * w4) * 64) = (u32x2){v.x, v.y}; *(u32x2*)(tb_ + (size_t)(2 * w4 + 1) * 64) = (u32x2){v.z, v.w}; }
    __syncthreads();
}
#undef IDX_LATOM_ADD
#undef IDX_LATOM_OR
}


__device__ __forceinline__ void phase6(const Args& A, unsigned char* lds_, const int wave) {
    char* lds = (char*)lds_;
    att::Seam S;
#define P6_WS() unsigned char* ws = A.ws; asm volatile("" : "+s"(ws))
    for (int v = blockIdx.x; v < 256; v += gridDim.x) {
        {
            P6_WS();
            const bf16_t* QM = (const bf16_t*)(ws + WS_QM); const bf16_t* KM = (const bf16_t*)(ws + WS_KM); const bf16_t* VM = (const bf16_t*)(ws + WS_VM);
            bf16_t* OO = (bf16_t*)(ws + WS_H); float* SSQO = (float*)(ws + WS_OM); const float* KMEAN = (const float*)(ws + WS_KMEAN);
            const int bh = (v & 7) * 4 + (v >> 6), j = (v >> 3) & 7;
            for (int ps = 0; ps < 2; ++ps) { const int qb = ps ? 15 - j : j; const int qpos = qb * 256 + 32 * wave;
                if ((v & 3) == ps) { __syncthreads(); convert_experts(A, lds_, wave); __syncthreads(); }
                att::Blk cur; cur.Qw = QM + ((size_t)bh * SEQ + qpos) * 128; cur.K = KM + (size_t)bh * SEQ * 128; cur.V = VM + (size_t)bh * SEQ * 128;
                cur.Ow = OO + ((size_t)(bh >> 2) * SEQ + qpos) * 1024 + (bh & 3) * 128; cur.Sq = SSQO + ((size_t)(bh >> 2) * SEQ + qpos) * 8 + (bh & 3); cur.NT = 4 * (qb + 1); cur.qpos = qpos; cur.own_t0 = 4 * qb; cur.mrow = nullptr;
                att::att_prime(cur, lds, S, wave);
                att::moba_gate(S, KMEAN + (size_t)bh * 16 * 128, qb, lds, wave);
                att::att_block<0>(cur, cur, lds, S, wave); }
        }
        {
            P6_WS();
            const bf16_t* QD = (const bf16_t*)(ws + WS_QD); const bf16_t* KD = (const bf16_t*)(ws + WS_KD); const bf16_t* VD = (const bf16_t*)(ws + WS_VD);
            bf16_t* OO = (bf16_t*)(ws + WS_H); float* SSQO = (float*)(ws + WS_OM);
            const f16_t* QI = (const f16_t*)(ws + WS_QI); const f16_t* KI = (const f16_t*)(ws + WS_KI); const float* WI = (const float*)(ws + WS_WI);
            unsigned long long* MASK = (unsigned long long*)(ws + WS_MASK);
            const int b = 2 * (v & 3) + ((v >> 3) & 1), j = (v >> 4) + 16 * ((v >> 2) & 1);
            for (int ps = 0; ps < 2; ++ps) { const int qt = ps ? 63 - j : j;
                if ((v & 3) == 2 + ps) { __syncthreads(); convert_experts(A, lds_, wave); __syncthreads(); }
                { idx::Ops ops; idx::load_raw(b, 64 * qt, QI, WI, wave, ops);
                  for (int i = 0; i < 4; ++i) idx::unit(b, 64 * qt + 16 * i, i < 3, QI, KI, WI, MASK, (unsigned*)(ws + WS_KS) + (size_t)blockIdx.x * 65536, lds_, wave, ops); }
                VM_WAIT(); __syncthreads();
                const int qpos = 64 * qt + 32 * (wave >> 2), hd = wave & 3;
                att::Blk cur; cur.Qw = QD + ((size_t)(b * 4 + hd) * SEQ + qpos) * 128; cur.K = KD + (size_t)b * SEQ * 128; cur.V = VD + (size_t)b * SEQ * 128;
                cur.Ow = OO + ((size_t)b * SEQ + qpos) * 1024 + 512 + hd * 128; cur.Sq = SSQO + ((size_t)b * SEQ + qpos) * 8 + 4 + hd; cur.NT = qt + 1; cur.qpos = qpos; cur.own_t0 = 0; cur.mrow = MASK + ((size_t)b * SEQ + 64 * qt) * 64;
                att::att_prime(cur, lds, S, wave);
                att::att_block<1>(cur, cur, lds, S, wave); }
        }
    }
#undef P6_WS
}

__device__ __forceinline__ void phase9(const Args& A, const int wave) {
    const int lane = lane_opaque();
    const int gw = blockIdx.x * NWAVES + wave, NGW = gridDim.x * NWAVES;
    const bf16_t* x1 = (const bf16_t*)(A.ws + WS_X1); const float* mod = (const float*)(A.ws + WS_MOD); bf16_t* H2 = (bf16_t*)(A.ws + WS_H2);
    for (int row = gw; row < T; row += NGW) {
        const float* mb = mod + (size_t)(row >> 12) * 6144; f32x4 v[4];
        modnorm_row<true>(x1 + (size_t)row * DM, A.in[11], mb + 3072, mb + 4096, lane, v);
#pragma unroll
        for (int j = 0; j < 4; ++j) { unsigned h[4]; float l[4];
#pragma unroll
            for (int k = 0; k < 4; ++k) { h[k] = f2bf(v[j][k]); l[k] = v[j][k] - bf2f(h[k]); }
            u32x2 oh, ol; oh.x = h[0] | (h[1] << 16); oh.y = h[2] | (h[3] << 16); ol.x = pk2(l[0], l[1]); ol.y = pk2(l[2], l[3]);
            *((u32x2*)(H2 + (size_t)row * 2048) + lane + 64 * j) = oh; *((u32x2*)(H2 + (size_t)row * 2048 + 1024) + lane + 64 * j) = ol; }
    }
}

__device__ __forceinline__ void phase11(const Args& A, unsigned char* lds_, const int wave) {
    const int lane = lane_opaque();
    LAS int* sE = (LAS int*)((LAS unsigned char*)lds_ + wave * 1024); LAS float* sW = (LAS float*)(sE + 128);
    LAS int* hcnt = (LAS int*)((LAS unsigned char*)lds_ + 8192); LAS int* hbase = hcnt + NE;
    { const int t_ = wave * 64 + lane; if (t_ < NE) hcnt[t_] = 0; } __syncthreads();
    const int gw = blockIdx.x * NWAVES + wave, NGW = gridDim.x * NWAVES;
    unsigned char* ws = A.ws;
    const float* RLOG = (const float*)(ws + WS_RLOG); const float* bias = A.in[13];
    float* EW = (float*)(ws + WS_EW); int* LIST = (int*)(ws + WS_LIST); int* CNT = (int*)(ws + WS_CTL) + CW_CNT;
    const float NINF = -__builtin_inff();
    const int half = lane >> 5;
    float lgn[4];
#pragma unroll
    for (int j = 0; j < 4; ++j) { const int e = lane + 64 * j; lgn[j] = (gw < T) ? RLOG[(size_t)gw * 512 + e] + RLOG[(size_t)gw * 512 + 256 + e] : 0.f; }
    int it = 0;
    for (int row = gw; row < T; row += NGW, ++it) {
        float sc[4], bv[4];
#pragma unroll
        for (int j = 0; j < 4; ++j) { const int e = lane + 64 * j; const float lg = lgn[j];
            sc[j] = 1.f / (1.f + expf(-lg)); bv[j] = sc[j] + bias[e]; }
        if (row + NGW < T) {
#pragma unroll
            for (int j = 0; j < 4; ++j) { const int e = lane + 64 * j; lgn[j] = RLOG[(size_t)(row + NGW) * 512 + e] + RLOG[(size_t)(row + NGW) * 512 + 256 + e]; } }
        float gs[8];
#pragma unroll
        for (int j = 0; j < 4; ++j) { float m1l, m1h; half_max_dpp(bv[j], m1l, m1h); const float m1 = half ? m1h : m1l;
            const unsigned long long bal = __ballot(bv[j] == m1); const int fl = __ffs((unsigned)bal) - 1, fh = __ffs((unsigned)(bal >> 32)) - 1;
            const float v2 = ((lane & 31) == (half ? fh : fl)) ? NINF : bv[j]; float m2l, m2h; half_max_dpp(v2, m2l, m2h);
            gs[2 * j] = m1l + m2l; gs[2 * j + 1] = m1h + m2h; }
        unsigned gmask = 0u;
#pragma unroll
        for (int g = 0; g < 8; ++g) { int rank = 0;
#pragma unroll
            for (int o = 0; o < 8; ++o) rank += (gs[o] > gs[g] || (gs[o] == gs[g] && o < g)) ? 1 : 0;
            if (rank < 4) gmask |= 1u << g; }
        float val[4];
#pragma unroll
        for (int j = 0; j < 4; ++j) val[j] = ((gmask >> (half + 2 * j)) & 1u) ? bv[j] : NINF;
        int ei[8]; float ew[8]; float wsum = 0.f;
#pragma unroll
        for (int r = 0; r < 8; ++r) {
            const float lm = fmaxf(fmaxf(val[0], val[1]), fmaxf(val[2], val[3])); const float m = wave_max_dpp(lm);
            const unsigned long long b0 = __ballot(val[0] == m), b1 = __ballot(val[1] == m), b2 = __ballot(val[2] == m), b3 = __ballot(val[3] == m);
            const int js = b0 ? 0 : b1 ? 1 : b2 ? 2 : 3; const unsigned long long bs = b0 ? b0 : b1 ? b1 : b2 ? b2 : b3;
            const int ls = __ffsll((long long)bs) - 1; const int es = ls + 64 * js;
            const float mys = js == 0 ? sc[0] : js == 1 ? sc[1] : js == 2 ? sc[2] : sc[3];
            const float w = rdl_f(mys, ls);
#pragma unroll
            for (int j = 0; j < 4; ++j) val[j] = (lane == ls && js == j) ? NINF : val[j];
            ei[r] = es; ew[r] = w; wsum += w; }
        int my_e = 0; float my_w = 0.f;
#pragma unroll
        for (int r = 0; r < 8; ++r) if (lane == r) { my_e = ei[r]; my_w = ew[r] / wsum * 2.5f; }
        if (lane < 8) { sE[it * 8 + lane] = my_e; sW[it * 8 + lane] = my_w; }
    }
    LDS_WAIT();
    int eL[2], rkL[2], entL[2]; bool actL[2];
#pragma unroll
    for (int h = 0; h < 2; ++h) { const int p = lane + 64 * h, ti = p >> 3; const int row = gw + ti * NGW;
        actL[h] = ti < it; eL[h] = 0; rkL[h] = 0; entL[h] = row * 8 + (p & 7);
        if (actL[h]) { eL[h] = sE[p]; EW[entL[h]] = sW[p]; rkL[h] = __hip_atomic_fetch_add(hcnt + eL[h], 1, __ATOMIC_RELAXED, __HIP_MEMORY_SCOPE_WORKGROUP); } }
    __syncthreads();
    { const int t_ = wave * 64 + lane; if (t_ < NE) { const int c = hcnt[t_]; hbase[t_] = c > 0 ? atomicAdd(&CNT[t_ * CNT_STRIDE], c) : 0; } }
    __syncthreads();
#pragma unroll
    for (int h = 0; h < 2; ++h) if (actL[h]) LIST[(size_t)eL[h] * T + hbase[eL[h]] + rkL[h]] = entL[h];
}

__device__ __forceinline__ int moe_tables(const Args& A, unsigned char* lds_, const int wave) {
    LAS int* cnt = (LAS int*)((LAS unsigned char*)lds_ + TAB_OFF); LAS int* tstart = cnt + 264;
    const int* CNT = (const int*)(A.ws + WS_CTL) + CW_CNT;
    const int tid = wave * 64 + lane_opaque();
    if (tid < NE) cnt[tid] = __hip_atomic_load(CNT + tid * CNT_STRIDE, __ATOMIC_RELAXED, __HIP_MEMORY_SCOPE_AGENT);
    if (tid == NE) cnt[NE] = T;
    __syncthreads();
    if (wave == 0) {
        const int l = tid; const u32x4 c4 = *(const LAS u32x4*)(cnt + 4 * l);
        const int t0 = (int)(c4.x + 255u) >> 8, t1 = (int)(c4.y + 255u) >> 8, t2 = (int)(c4.z + 255u) >> 8, t3 = (int)(c4.w + 255u) >> 8, loc = (t0 + t1) + (t2 + t3);
        int p = loc;
        p += idx::dpp_i0<0x111>(p); p += idx::dpp_i0<0x112>(p); p += idx::dpp_i0<0x114>(p); p += idx::dpp_i0<0x118>(p);
        const int r0 = __builtin_amdgcn_readlane(p, 15), r1 = __builtin_amdgcn_readlane(p, 31), r2 = __builtin_amdgcn_readlane(p, 47);
        const int rr = l >> 4; p += rr == 0 ? 0 : rr == 1 ? r0 : rr == 2 ? r0 + r1 : r0 + r1 + r2;
        const int ex = p - loc;
        *(LAS u32x4*)(tstart + 4 * l) = (u32x4){(unsigned)ex, (unsigned)(ex + t0), (unsigned)(ex + t0 + t1), (unsigned)(ex + t0 + t1 + t2)};
        if (l == 63) { tstart[NE] = p; tstart[NEX] = p + ((T + 255) >> 8); }
    }
    __syncthreads();
    return tstart[NEX];
}


__device__ __forceinline__ void phase14(const Args& A, const int wave) {
    const int lane = lane_opaque();
    const int gw = blockIdx.x * NWAVES + wave, NGW = gridDim.x * NWAVES;
    float* out = A.out; const float* mod = (const float*)(A.ws + WS_MOD); const int* INV = (const int*)(A.ws + WS_INV);
    const unsigned char* CA = (const unsigned char*)(A.ws + WS_CA); const bf16_t* SH = (const bf16_t*)(A.ws + WS_SH); const bf16_t* X1 = (const bf16_t*)(A.ws + WS_X1);
#define P14_LOAD(pr_, row_, w_, x_, g2_) do { _Pragma("unroll") for (int k = 0; k < 8; ++k) { const int p = __builtin_amdgcn_readlane(pr_, k); w_[k] = *((const u32x4*)(CA + (size_t)p * DM) + lane); } \
        _Pragma("unroll") for (int q = 0; q < 4; ++q) g2_[q] = *((const f32x4*)(mod + (size_t)((row_) >> 12) * 6144 + 5120 + 16 * lane) + q); \
        w_[8] = *((const u32x4*)((const unsigned char*)SH + (size_t)(row_) * DM) + lane); \
        w_[10] = *((const u32x4*)(X1 + (size_t)(row_) * DM + 16 * lane)); w_[11] = *((const u32x4*)(X1 + (size_t)(row_) * DM + 16 * lane) + 1); } while (0)
#define P14_FIN(row_, w_, x_, g2_) do { float* orow = out + (size_t)(row_) * DM + 16 * lane; \
        float y[16]; _Pragma("unroll") for (int q = 0; q < 16; ++q) y[q] = 0.f; \
        _Pragma("unroll") for (int k = 0; k < 8; ++k) _Pragma("unroll") for (int d = 0; d < 4; ++d) { \
            const f32x2 lo = __builtin_amdgcn_cvt_pk_f32_fp8((int)w_[k][d], false), hi = __builtin_amdgcn_cvt_pk_f32_fp8((int)w_[k][d], true); \
            y[4 * d] += lo[0]; y[4 * d + 1] += lo[1]; y[4 * d + 2] += hi[0]; y[4 * d + 3] += hi[1]; } \
        float ysh[16]; _Pragma("unroll") for (int d = 0; d < 4; ++d) { \
            const f32x2 lo = __builtin_amdgcn_cvt_pk_f32_fp8((int)w_[8][d], false), hi = __builtin_amdgcn_cvt_pk_f32_fp8((int)w_[8][d], true); \
            ysh[4 * d] = lo[0]; ysh[4 * d + 1] = lo[1]; ysh[4 * d + 2] = hi[0]; ysh[4 * d + 3] = hi[1]; } \
        float v[16]; float s = 0.f; \
        _Pragma("unroll") for (int q = 0; q < 4; ++q) { const f32x4 g = g2_[q]; \
            _Pragma("unroll") for (int e = 0; e < 4; ++e) { const unsigned xw = w_[10 + (q >> 1)][2 * (q & 1) + (e >> 1)]; \
                const float xv = (e & 1) ? bfhi(xw) : bflo(xw); \
                v[4 * q + e] = xv + g[e] * (y[4 * q + e] * (1.f / 16.f) + ysh[4 * q + e] * 0.25f); s += v[4 * q + e] * v[4 * q + e]; } } \
        const float rstd = 1.f / sqrtf(wave_sum_dpp(s) * (1.f / DM) + EPS); \
        _Pragma("unroll") for (int q = 0; q < 4; ++q) { const f32x4 g = gfin[q]; \
            *((f32x4*)orow + q) = (f32x4){v[4 * q] * rstd * g[0], v[4 * q + 1] * rstd * g[1], v[4 * q + 2] * rstd * g[2], v[4 * q + 3] * rstd * g[3]}; } } while (0)
    f32x4 gfin[4];
#pragma unroll
    for (int q = 0; q < 4; ++q) gfin[q] = *((const f32x4*)(A.in[20] + 16 * lane) + q);
    int prA = (gw < T) ? INV[(size_t)gw * 8 + (lane & 7)] : 0, prB = (gw + NGW < T) ? INV[(size_t)(gw + NGW) * 8 + (lane & 7)] : 0;
    for (int row = gw; row < T; row += 2 * NGW) {
        const int rowB = row + NGW; const bool hasB = rowB < T;
        const int pa = prA, pb = prB;
        if (row + 2 * NGW < T) prA = INV[(size_t)(row + 2 * NGW) * 8 + (lane & 7)];
        if (row + 3 * NGW < T) prB = INV[(size_t)(row + 3 * NGW) * 8 + (lane & 7)];
        u32x4 wa[12], wb[12]; f32x4 xa[4], xb[4], ga[4], gb[4];
        P14_LOAD(pa, row, wa, xa, ga);
        if (hasB) P14_LOAD(pb, rowB, wb, xb, gb);
        P14_FIN(row, wa, xa, ga);
        if (hasB) P14_FIN(rowB, wb, xb, gb);
    }
#undef P14_LOAD
#undef P14_FIN
}

__global__ void __launch_bounds__(NTHR, 2) fwd(Args args) {
    extern __shared__ __attribute__((aligned(16))) unsigned char lds[];
    const int wave = __builtin_amdgcn_readfirstlane((int)threadIdx.x >> 6);
    volatile LAS unsigned* MISC = (volatile LAS unsigned*)((LAS unsigned char*)lds + MISC_OFF);
    if (wave == 0) MISC[lane_opaque()] = 0u;
    __syncthreads();
    const int lo = args.ph_lo, hi = args.ph_hi;
    unsigned char* ws = args.ws;
    XcdBarrier bar; bar.bar = (unsigned*)(ws + WS_CTL); bar.x = 0; bar.st = nullptr;
    if (hi - lo > 1) bar = xcd_barrier_post((unsigned*)(ws + WS_CTL), MISC, wave == 0 && lane_opaque() == 0);
    const int G = gridDim.x, cid = blockIdx.x;
#define IN(k) (lo <= (k) && (k) < hi)
#define SEAM(k) do { if (IN(k) && IN((k) + 1)) xcd_barrier(bar, wave); } while (0)
    LAS unsigned char* ring = (LAS unsigned char*)lds;

    if (IN(0)) { phase0(args, lds, wave); __syncthreads(); } SEAM(0);
    if (IN(1)) { phase1(args, wave); } SEAM(1);
    if (IN(2)) {
        pg8::DenseSched S; S.init(ws + WS_H, 2048u, ws + WS_WIN, 2048u, T, NPROJP, G, cid);
        pg8::EpiProjFused E{(bf16_t*)(ws + WS_QM), (bf16_t*)(ws + WS_KM), (bf16_t*)(ws + WS_VM), (bf16_t*)(ws + WS_QD), (bf16_t*)(ws + WS_CKVN), (float*)(ws + WS_KVRAW),
                            (f16_t*)(ws + WS_QI), (f16_t*)(ws + WS_KI), (float*)(ws + WS_WI), (const float*)(ws + WS_COSH), (const float*)(ws + WS_SINH), (const float*)(ws + WS_COSI), (const float*)(ws + WS_SINI)};
        pg8::gemm_phase<pg8::EpiProjFused, pg8::DenseSched, true>(ring, S, E, 1024, wave);
    }
    if (IN(2) && IN(4)) xcd_barrier(bar, wave);
    if (IN(4)) {
        const int ngemm = T / 256;
        if (G > ngemm && cid >= ngemm) kmean_units(args, lds, wave, cid - ngemm, G - ngemm);
        else {
            pg8::DenseSched S; S.init(ws + WS_CKVN, 512u, ws + WS_WKV, 512u, T, 256, G, cid);
            pg8::EpiKV E{(bf16_t*)(ws + WS_KD), (bf16_t*)(ws + WS_VD), (const float*)(ws + WS_KVRAW), (const float*)(ws + WS_COSH), (const float*)(ws + WS_SINH)};
            pg8::gemm_phase<pg8::EpiKV, pg8::DenseSched, true>(ring, S, E, 256, wave);
            if (G <= ngemm) { __syncthreads(); kmean_units(args, lds, wave, cid, G); }
        }
    }
    if (IN(4) && IN(6)) xcd_barrier(bar, wave);
    if (IN(6)) { phase6(args, lds, wave); __syncthreads(); }
    if (IN(6) && IN(8)) xcd_barrier(bar, wave);
    if (IN(8)) {
        pg8::DenseSched S; S.init(ws + WS_H, 2048u, ws + WS_WOUT, 2048u, T, 1024, G, cid);
        pg8::EpiResidNorm E{args.in[0], (bf16_t*)(ws + WS_X1), (const float*)(ws + WS_MOD), (const float*)(ws + WS_OM), (LAS float*)((LAS unsigned char*)lds + TOK_OFF)};
        pg8::gemm_phase<pg8::EpiResidNorm, pg8::DenseSched, true, true>(ring, S, E, 1024, wave);
    } SEAM(8);
    if (IN(9)) { phase9(args, wave); } SEAM(9);
    if (IN(10)) {
        pg8::DenseSched S; S.init(ws + WS_H2, 4096u, ws + WS_WR, 4096u, T, 512, G, cid);
        pg8::EpiF32 E{(float*)(ws + WS_RLOG), 512};
        pg8::gemm_phase<pg8::EpiF32, pg8::DenseSched, true>(ring, S, E, 2048, wave);
    } SEAM(10);
    if (IN(11)) { phase11(args, lds, wave); } SEAM(11);
    if (IN(12)) {
        const int total_rt = moe_tables(args, lds, wave);
        pg8::MoeTab tb{(const LAS int*)((LAS unsigned char*)lds + TAB_OFF), (const LAS int*)((LAS unsigned char*)lds + TAB_OFF) + 264};
        LAS int* tokl = (LAS int*)((LAS unsigned char*)lds + TOK_OFF);
        LAS int* utab = (LAS int*)((LAS unsigned char*)lds + TAB_OFF) + 528;
        pg8::MoeUpSched S{tb, (const char*)(ws + WS_H2), tokl, (const char*)(ws + WS_WGU), 2048u, total_rt * 2, G, cid, utab};
        { const int t_ = wave * 64 + lane_opaque(); if (t_ < pg8::UT_MAX) { pg8::Unit u; const bool ok = S.compute(t_, u); *(LAS u32x4*)(utab + 4 * t_) = ok ? (u32x4){(unsigned)u.e, (unsigned)u.rt, (unsigned)(u.pn | ((u.e == NE ? 256 : (tb.cnt[u.e] - u.pm * 256 < 256 ? tb.cnt[u.e] - u.pm * 256 : 256)) << 8)), (unsigned)u.pm} : (u32x4){~0u, 0u, 0u, 0u}; } __syncthreads(); }
        {
            const int lane = lane_opaque(), tid = wave * 64 + lane, half = tid >> 8, row = tid & 255;
            const int* list = (const int*)(ws + WS_LIST); const float* ew = (const float*)(ws + WS_EW); int* inv = (int*)(ws + WS_INV);
            int ue = -1, upm = 0, urt = 0;
            { pg8::Unit u; if (lane < MAX_UNITS && S.next(lane, u)) { ue = u.e; upm = u.pm; urt = u.rt; } }
            const int nun = __popcll(__ballot(ue >= 0));
            for (int i0 = 0; i0 < MAX_UNITS / 2; i0 += 5) {
                int ent[5], ke[5], kpos[5], krt[5]; bool val[5];
#pragma unroll
                for (int jj = 0; jj < 5; ++jj) { const int k = half + 2 * (i0 + jj), kc = k < MAX_UNITS ? k : 0;
                    ke[jj] = __builtin_amdgcn_readlane(ue, kc); krt[jj] = __builtin_amdgcn_readlane(urt, kc); kpos[jj] = __builtin_amdgcn_readlane(upm, kc) * 256 + row;
                    val[jj] = k < nun && ke[jj] != NE && kpos[jj] < tb.cnt[ke[jj] < 0 ? 0 : ke[jj]];
                    ent[jj] = list[(size_t)(val[jj] ? ke[jj] : 0) * T + (val[jj] ? kpos[jj] : 0)]; }
                float wv[5];
#pragma unroll
                for (int jj = 0; jj < 5; ++jj) { ent[jj] = val[jj] ? ent[jj] : 0; wv[jj] = ew[ent[jj]]; }
#pragma unroll
                for (int jj = 0; jj < 5; ++jj) { const int k = half + 2 * (i0 + jj);
                    if (k < nun) { unsigned tw = 0u;
                        if (ke[jj] == NE) tw = (unsigned)kpos[jj] | 0x3C000000u;
                        else if (val[jj]) { const f16_t wh = (f16_t)wv[jj]; tw = (unsigned)(ent[jj] >> 3) | ((unsigned)__builtin_bit_cast(unsigned short, wh) << 16); inv[ent[jj]] = krt[jj] * 256 + row; }
                        tokl[k * 256 + row] = (int)tw; } }
            }
            __syncthreads();
        }
        pg8::EpiAct E{(bf16_t*)(ws + WS_ACT), tokl};
        pg8::gemm_phase<pg8::EpiAct, pg8::MoeUpSched, true>(ring, S, E, 1024, wave);
    } SEAM(12);
    if (IN(13)) {
        const int total_rt = moe_tables(args, lds, wave);
        pg8::MoeTab tb{(const LAS int*)((LAS unsigned char*)lds + TAB_OFF), (const LAS int*)((LAS unsigned char*)lds + TAB_OFF) + 264};
        LAS int* utab = (LAS int*)((LAS unsigned char*)lds + TAB_OFF) + 528;
        pg8::MoeDownSched S{tb, (const char*)(ws + WS_ACT), (const char*)(ws + WS_WD), 512u, total_rt * 4, G, cid, utab};
        { const int t_ = wave * 64 + lane_opaque(); if (t_ < pg8::UT_MAX) { pg8::Unit u; const bool ok = S.compute(t_, u); *(LAS u32x4*)(utab + 4 * t_) = ok ? (u32x4){(unsigned)u.e, (unsigned)u.rt, (unsigned)(u.pn | ((u.e == NE ? 256 : (tb.cnt[u.e] - u.pm * 256 < 256 ? tb.cnt[u.e] - u.pm * 256 : 256)) << 8)), (unsigned)u.pm} : (u32x4){~0u, 0u, 0u, 0u}; } __syncthreads(); }
        pg8::EpiDown E{(bf16_t*)(ws + WS_CA), (bf16_t*)(ws + WS_SH)};
        pg8::gemm_phase<pg8::EpiDown, pg8::MoeDownSched, true>(ring, S, E, 256, wave);
    } SEAM(13);
    if (IN(14)) { phase14(args, wave); }
#undef IN
#undef SEAM
}

#ifndef N_LAUNCHES
#define N_LAUNCHES 1
#endif
extern "C" void kernel_launch(void* const* d_in, const int* in_sizes, int n_in, void* d_out, int out_size, void* d_ws, size_t ws_size, hipStream_t stream) {
    static int grid = 0;
    if (grid == 0) {
        if (n_in != 21 || in_sizes[0] != T * DM || out_size != T * DM || ws_size < WS_END) {
            fprintf(stderr, "kernel_launch: shape/workspace mismatch (n_in %d, in0 %d, out %d, ws %zu, need %zu); nothing launched\n", n_in, n_in > 0 ? in_sizes[0] : -1, out_size, ws_size, (size_t)WS_END); grid = -1; return; }
        int dev = 0, cus = 0, per_cu = 0;
        if (hipGetDevice(&dev) != hipSuccess || hipDeviceGetAttribute(&cus, hipDeviceAttributeMultiprocessorCount, dev) != hipSuccess) { grid = -1; return; }
        if (hipFuncSetAttribute((const void*)fwd, hipFuncAttributeMaxDynamicSharedMemorySize, LDS_BYTES) != hipSuccess) { fprintf(stderr, "kernel_launch: hipFuncSetAttribute failed\n"); grid = -1; return; }
        if (hipOccupancyMaxActiveBlocksPerMultiprocessor(&per_cu, (const void*)fwd, NTHR, LDS_BYTES) != hipSuccess || per_cu < 1) fprintf(stderr, "kernel_launch: occupancy query says %d\n", per_cu);
        (void)hipGetLastError();
        grid = cus;
    }
    if (grid < 0) return;
    (void)hipMemsetAsync((char*)d_ws + WS_CTL, 0, CTL_ZERO_BYTES, stream);
    Args a{};
    for (int i = 0; i < 21; ++i) a.in[i] = (const float*)d_in[i];
    a.out = (float*)d_out; a.ws = (unsigned char*)d_ws;
    if (N_LAUNCHES == 1) { a.ph_lo = 0; a.ph_hi = NPHASE; hipLaunchKernelGGL(fwd, dim3(grid), dim3(NTHR), LDS_BYTES, stream, a); }
    else for (int p = 0; p < NPHASE; ++p) { a.ph_lo = p; a.ph_hi = p + 1; hipLaunchKernelGGL(fwd, dim3(grid), dim3(NTHR), LDS_BYTES, stream, a); }
}
```

```cpp
#include <hip/hip_runtime.h>
#include <cstdio>
#include <cstdint>

#define GAS __attribute__((address_space(1)))
#define LAS __attribute__((address_space(3)))
typedef unsigned short bf16_t;
typedef short bf16x8 __attribute__((ext_vector_type(8)));
typedef float f32x4 __attribute__((ext_vector_type(4)));
typedef float f32x2 __attribute__((ext_vector_type(2)));
typedef unsigned u32x4 __attribute__((ext_vector_type(4)));
typedef unsigned u32x2 __attribute__((ext_vector_type(2)));
typedef _Float16 f16_t;

constexpr int NB = 8, SEQ = 4096, T = NB * SEQ, DM = 1024;
constexpr int NPROJ = 2888, NPROJP = 3072;
constexpr int NE = 256, NEX = 257;
constexpr int NWAVES = 8, NTHR = 512;
constexpr float EPS = 1e-6f;
constexpr int NPHASE = 15;

constexpr size_t MiB = 1u << 20;
constexpr size_t WS_CTL = 0, CTL_ZERO_BYTES = 65536;
constexpr int CW_CNT = 4096, CNT_STRIDE = 32;
constexpr size_t WS_MOD = 1 * MiB;
constexpr size_t WS_KMEAN = 1 * MiB + 256 * 1024;
constexpr size_t WS_COSH = 2 * MiB, WS_SINH = WS_COSH + 256 * 1024, WS_COSI = WS_SINH + 256 * 1024, WS_SINI = WS_COSI + 128 * 1024;
constexpr size_t WS_WIN = 4 * MiB;
constexpr size_t WS_WOUT = 10 * MiB;
constexpr size_t WS_WR = 12 * MiB;
constexpr size_t WS_WKV = 14 * MiB;
constexpr size_t WS_WD = 16 * MiB;
constexpr size_t WS_WGU = 145 * MiB;
constexpr size_t WS_H = 402 * MiB;
constexpr size_t WS_KS = 466 * MiB;
constexpr size_t WS_QM = 706 * MiB, WS_KM = 738 * MiB, WS_VM = 770 * MiB, WS_QD = 802 * MiB;
constexpr size_t WS_MASK = 834 * MiB;
constexpr size_t WS_CKVN = 834 * MiB, WS_KVRAW = 850 * MiB, WS_KD = 866 * MiB, WS_VD = 874 * MiB;
constexpr size_t WS_QI = 896 * MiB, WS_KI = 928 * MiB, WS_WI = 932 * MiB, WS_OM = 936 * MiB;
constexpr size_t WS_H2 = 402 * MiB;
constexpr size_t WS_SH = 530 * MiB;
constexpr size_t WS_RLOG = 530 * MiB;
constexpr size_t WS_EW = 835 * MiB, WS_LIST = 836 * MiB;
constexpr size_t WS_ACT = 658 * MiB;
constexpr size_t WS_CA = 145 * MiB;
constexpr size_t WS_INV = 834 * MiB;
constexpr size_t WS_X1 = 944 * MiB;
constexpr size_t WS_END = 1024 * MiB;
static_assert(WS_WD + (size_t)NEX * 1024 * 256 * 2 <= WS_WGU && WS_WGU + (size_t)NEX * 512 * 1024 * 2 <= WS_H, "weights map");
static_assert(WS_LIST + (size_t)NE * T * 4 <= WS_KD + 16 * MiB && WS_ACT + 360448ull * 512 <= WS_INV, "moe map");

constexpr int RING_BYTES = 131072;
constexpr int MISC_OFF = 157 * 1024;
constexpr int TAB_OFF = MISC_OFF + 256;
constexpr int TOK_OFF = RING_BYTES, MAX_UNITS = 20;
static_assert(TOK_OFF + MAX_UNITS * 1024 <= MISC_OFF, "lds map");
constexpr int LDS_BYTES = 160 * 1024;

__device__ __forceinline__ unsigned f2bf(float f) { unsigned u = __builtin_bit_cast(unsigned, f); return (u + 0x7fffu + ((u >> 16) & 1u)) >> 16; }
__device__ __forceinline__ float bf2f(unsigned h) { return __builtin_bit_cast(float, h << 16); }
__device__ __forceinline__ unsigned pk2(float lo, float hi) { unsigned r; asm("v_cvt_pk_bf16_f32 %0, %1, %2" : "=v"(r) : "v"(lo), "v"(hi)); return r; }
__device__ __forceinline__ float bflo(unsigned w) { return __builtin_bit_cast(float, w << 16); }
__device__ __forceinline__ float bfhi(unsigned w) { return __builtin_bit_cast(float, w & 0xffff0000u); }
__device__ __forceinline__ int lane_opaque() { int l; asm volatile("v_mbcnt_lo_u32_b32 %0, -1, 0\n\tv_mbcnt_hi_u32_b32 %0, -1, %0" : "=v"(l)); return l; }


template <int CTRL> __device__ __forceinline__ float dpp_mov_f(float v) { return __builtin_bit_cast(float, __builtin_amdgcn_update_dpp(__builtin_bit_cast(int, v), __builtin_bit_cast(int, v), CTRL, 0xF, 0xF, false)); }
__device__ __forceinline__ float row_max16(float v) {
    v = fmaxf(v, dpp_mov_f<0xB1>(v)); v = fmaxf(v, dpp_mov_f<0x4E>(v)); v = fmaxf(v, dpp_mov_f<0x141>(v)); v = fmaxf(v, dpp_mov_f<0x140>(v)); return v;
}
__device__ __forceinline__ float rdl_f(float v, int l) { return __builtin_bit_cast(float, __builtin_amdgcn_readlane(__builtin_bit_cast(int, v), l)); }
__device__ __forceinline__ float wave_sum_dpp(float v) {
    v += dpp_mov_f<0xB1>(v); v += dpp_mov_f<0x4E>(v); v += dpp_mov_f<0x141>(v); v += dpp_mov_f<0x140>(v);
    return (rdl_f(v, 0) + rdl_f(v, 16)) + (rdl_f(v, 32) + rdl_f(v, 48));
}
__device__ __forceinline__ float wave_max_dpp(float v) { v = row_max16(v); return fmaxf(fmaxf(rdl_f(v, 0), rdl_f(v, 16)), fmaxf(rdl_f(v, 32), rdl_f(v, 48))); }
__device__ __forceinline__ void half_max_dpp(float v, float& lo, float& hi) { v = row_max16(v); lo = fmaxf(rdl_f(v, 0), rdl_f(v, 16)); hi = fmaxf(rdl_f(v, 32), rdl_f(v, 48)); }
#define VM_WAIT() asm volatile("s_waitcnt vmcnt(0)" ::: "memory")
#define LDS_WAIT() asm volatile("s_waitcnt lgkmcnt(0)" ::: "memory")

struct Args { const float* in[21]; float* out; unsigned char* ws; int ph_lo, ph_hi; };

#define XB_TMO      128
#define XB_XCNT(j)  (256  + 64 * (j))
#define XB_XSUB(j)  (1280 + 64 * (j))
#define XB_XGEN(j)  (2304 + 64 * (j))
#define XB_TOP      3328
#define XB_TOPGEN   3392
#define XCD_BAR_WORDS 3456
#define XB_SPIN_CAP (1u << 22)
__device__ __forceinline__ unsigned xb_ld(unsigned* p)              { return __hip_atomic_load(p, __ATOMIC_RELAXED, __HIP_MEMORY_SCOPE_AGENT); }
__device__ __forceinline__ unsigned xb_add(unsigned* p, unsigned v) { return __hip_atomic_fetch_add(p, v, __ATOMIC_RELAXED, __HIP_MEMORY_SCOPE_AGENT); }
__device__ __forceinline__ unsigned xb_xcc_id() { return (unsigned)__builtin_amdgcn_s_getreg((3 << 11) | 20) & 0xFu; }
#define XB_SPIN(cond, bar) do { unsigned _sp = 0; while (cond) { __builtin_amdgcn_s_sleep(1); \
    if ((++_sp & 255u) == 0u) { if (xb_ld(&(bar)[XB_TMO])) break; if (_sp > XB_SPIN_CAP) { atomicAdd(&(bar)[XB_TMO], 1u); break; } } } } while (0)
struct XcdBarrier { unsigned* bar; unsigned x; volatile LAS unsigned* st; };
__device__ __forceinline__ XcdBarrier xcd_barrier_post(unsigned* bar, volatile LAS unsigned* st, bool t0) {
    XcdBarrier b; b.bar = bar; b.x = xb_xcc_id(); b.st = st;
    if (t0) (void)xb_add(&bar[XB_XCNT(b.x)], 1u);
    return b;
}
__device__ __forceinline__ void xcd_barrier_complete(unsigned* bar, unsigned x, unsigned& nloc, unsigned& nx) {
    const unsigned G = gridDim.x * gridDim.y * gridDim.z;
    unsigned sum, cnt, mine, sp = 0u;
    for (;;) {
        sum = 0u; cnt = 0u; mine = 0u;
#pragma unroll
        for (unsigned j = 0; j < 16; ++j) { const unsigned c = xb_ld(&bar[XB_XCNT(j)]); sum += c; cnt += (c > 0u) ? 1u : 0u; mine = (j == x) ? c : mine; }
        if (sum == G) break;
        __builtin_amdgcn_s_sleep(1);
        if ((++sp & 255u) == 0u) { if (xb_ld(&bar[XB_TMO])) break; if (sp > XB_SPIN_CAP) { atomicAdd(&bar[XB_TMO], 1u); break; } }
    }
    nloc = mine > 0u ? mine : 1u; nx = cnt > 0u ? cnt : 1u;
}
__device__ __forceinline__ void xcd_barrier(const XcdBarrier& b, int wave) {
    asm volatile("s_waitcnt vmcnt(0)" ::: "memory");
    __syncthreads();
    if (wave == 0 && lane_opaque() == 0) {
        unsigned* bar = b.bar;
        __builtin_amdgcn_s_waitcnt(0);
        unsigned nloc = b.st[0], nx = b.st[1];
        if (nloc == 0u) { xcd_barrier_complete(bar, b.x, nloc, nx); b.st[0] = nloc; b.st[1] = nx; }
        const unsigned old = xb_add(&bar[XB_XSUB(b.x)], 1u);
        const unsigned gen = old / nloc;
        if (old + 1u == (gen + 1u) * nloc) {
            __builtin_amdgcn_fence(__ATOMIC_RELEASE, "agent");
            asm volatile("s_waitcnt vmcnt(0)" ::: "memory");
            const unsigned og = xb_add(&bar[XB_TOP], 1u);
            const unsigned tg = og / nx;
            if (og + 1u == (tg + 1u) * nx) xb_add(&bar[XB_TOPGEN], 1u);
            else XB_SPIN(xb_ld(&bar[XB_TOPGEN]) == tg, bar);
            __builtin_amdgcn_fence(__ATOMIC_ACQUIRE, "agent");
            xb_add(&bar[XB_XGEN(b.x)], 1u);
            asm volatile("s_waitcnt vmcnt(0)" ::: "memory");
        } else {
            XB_SPIN(xb_ld(&bar[XB_XGEN(b.x)]) == gen, bar);
            __builtin_amdgcn_fence(__ATOMIC_ACQUIRE, "agent");
            asm volatile("s_waitcnt vmcnt(0)" ::: "memory");
        }
    }
    __syncthreads();
}

namespace pg8 {
constexpr int BM = 256, BK = 64, HALF = 128, HTB = HALF * BK * 2, NXCD = 8, WGM = 8;
__host__ __device__ __forceinline__ int lds_byte(int r, int c) { const int st = (r >> 4) * 2 + (c >> 5), rr = r & 15, cc = c & 31, ob = rr * 64 + cc * 2; return st * 1024 + (ob ^ (((ob >> 9) & 1) << 5)); }
__host__ __device__ __forceinline__ void stage_rc(int b, int& R, int& C) { const int st = b / 1024, sb = b % 1024, swz = sb ^ (((sb >> 9) & 1) << 5); R = (st >> 1) * 16 + swz / 64; C = (st & 1) * 32 + (swz % 64) / 2; }
__host__ __device__ __forceinline__ int perm32(int rho) { const int n = rho >> 4, i = rho & 15; return 8 * (i >> 2) + 4 * n + (i & 3); }

struct Unit { int pm, pn, e, rt, slot; };

struct DenseSched {
    const char* A; const char* B; unsigned lda, ldb; int nM, nN, nwg, G, c;
    __device__ __forceinline__ void init(const void* A_, unsigned lda_, const void* B_, unsigned ldb_, int M, int N, int G_, int c_) { A = (const char*)A_; B = (const char*)B_; lda = lda_; ldb = ldb_; nM = M / BM; nN = N / BM; nwg = nM * nN; G = G_; c = c_; }
    __device__ __forceinline__ bool next(int i, Unit& u) const {
        const long L = (long)i * G + c; if (L >= nwg) return false;
        int wgid = (int)L; { const int q = nwg / NXCD, r = nwg % NXCD, xcd = wgid % NXCD, off = wgid / NXCD; wgid = (xcd < r ? xcd * (q + 1) : r * (q + 1) + (xcd - r) * q) + off; }
        const int nig = WGM * nN, gid = wgid / nig, fm = gid * WGM, gsz = (nM - fm) < WGM ? (nM - fm) : WGM;
        u.pm = fm + ((wgid % nig) % gsz); u.pn = (wgid % nig) / gsz; u.e = 0; u.rt = u.pm; u.slot = i; return true;
    }
    __device__ __forceinline__ const char* a_ubase(const Unit& u) const { return A + (size_t)u.pm * BM * lda; }
    __device__ __forceinline__ void a_off(const Unit& u, const int (&R)[2], const int (&C)[2], unsigned (&o)[2][2]) const {
#pragma unroll
        for (int h = 0; h < 2; ++h)
#pragma unroll
            for (int i = 0; i < 2; ++i) o[h][i] = (unsigned)(h * HALF + R[i]) * lda + (unsigned)C[i] * 2u;
    }
    __device__ __forceinline__ const char* b_base(const Unit& u) const { return B + (size_t)u.pn * BM * ldb; }
};

template <class Epi, class Sched, bool ALIGN_EPI, bool MIDHOOK = false>
__device__ __forceinline__ void gemm_phase(LAS unsigned char* lds, const Sched& S, const Epi& E, const int K, const int wid) {
    const int lane = lane_opaque(), tid = wid * 64 + lane, wr = wid >> 2, wc = wid & 3, fr = lane & 15, fq = lane >> 4;
    const int nt = K / BK;
    int Rr[2], Cc[2]; unsigned voffB[2];
#pragma unroll
    for (int i = 0; i < 2; ++i) { int R, C; stage_rc(tid * 16 + i * 8192, R, C); Rr[i] = R; Cc[i] = C; const int Rb = Epi::PERM ? ((R & ~31) + perm32(R & 31)) : R;
        voffB[i] = (unsigned)Rb * S.ldb + (unsigned)C * 2u; }
    const size_t kstep = (size_t)(BK * 2);
    const size_t hstepB = (size_t)HALF * S.ldb;
    const unsigned ldsw = (unsigned)wid * 1024u;
    const int aoff = lds_byte(wr * 64 + fr, fq * 8), boff = lds_byte(wc * 32 + fr, fq * 8);
#define PG8_SA(b, h) (((b) * 2 + (h)) * HTB)
#define PG8_SB(b, h) ((4 + (b) * 2 + (h)) * HTB)
#define PG8_STAGE(bufoff, gbase, voff) do { _Pragma("unroll") for (int _i = 0; _i < 2; ++_i) \
        __builtin_amdgcn_global_load_lds((const unsigned*)((const char*)(gbase) + (voff)[_i]), (LAS unsigned*)(lds + (bufoff) + ldsw + _i * 8192), 16, 0, 0); } while (0)
#define PG8_LDA(dst, b, h) do { _Pragma("unroll") for (int m = 0; m < 4; ++m) _Pragma("unroll") for (int k = 0; k < 2; ++k) dst[m][k] = *(const LAS bf16x8*)(lds + PG8_SA(b, h) + aoff + m * 2048 + k * 1024); } while (0)
#define PG8_LDB(dst, b, h) do { _Pragma("unroll") for (int n = 0; n < 2; ++n) _Pragma("unroll") for (int k = 0; k < 2; ++k) dst[n][k] = *(const LAS bf16x8*)(lds + PG8_SB(b, h) + boff + n * 2048 + k * 1024); } while (0)
#define PG8_MMA(ai, bj, At, Bt) do { __builtin_amdgcn_s_setprio(1); _Pragma("unroll") for (int m = 0; m < 4; ++m) _Pragma("unroll") for (int n = 0; n < 2; ++n) _Pragma("unroll") for (int k = 0; k < 2; ++k) \
        acc[ai][bj][m][n] = __builtin_amdgcn_mfma_f32_16x16x32_bf16(Bt[n][k], At[m][k], acc[ai][bj][m][n], 0, 0, 0); __builtin_amdgcn_s_setprio(0); } while (0)
#define PG8_WAIT_V(n) asm volatile("s_waitcnt vmcnt(" #n ")" ::: "memory")
#define PG8_WAIT_L(n) asm volatile("s_waitcnt lgkmcnt(" #n ")" ::: "memory")
#define PG8_BAR __builtin_amdgcn_s_barrier()
#define PG8_SCHED __builtin_amdgcn_sched_barrier(0)
    Unit cur, nxt; int ui = 0;
    if (!S.next(0, cur)) return;
    if constexpr (MIDHOOK) E.begin(cur, wid);
    f32x4 acc[2][2][4][2];
#pragma unroll
    for (int a = 0; a < 2; ++a)
#pragma unroll
        for (int b = 0; b < 2; ++b)
#pragma unroll
            for (int m = 0; m < 4; ++m)
#pragma unroll
                for (int n = 0; n < 2; ++n) acc[a][b][m][n] = (f32x4){0.f, 0.f, 0.f, 0.f};
    bf16x8 At[4][2], B0[2][2], B1[2][2];
    unsigned oc[2][2];
    S.a_off(cur, Rr, Cc, oc);
    const char* cA = S.a_ubase(cur);
    const char* cB = S.b_base(cur);
    PG8_STAGE(PG8_SB(0, 0), cB, voffB); PG8_STAGE(PG8_SB(0, 1), cB + hstepB, voffB); PG8_STAGE(PG8_SA(0, 0), cA, oc[0]); PG8_STAGE(PG8_SA(0, 1), cA, oc[1]);
    if (wr == 1) PG8_BAR;
    PG8_WAIT_V(2); PG8_BAR;
    PG8_STAGE(PG8_SB(1, 0), cB + kstep, voffB); PG8_STAGE(PG8_SA(1, 0), cA + kstep, oc[0]); PG8_STAGE(PG8_SB(1, 1), cB + hstepB + kstep, voffB);
    PG8_WAIT_V(6); PG8_BAR;
    for (;;) {
        const bool has_next = S.next(ui + 1, nxt);
        if constexpr (MIDHOOK) { if (has_next) E.begin(nxt, wid); }
        const char* nB = has_next ? S.b_base(nxt) : cB; const char* nA = has_next ? S.a_ubase(nxt) : cA;
#pragma nounroll
        for (int t = 0; t < nt; t += 2) {
            const bool last = (t == nt - 2);
            if constexpr (MIDHOOK) { if (t == nt / 2) E.mid(acc, cur, wr, fr); }
            const char* a1 = cA + (size_t)(t + 1) * kstep;
            const char* a2 = last ? nA : cA + (size_t)(t + 2) * kstep; const char* b2 = last ? nB : cB + (size_t)(t + 2) * kstep;
            const char* a3 = a2 + kstep; const char* b3 = b2 + kstep;
            PG8_LDB(B0, 0, 0); PG8_LDB(B1, 0, 1); PG8_SCHED; PG8_LDA(At, 0, 0); PG8_STAGE(PG8_SA(1, 1), a1, oc[1]);
            if (last && has_next) S.a_off(nxt, Rr, Cc, oc);
            PG8_WAIT_V(8); PG8_WAIT_L(0); PG8_BAR; PG8_MMA(0, 0, At, B0); PG8_MMA(0, 1, At, B1); PG8_BAR; PG8_SCHED;
            PG8_LDA(At, 0, 1); PG8_STAGE(PG8_SB(0, 0), b2, voffB); PG8_STAGE(PG8_SB(0, 1), b2 + hstepB, voffB); PG8_STAGE(PG8_SA(0, 0), a2, oc[0]);
            PG8_WAIT_V(8); PG8_WAIT_L(0); PG8_BAR; PG8_MMA(1, 0, At, B0); PG8_MMA(1, 1, At, B1); PG8_BAR; PG8_SCHED;
            PG8_LDB(B0, 1, 0); PG8_LDB(B1, 1, 1); PG8_SCHED; PG8_LDA(At, 1, 0); PG8_STAGE(PG8_SA(0, 1), a2, oc[1]);
            PG8_WAIT_V(8); PG8_WAIT_L(0); PG8_BAR; PG8_MMA(0, 0, At, B0); PG8_MMA(0, 1, At, B1); PG8_BAR; PG8_SCHED;
            PG8_LDA(At, 1, 1); PG8_STAGE(PG8_SB(1, 0), b3, voffB); PG8_STAGE(PG8_SB(1, 1), b3 + hstepB, voffB); PG8_STAGE(PG8_SA(1, 0), a3, oc[0]);
            PG8_WAIT_V(8); PG8_WAIT_L(0); PG8_BAR; PG8_MMA(1, 0, At, B0); PG8_MMA(1, 1, At, B1); PG8_BAR; PG8_SCHED;
        }
        if constexpr (ALIGN_EPI) { if (wr == 0) PG8_BAR; }
        E(acc, cur, wr, wc, fr, fq);
        if (!has_next) break;
#pragma unroll
        for (int a = 0; a < 2; ++a)
#pragma unroll
            for (int b = 0; b < 2; ++b)
#pragma unroll
                for (int m = 0; m < 4; ++m)
#pragma unroll
                    for (int n = 0; n < 2; ++n) acc[a][b][m][n] = (f32x4){0.f, 0.f, 0.f, 0.f};
        cur = nxt; cB = nB; cA = nA; ++ui;
        if constexpr (ALIGN_EPI) { if (wr == 1) PG8_BAR; }
    }
    PG8_WAIT_V(0);
    if constexpr (!ALIGN_EPI) { if (wr == 0) PG8_BAR; }
    PG8_BAR;
#undef PG8_SA
#undef PG8_SB
#undef PG8_STAGE
#undef PG8_LDA
#undef PG8_LDB
#undef PG8_MMA
#undef PG8_WAIT_V
#undef PG8_WAIT_L
#undef PG8_BAR
#undef PG8_SCHED
}

struct EpiProjFused {
    static constexpr bool PERM = true;
    bf16_t* QM; bf16_t* KM; bf16_t* VM; bf16_t* QD; bf16_t* CKV; float* SSQ; f16_t* QI; f16_t* KI; float* WI;
    const float* cosH; const float* sinH; const float* cosI; const float* sinI;
    __device__ __forceinline__ void operator()(const f32x4 (&acc)[2][2][4][2], const Unit& u, int wr, int wc, int fr, int fq) const {
        typedef _Float16 f16x8v __attribute__((ext_vector_type(8)));
        const int pn = u.pn, rowb = u.pm * BM + wr * 64 + fr;
        if (pn < 8) {
            const int sec = pn >> 1; bf16_t* dstb = sec == 0 ? QM : sec == 1 ? KM : sec == 2 ? VM : QD;
            const bool rope = (sec != 2) && (wc == 0);
            const int i0 = 8 * (fq & 1);
#define EPF_LD(it_, A0, A1, A2, A3) do { const int s_ = (rowb + ((it_) >> 2) * HALF + ((it_) & 3) * 16) & 4095; \
                A0 = *(const f32x4*)(cosH + s_ * 16 + i0); A1 = *(const f32x4*)(cosH + s_ * 16 + i0 + 4); A2 = *(const f32x4*)(sinH + s_ * 16 + i0); A3 = *(const f32x4*)(sinH + s_ * 16 + i0 + 4); } while (0)
            if (rope) {
                f32x4 n0, n1, n2, n3; EPF_LD(0, n0, n1, n2, n3);
#pragma unroll
                for (int it = 0; it < 8; ++it) { const int ai = it >> 2, m = it & 3; const int row = rowb + ai * HALF + m * 16, b = row >> 12, s = row & 4095;
                    const f32x4 c0 = n0, c1 = n1, s0 = n2, s1 = n3;
                    if (it < 7) { EPF_LD(it + 1, n0, n1, n2, n3); __builtin_amdgcn_sched_barrier(0); }
#pragma unroll
                    for (int bj = 0; bj < 2; ++bj) { f32x4 v0 = acc[ai][bj][m][0], v1 = acc[ai][bj][m][1]; f32x4 y0, y1;
#pragma unroll
                        for (int j = 0; j < 4; ++j) { y0[j] = __shfl_xor(v0[j], 32); y1[j] = __shfl_xor(v1[j], 32); }
                        const float sg = fq < 2 ? -1.f : 1.f;
                        v0 = v0 * c0 + sg * (y0 * s0); v1 = v1 * c1 + sg * (y1 * s1);
                        u32x4 w; w.x = pk2(v0[0], v0[1]); w.y = pk2(v0[2], v0[3]); w.z = pk2(v1[0], v1[1]); w.w = pk2(v1[2], v1[3]);
                        const int h = 2 * (pn & 1) + bj;
                        *(u32x4*)(dstb + ((size_t)(b * 4 + h) * SEQ + s) * 128 + wc * 32 + 8 * fq) = w; } }
            } else {
#pragma unroll
                for (int it = 0; it < 8; ++it) { const int ai = it >> 2, m = it & 3; const int row = rowb + ai * HALF + m * 16, b = row >> 12, s = row & 4095;
#pragma unroll
                    for (int bj = 0; bj < 2; ++bj) { const f32x4 v0 = acc[ai][bj][m][0], v1 = acc[ai][bj][m][1];
                        u32x4 w; w.x = pk2(v0[0], v0[1]); w.y = pk2(v0[2], v0[3]); w.z = pk2(v1[0], v1[1]); w.w = pk2(v1[2], v1[3]);
                        const int h = 2 * (pn & 1) + bj;
                        *(u32x4*)(dstb + ((size_t)(b * 4 + h) * SEQ + s) * 128 + wc * 32 + 8 * fq) = w; } }
            }
#undef EPF_LD
        } else if (pn == 8) {
#pragma unroll
            for (int ai = 0; ai < 2; ++ai)
#pragma unroll
                for (int m = 0; m < 4; ++m) { const int row = rowb + ai * HALF + m * 16; float ss = 0.f;
#pragma unroll
                    for (int bj = 0; bj < 2; ++bj) { const f32x4 v0 = acc[ai][bj][m][0], v1 = acc[ai][bj][m][1];
                        ss += (v0[0] * v0[0] + v0[1] * v0[1]) + (v0[2] * v0[2] + v0[3] * v0[3]) + (v1[0] * v1[0] + v1[1] * v1[1]) + (v1[2] * v1[2] + v1[3] * v1[3]);
                        u32x4 w; w.x = pk2(v0[0], v0[1]); w.y = pk2(v0[2], v0[3]); w.z = pk2(v1[0], v1[1]); w.w = pk2(v1[2], v1[3]);
                        *(u32x4*)(CKV + (size_t)row * 256 + bj * HALF + wc * 32 + 8 * fq) = w; }
                    ss += __shfl_xor(ss, 16); ss += __shfl_xor(ss, 32);
                    if (fq == 0) SSQ[(size_t)row * 4 + wc] = ss; }
        } else if (pn < 11) {
            const bool rope = (wc & 1) == 0;
#pragma unroll
            for (int ai = 0; ai < 2; ++ai)
#pragma unroll
                for (int m = 0; m < 4; ++m) { const int row = rowb + ai * HALF + m * 16, s = row & 4095;
                    f32x4 c0 = {0.f, 0.f, 0.f, 0.f}, c1 = c0, s0 = c0, s1 = c0;
                    if (rope) { c0 = *(const f32x4*)(cosI + s * 8); c1 = *(const f32x4*)(cosI + s * 8 + 4); s0 = *(const f32x4*)(sinI + s * 8); s1 = *(const f32x4*)(sinI + s * 8 + 4); }
#pragma unroll
                    for (int bj = 0; bj < 2; ++bj) { f32x4 v0 = acc[ai][bj][m][0], v1 = acc[ai][bj][m][1];
                        if (rope) { f32x4 y0, y1;
#pragma unroll
                            for (int j = 0; j < 4; ++j) { y0[j] = __shfl_xor(v0[j], 16); y1[j] = __shfl_xor(v1[j], 16); }
                            if (fq < 2) { const float sg = fq == 0 ? -1.f : 1.f; v0 = v0 * c0 + sg * (y0 * s0); v1 = v1 * c1 + sg * (y1 * s1); } }
                        f16x8v o; o[0] = (f16_t)v0[0]; o[1] = (f16_t)v0[1]; o[2] = (f16_t)v0[2]; o[3] = (f16_t)v0[3]; o[4] = (f16_t)v1[0]; o[5] = (f16_t)v1[1]; o[6] = (f16_t)v1[2]; o[7] = (f16_t)v1[3];
                        *(f16x8v*)(QI + (size_t)row * 512 + (pn - 9) * 256 + bj * HALF + wc * 32 + 8 * fq) = o; } }
        } else {
            if (wc < 2) {
#pragma unroll
                for (int ai = 0; ai < 2; ++ai)
#pragma unroll
                    for (int m = 0; m < 4; ++m) { const int row = rowb + ai * HALF + m * 16, s = row & 4095;
                        f32x4 v0 = acc[ai][0][m][0], v1 = acc[ai][0][m][1];
                        if (wc == 0) { f32x4 y0, y1;
#pragma unroll
                            for (int j = 0; j < 4; ++j) { y0[j] = __shfl_xor(v0[j], 16); y1[j] = __shfl_xor(v1[j], 16); }
                            if (fq < 2) { const f32x4 c0 = *(const f32x4*)(cosI + s * 8), c1 = *(const f32x4*)(cosI + s * 8 + 4), s0 = *(const f32x4*)(sinI + s * 8), s1 = *(const f32x4*)(sinI + s * 8 + 4);
                                const float sg = fq == 0 ? -1.f : 1.f; v0 = v0 * c0 + sg * (y0 * s0); v1 = v1 * c1 + sg * (y1 * s1); } }
                        f16x8v o; o[0] = (f16_t)v0[0]; o[1] = (f16_t)v0[1]; o[2] = (f16_t)v0[2]; o[3] = (f16_t)v0[3]; o[4] = (f16_t)v1[0]; o[5] = (f16_t)v1[1]; o[6] = (f16_t)v1[2]; o[7] = (f16_t)v1[3];
                        *(f16x8v*)(KI + (size_t)(row >> 5) * 2048 + (wc * 4 + fq) * 256 + (row & 31) * 8) = o; }
            } else if (wc == 2 && fq == 0) {
#pragma unroll
                for (int ai = 0; ai < 2; ++ai)
#pragma unroll
                    for (int m = 0; m < 4; ++m) { const int row = rowb + ai * HALF + m * 16; const float k = 0.35355339059327373f;
                        *(f32x4*)(WI + (size_t)row * 8) = acc[ai][0][m][0] * k; *(f32x4*)(WI + (size_t)row * 8 + 4) = acc[ai][0][m][1] * k; }
            }
        }
    }
};
struct EpiKV {
    static constexpr bool PERM = true;
    bf16_t* KD; bf16_t* VD; const float* SSQ; const float* cosH; const float* sinH;
    __device__ __forceinline__ void operator()(const f32x4 (&acc)[2][2][4][2], const Unit& u, int wr, int wc, int fr, int fq) const {
        const int rowb = u.pm * BM + wr * 64 + fr;
        float rs[8];
        { f32x4 q[8];
#pragma unroll
          for (int it = 0; it < 8; ++it) q[it] = *(const f32x4*)(SSQ + (size_t)(rowb + (it >> 2) * HALF + (it & 3) * 16) * 4);
#pragma unroll
          for (int it = 0; it < 8; ++it) rs[it] = 1.f / sqrtf(((q[it][0] + q[it][1]) + (q[it][2] + q[it][3])) * (1.f / 256.f) + EPS); }
        const int i0 = 8 * (fq & 1);
#define EKV_LD(it_, A0, A1, A2, A3) do { const int s_ = (rowb + ((it_) >> 2) * HALF + ((it_) & 3) * 16) & 4095; \
            A0 = *(const f32x4*)(cosH + s_ * 16 + i0); A1 = *(const f32x4*)(cosH + s_ * 16 + i0 + 4); A2 = *(const f32x4*)(sinH + s_ * 16 + i0); A3 = *(const f32x4*)(sinH + s_ * 16 + i0 + 4); } while (0)
#define EKV_ST(v0_, v1_) do { u32x4 w; w.x = pk2(v0_[0], v0_[1]); w.y = pk2(v0_[2], v0_[3]); w.z = pk2(v1_[0], v1_[1]); w.w = pk2(v1_[2], v1_[3]); \
            *(u32x4*)(KD + (size_t)row * 128 + wc * 32 + 8 * fq) = w; \
            const f32x4 u0 = acc[ai][1][m][0] * rstd, u1 = acc[ai][1][m][1] * rstd; \
            u32x4 x; x.x = pk2(u0[0], u0[1]); x.y = pk2(u0[2], u0[3]); x.z = pk2(u1[0], u1[1]); x.w = pk2(u1[2], u1[3]); \
            *(u32x4*)(VD + (size_t)row * 128 + wc * 32 + 8 * fq) = x; } while (0)
        if (wc == 0) {
            f32x4 n0, n1, n2, n3; EKV_LD(0, n0, n1, n2, n3);
#pragma unroll
            for (int it = 0; it < 8; ++it) { const int ai = it >> 2, m = it & 3; const int row = rowb + ai * HALF + m * 16; const float rstd = rs[it];
                const f32x4 c0 = n0, c1 = n1, s0 = n2, s1 = n3;
                if (it < 7) { EKV_LD(it + 1, n0, n1, n2, n3); __builtin_amdgcn_sched_barrier(0); }
                f32x4 v0 = acc[ai][0][m][0] * rstd, v1 = acc[ai][0][m][1] * rstd; f32x4 y0, y1;
#pragma unroll
                for (int j = 0; j < 4; ++j) { y0[j] = __shfl_xor(v0[j], 32); y1[j] = __shfl_xor(v1[j], 32); }
                const float sg = fq < 2 ? -1.f : 1.f; v0 = v0 * c0 + sg * (y0 * s0); v1 = v1 * c1 + sg * (y1 * s1);
                EKV_ST(v0, v1); }
        } else {
#pragma unroll
            for (int it = 0; it < 8; ++it) { const int ai = it >> 2, m = it & 3; const int row = rowb + ai * HALF + m * 16; const float rstd = rs[it];
                const f32x4 v0 = acc[ai][0][m][0] * rstd, v1 = acc[ai][0][m][1] * rstd;
                EKV_ST(v0, v1); }
        }
#undef EKV_LD
#undef EKV_ST
    }
};
struct EpiF32 {
    static constexpr bool PERM = true;
    float* O; int ldc;
    __device__ __forceinline__ void operator()(const f32x4 (&acc)[2][2][4][2], const Unit& u, int wr, int wc, int fr, int fq) const {
        const int row0 = u.pm * BM + wr * 64 + fr, col0 = u.pn * BM + wc * 32 + 8 * fq;
#pragma unroll
        for (int ai = 0; ai < 2; ++ai)
#pragma unroll
            for (int m = 0; m < 4; ++m) { float* rowp = O + (size_t)(row0 + ai * HALF + m * 16) * ldc + col0;
#pragma unroll
                for (int bj = 0; bj < 2; ++bj) { *(f32x4*)(rowp + bj * HALF) = acc[ai][bj][m][0]; *(f32x4*)(rowp + bj * HALF + 4) = acc[ai][bj][m][1]; } }
    }
};

struct EpiResidNorm {
    static constexpr bool PERM = true;
    const float* X; bf16_t* O; const float* mod; const float* SSQO; LAS float* tab;
    __device__ __forceinline__ void begin(const Unit& u, int wid) const {
        const int tid = wid * 64 + lane_opaque();
        if (tid < BM) { const float* p = SSQO + (size_t)(u.pm * BM + tid) * 8; const f32x4 a = *(const f32x4*)p, b = *(const f32x4*)(p + 4);
            const float rm = 1.f / sqrtf(((a[0] + a[1]) + (a[2] + a[3])) * (1.f / 512.f) + EPS), rd = 1.f / sqrtf(((b[0] + b[1]) + (b[2] + b[3])) * (1.f / 512.f) + EPS);
            *(LAS f32x2*)(tab + (u.slot % 3) * 512 + tid * 2) = (f32x2){rm / rd, rd}; }
    }
    __device__ __forceinline__ void mid(f32x4 (&acc)[2][2][4][2], const Unit& u, int wr, int fr) const {
        const LAS float* t = tab + (u.slot % 3) * 512 + (wr * 64 + fr) * 2;
#pragma unroll
        for (int ai = 0; ai < 2; ++ai)
#pragma unroll
            for (int m = 0; m < 4; ++m) { const float q = t[(ai * HALF + m * 16) * 2];
#pragma unroll
                for (int bj = 0; bj < 2; ++bj) { acc[ai][bj][m][0] = acc[ai][bj][m][0] * q; acc[ai][bj][m][1] = acc[ai][bj][m][1] * q; } }
    }
    __device__ __forceinline__ void operator()(const f32x4 (&acc)[2][2][4][2], const Unit& u, int wr, int wc, int fr, int fq) const {
        const int row0 = u.pm * BM + wr * 64 + fr, col0 = u.pn * BM + wc * 32 + 8 * fq;
        const float* g = mod + (size_t)((u.pm * BM) >> 12) * 6144 + 2048 + col0;
        const LAS float* t = tab + (u.slot % 3) * 512 + (wr * 64 + fr) * 2 + 1;
        f32x4 gg[2][2];
#pragma unroll
        for (int bj = 0; bj < 2; ++bj) { gg[bj][0] = *(const f32x4*)(g + bj * HALF); gg[bj][1] = *(const f32x4*)(g + bj * HALF + 4); }
#define ERN_LD(it_, B) do { const size_t o_ = (size_t)(row0 + ((it_) >> 2) * HALF + ((it_) & 3) * 16) * DM + col0; \
            B[0][0] = *(const f32x4*)(X + o_); B[0][1] = *(const f32x4*)(X + o_ + 4); B[1][0] = *(const f32x4*)(X + o_ + HALF); B[1][1] = *(const f32x4*)(X + o_ + HALF + 4); } while (0)
        f32x4 xx[3][2][2];
        ERN_LD(0, xx[0]); ERN_LD(1, xx[1]);
#pragma unroll
        for (int it = 0; it < 8; ++it) { const int ai = it >> 2, m = it & 3; const float rd = t[(ai * HALF + m * 16) * 2];
            if (it + 2 < 8) { ERN_LD(it + 2, xx[(it + 2) % 3]); __builtin_amdgcn_sched_barrier(0); }
#pragma unroll
            for (int bj = 0; bj < 2; ++bj) { const size_t o = (size_t)(row0 + ai * HALF + m * 16) * DM + col0 + bj * HALF;
                const f32x4 r0 = xx[it % 3][bj][0] + gg[bj][0] * rd * acc[ai][bj][m][0], r1 = xx[it % 3][bj][1] + gg[bj][1] * rd * acc[ai][bj][m][1];
                u32x4 w; w.x = pk2(r0[0], r0[1]); w.y = pk2(r0[2], r0[3]); w.z = pk2(r1[0], r1[1]); w.w = pk2(r1[2], r1[3]);
                *(u32x4*)(O + o) = w; } }
#undef ERN_LD
    }
};
struct MoeTab { const LAS int* cnt; const LAS int* tstart; };
constexpr int UT_MAX = 32;
__device__ __forceinline__ int moe_find(const MoeTab& tb, int rt) {
    int lo = 0, hi = NEX;
    while (hi - lo > 1) { const int mid = (lo + hi) >> 1; if (tb.tstart[mid] <= rt) lo = mid; else hi = mid; }
    return lo;
}
struct MoeUpSched {
    MoeTab tb; const char* H2; const LAS int* tokl; const char* WGU; unsigned ldb; int total, G, c; const LAS int* utab;
    __device__ __forceinline__ bool next(int i, Unit& u) const {
        if (i < UT_MAX) { const u32x4 v = *(const LAS u32x4*)(utab + 4 * i); if ((int)v.x < 0) return false; u.e = (int)v.x; u.rt = (int)v.y; u.pn = (int)v.z & 0xff; u.pm = (int)v.w; u.slot = i | (((int)v.z >> 8) << 16); return true; }
        return compute(i, u);
    }
    __device__ __forceinline__ bool compute(int i, Unit& u) const {
        if (G == 256) { const int xcd = c & 7, k = c >> 3; u.rt = i * 128 + xcd * 16 + (k >> 1); u.pn = k & 1; if (u.rt * 2 >= total) return false; }
        else { const int L = i * G + c; if (L >= total) return false; u.rt = L >> 1; u.pn = L & 1; }
        u.e = moe_find(tb, u.rt); u.pm = u.rt - tb.tstart[u.e]; u.slot = i | (256 << 16); return true;
    }
    __device__ __forceinline__ const char* a_ubase(const Unit&) const { return H2; }
    __device__ __forceinline__ void a_off(const Unit& u, const int (&R)[2], const int (&C)[2], unsigned (&o)[2][2]) const {
#pragma unroll
        for (int h = 0; h < 2; ++h)
#pragma unroll
            for (int i = 0; i < 2; ++i) o[h][i] = (unsigned)(tokl[(u.slot & 0xffff) * BM + h * HALF + R[i]] & 0x7fff) * 4096u + (unsigned)C[i] * 2u;
    }
    __device__ __forceinline__ const char* b_base(const Unit& u) const { return WGU + ((size_t)u.e * 512 + (size_t)u.pn * 256) * 2048; }
};
struct EpiAct {
    static constexpr bool PERM = true;
    bf16_t* ACT; const LAS int* tokl;
    __device__ __forceinline__ void operator()(const f32x4 (&acc)[2][2][4][2], const Unit& u, int wr, int wc, int fr, int fq) const {
        const int row0 = u.rt * BM + wr * 64 + fr, col0 = u.pn * 128 + wc * 32 + 8 * fq;
#pragma unroll
        for (int ai = 0; ai < 2; ++ai)
#pragma unroll
            for (int m = 0; m < 4; ++m) { float a[8];
                const unsigned tw = (unsigned)tokl[(u.slot & 0xffff) * BM + ai * HALF + wr * 64 + m * 16 + fr];
                const float gw = (float)__builtin_bit_cast(f16_t, (unsigned short)(tw >> 16));
#pragma unroll
                for (int n = 0; n < 2; ++n)
#pragma unroll
                    for (int j = 0; j < 4; ++j) { const float gt = acc[ai][0][m][n][j], up = acc[ai][1][m][n][j]; a[n * 4 + j] = gt * __builtin_amdgcn_rcpf(1.f + __expf(-gt)) * up * gw; }
                u32x4 w; w.x = pk2(a[0], a[1]); w.y = pk2(a[2], a[3]); w.z = pk2(a[4], a[5]); w.w = pk2(a[6], a[7]);
                if (ai * HALF + wr * 64 + m * 16 + fr < (u.slot >> 16)) *(u32x4*)(ACT + (size_t)(row0 + ai * HALF + m * 16) * 256 + col0) = w; }
    }
};
struct MoeDownSched {
    MoeTab tb; const char* ACT; const char* WD; unsigned ldb; int total, G, c; const LAS int* utab;
    __device__ __forceinline__ bool next(int i, Unit& u) const {
        if (i < UT_MAX) { const u32x4 v = *(const LAS u32x4*)(utab + 4 * i); if ((int)v.x < 0) return false; u.e = (int)v.x; u.rt = (int)v.y; u.pn = (int)v.z & 0xff; u.pm = (int)v.w; u.slot = i | (((int)v.z >> 8) << 16); return true; }
        return compute(i, u);
    }
    __device__ __forceinline__ bool compute(int i, Unit& u) const {
        if (G == 256) { const int xcd = c & 7, k = c >> 3; u.rt = i * 64 + xcd * 8 + (k >> 2); u.pn = k & 3; if (u.rt * 4 >= total) return false; }
        else { const int L = i * G + c; if (L >= total) return false; u.rt = L >> 2; u.pn = L & 3; }
        u.e = moe_find(tb, u.rt); u.pm = u.rt - tb.tstart[u.e]; u.slot = i | (256 << 16); return true;
    }
    __device__ __forceinline__ const char* a_ubase(const Unit& u) const { return ACT + (size_t)u.rt * BM * 512; }
    __device__ __forceinline__ void a_off(const Unit& u, const int (&R)[2], const int (&C)[2], unsigned (&o)[2][2]) const {
#pragma unroll
        for (int h = 0; h < 2; ++h)
#pragma unroll
            for (int i = 0; i < 2; ++i) o[h][i] = (unsigned)(h * HALF + R[i]) * 512u + (unsigned)C[i] * 2u;
    }
    __device__ __forceinline__ const char* b_base(const Unit& u) const { return WD + ((size_t)u.e * 1024 + (size_t)u.pn * 256) * 512; }
};
struct EpiDown {
    static constexpr bool PERM = true;
    bf16_t* CA; bf16_t* SH;
    __device__ __forceinline__ void operator()(const f32x4 (&acc)[2][2][4][2], const Unit& u, int wr, int wc, int fr, int fq) const {
        const int col0 = u.pn * BM + wc * 32 + 8 * fq;
        {
            const bool shd = u.e == NE; const float fsc = shd ? 4.f : 16.f;
            unsigned char* base = (shd ? (unsigned char*)SH + ((size_t)u.pm * BM + wr * 64 + fr) * DM : (unsigned char*)CA + ((size_t)u.rt * BM + wr * 64 + fr) * DM) + (col0 - 8 * (fq & 1));
#pragma unroll
            for (int ai = 0; ai < 2; ++ai)
#pragma unroll
                for (int mp = 0; mp < 4; mp += 2)
#pragma unroll
                    for (int bj = 0; bj < 2; ++bj) { unsigned wx[2], wy[2];
#pragma unroll
                        for (int q = 0; q < 2; ++q) { f32x4 v0 = acc[ai][bj][mp + q][0] * fsc, v1 = acc[ai][bj][mp + q][1] * fsc;
#pragma unroll
                            for (int j2 = 0; j2 < 4; ++j2) { v0[j2] = __builtin_amdgcn_fmed3f(v0[j2], -448.f, 448.f); v1[j2] = __builtin_amdgcn_fmed3f(v1[j2], -448.f, 448.f); }
                            int t = 0;
                            t = __builtin_amdgcn_cvt_pk_fp8_f32(v0[0], v0[1], t, false); t = __builtin_amdgcn_cvt_pk_fp8_f32(v0[2], v0[3], t, true); wx[q] = (unsigned)t;
                            t = __builtin_amdgcn_cvt_pk_fp8_f32(v1[0], v1[1], t, false); t = __builtin_amdgcn_cvt_pk_fp8_f32(v1[2], v1[3], t, true); wy[q] = (unsigned)t; }
                        const auto sx = __builtin_amdgcn_permlane16_swap(wx[0], wx[1], false, false), sy = __builtin_amdgcn_permlane16_swap(wy[0], wy[1], false, false);
                        u32x4 w; w.x = sx[0]; w.y = sy[0]; w.z = sx[1]; w.w = sy[1];
                        if (ai * HALF + wr * 64 + (mp + (fq & 1)) * 16 + fr < (u.slot >> 16)) *(u32x4*)(base + (size_t)(ai * HALF + (mp + (fq & 1)) * 16) * DM + bj * HALF) = w; }
        }
    }
};
}

__constant__ float c_invH[16] = {1.000000000e+00f, 4.403665960e-01f, 1.939227432e-01f, 8.539710194e-02f, 3.760603070e-02f, 1.656044088e-02f, 7.292664610e-03f, 3.211446106e-03f,
                                 1.414213562e-03f, 6.227724371e-04f, 2.742481884e-04f, 1.207697351e-04f, 5.318295734e-05f, 2.341999971e-05f, 1.031338525e-05f, 4.541670478e-06f};
__constant__ float c_invI[8] = {1.000000000e+00f, 1.939227432e-01f, 3.760603070e-02f, 7.292664610e-03f, 1.414213562e-03f, 2.742481884e-04f, 5.318295734e-05f, 1.031338525e-05f};

struct TrJob { const float* W; int ldn, nvalid; bf16_t* WT; int dld, dcol, rmode, rbase, vmode, k0, n0; const float* kgain; };
template <bool CHECK = true>
__device__ __forceinline__ void tr_load(const TrJob& J, int lane, f32x4 (&v)[8]) {
    const int n4 = (lane & 7) * 4; const bool ok = !CHECK || J.n0 + n4 < J.nvalid;
#pragma unroll
    for (int i = 0; i < 8; ++i) { const int kk = 8 * i + (lane >> 3); v[i] = ok ? *(const f32x4*)(J.W + (size_t)(J.k0 + kk) * J.ldn + J.n0 + n4) : (f32x4){0.f, 0.f, 0.f, 0.f}; }
}
__device__ __forceinline__ void tr_finish(const TrJob& J, int lane, const f32x4 (&v)[8], LAS float* scr) {
    const int n4 = (lane & 7) * 4;
    float kg[8];
    { const float* kp = (J.kgain ? J.kgain + J.k0 : c_invH) + 8 * (lane & 7) * (J.kgain ? 1 : 0);
#pragma unroll
      for (int q = 0; q < 8; ++q) kg[q] = kp[q];
      if (!J.kgain) {
#pragma unroll
          for (int q = 0; q < 8; ++q) kg[q] = 1.f; } }
#pragma unroll
    for (int i = 0; i < 8; ++i) { const int kk = 8 * i + (lane >> 3); LAS float* d = scr + kk * 33 + n4; d[0] = v[i][0]; d[1] = v[i][1]; d[2] = v[i][2]; d[3] = v[i][3]; }
    LDS_WAIT(); asm volatile("" ::: "memory");
    const int c = lane & 7;
#pragma unroll
    for (int j = 0; j < 4; ++j) { const int n = (lane >> 3) + 8 * j; const LAS float* s = scr + (8 * c) * 33 + n;
        float x[8];
#pragma unroll
        for (int q = 0; q < 8; ++q) { x[q] = s[q * 33] * kg[q]; if (J.vmode == 2) x[q] = x[q] - bf2f(f2bf(x[q])); }
        u32x4 o; o.x = pk2(x[0], x[1]); o.y = pk2(x[2], x[3]); o.z = pk2(x[4], x[5]); o.w = pk2(x[6], x[7]);
        const int ng = J.n0 + n; const int drow = J.rmode ? ((ng >> 7) * 256 + (ng & 127) + J.rbase) : (J.rbase + ng);
        *(u32x4*)(J.WT + (size_t)drow * J.dld + J.dcol + J.k0 + 8 * c) = o; }
    LDS_WAIT(); asm volatile("" ::: "memory");
}
__device__ __forceinline__ void tr_item(const float* W, int ldn, int nvalid, bf16_t* WT, int dld, int dcol, int rmode, int rbase, int vmode, int k0, int n0, LAS float* scr, int lane, const float* kgain = nullptr) {
    const TrJob J{W, ldn, nvalid, WT, dld, dcol, rmode, rbase, vmode, k0, n0, kgain}; f32x4 v[8]; tr_load(J, lane, v); tr_finish(J, lane, v, scr);
}

__device__ __forceinline__ void phase0(const Args& A, unsigned char* lds_, const int wave) {
    LAS unsigned char* lds = (LAS unsigned char*)lds_;
    const int lane = lane_opaque(), tid = wave * 64 + lane, G = gridDim.x;
    unsigned char* ws = A.ws;
    {
        LAS float* cact = (LAS float*)lds;
        LAS float* part = cact + 8192;
        const float* c = A.in[1]; const float* w_ada = A.in[2]; const float* b_ada = A.in[3]; float* mod = (float*)(ws + WS_MOD);
        for (int i = tid; i < 8192; i += NTHR) { const float v = c[i]; cact[i] = v / (1.f + expf(-v)); }
        __syncthreads();
        for (int chunk = blockIdx.x; chunk < 256; chunk += G) {
            const int n0 = chunk * 24, j = tid % 24, q = tid / 24;
            float a0 = 0.f, a1 = 0.f, a2 = 0.f, a3 = 0.f, a4 = 0.f, a5 = 0.f, a6 = 0.f, a7 = 0.f;
            if (tid < 504) {
                float wv[49];
#pragma unroll
                for (int i = 0; i < 49; ++i) { const int k = q + 21 * i; wv[i] = k < 1024 ? w_ada[(size_t)k * 6144 + n0 + j] : 0.f; }
#pragma unroll
                for (int i = 0; i < 49; ++i) { const int k = q + 21 * i < 1024 ? q + 21 * i : 1023; const float w = wv[i];
                    a0 += cact[k] * w; a1 += cact[1024 + k] * w; a2 += cact[2048 + k] * w; a3 += cact[3072 + k] * w;
                    a4 += cact[4096 + k] * w; a5 += cact[5120 + k] * w; a6 += cact[6144 + k] * w; a7 += cact[7168 + k] * w; } }
            if (tid < 504) { LAS float* p = part + (q * 8) * 24 + j; p[0] = a0; p[24] = a1; p[48] = a2; p[72] = a3; p[96] = a4; p[120] = a5; p[144] = a6; p[168] = a7; }
            __syncthreads();
            if (tid < 192) { const int b = tid / 24, jj = tid % 24; float s = b_ada[n0 + jj];
                for (int qq = 0; qq < 21; ++qq) s += part[(qq * 8 + b) * 24 + jj];
                mod[b * 6144 + n0 + jj] = s; }
            __syncthreads();
        }
    }
    {
        float* cosH = (float*)(ws + WS_COSH); float* sinH = (float*)(ws + WS_SINH); float* cosI = (float*)(ws + WS_COSI); float* sinI = (float*)(ws + WS_SINI);
        for (int i = blockIdx.x * NTHR + tid; i < SEQ * 24; i += G * NTHR) {
            int pos, f; float inv; bool isH = i < SEQ * 16;
            if (isH) { pos = i >> 4; f = i & 15; inv = c_invH[f]; } else { const int k = i - SEQ * 16; pos = k >> 3; f = k & 7; inv = c_invI[f]; }
            const float ang = (float)pos * inv;
            double t = (double)ang * 0.15915494309189533577; t -= rint(t);
            const float rev = (float)t;
            const float cs = __builtin_amdgcn_cosf(rev), sn = __builtin_amdgcn_sinf(rev);
            if (isH) { cosH[i] = cs; sinH[i] = sn; } else { cosI[i - SEQ * 16] = cs; sinI[i - SEQ * 16] = sn; }
        }
    }
    {
        LAS float* scr = (LAS float*)(lds + 65536 + wave * 8448);
        const int gw = blockIdx.x * NWAVES + wave, NGW = G * NWAVES;
        bf16_t* WIN = (bf16_t*)(ws + WS_WIN); bf16_t* WOUT = (bf16_t*)(ws + WS_WOUT); bf16_t* WR = (bf16_t*)(ws + WS_WR); bf16_t* WKV = (bf16_t*)(ws + WS_WKV);
        constexpr int I_IN = 16 * 96, I_KV = 4 * 8, I_OUT = 16 * 32, I_R = 16 * 8;
        constexpr int NITEMS = I_IN + I_KV + I_OUT + 3 * I_R;
        for (int it = gw; it < NITEMS; it += NGW) {
            int r = it;
            if (r < I_IN) { tr_item(A.in[5], NPROJ, NPROJ, WIN, 1024, 0, 0, 0, 0, 64 * (r / 96), 32 * (r % 96), scr, lane); continue; } r -= I_IN;
            if (r < I_KV) { tr_item(A.in[7], 256, 256, WKV, 256, 0, 0, 0, 0, 64 * (r / 8), 32 * (r % 8), scr, lane, A.in[6]); continue; } r -= I_KV;
            if (r < I_OUT) { const int k0_ = 64 * (r / 32); tr_item(A.in[10], 1024, 1024, WOUT, 1024, 0, 0, 0, 0, k0_, 32 * (r % 32), scr, lane, k0_ < 512 ? A.in[8] : A.in[9] - 512); continue; } r -= I_OUT;
            if (r < I_R) { tr_item(A.in[12], 256, 256, WR, 2048, 0, 0, 0, 1, 64 * (r / 8), 32 * (r % 8), scr, lane); continue; } r -= I_R;
            if (r < I_R) { tr_item(A.in[12], 256, 256, WR, 2048, 1024, 0, 0, 1, 64 * (r / 8), 32 * (r % 8), scr, lane); continue; } r -= I_R;
            tr_item(A.in[12], 256, 256, WR, 2048, 0, 0, 256, 2, 64 * (r / 8), 32 * (r % 8), scr, lane);
        }
        for (int i = blockIdx.x * NTHR + tid; i < 256 * 128; i += G * NTHR) { const int rr = 256 + (i >> 7), cc = 1024 + (i & 127) * 8; *(u32x4*)(WR + (size_t)rr * 2048 + cc) = (u32x4){0u, 0u, 0u, 0u}; }
    }
}


__device__ __forceinline__ void convert_experts(const Args& A, unsigned char* lds_, const int wave) {
    LAS unsigned char* lds = (LAS unsigned char*)lds_;
    const int lane = lane_opaque();
    unsigned char* ws = A.ws;
    LAS float* scr = (LAS float*)(lds + wave * 8448);
    const int gw = blockIdx.x * NWAVES + wave, NGW = gridDim.x * NWAVES;
    bf16_t* WD = (bf16_t*)(ws + WS_WD); bf16_t* WGU = (bf16_t*)(ws + WS_WGU);
    struct XJob { const char* src; char* dst; unsigned ldnB, dldB; };
    auto job = [&](int r) -> XJob {
        const int e = r / 384, q = r % 384; const bool sh_ = (e == NE);
        if (q < 256) { const int q2 = q & 127, k0 = 64 * (q2 >> 3), n0 = 32 * (q2 & 7), up = q >> 7;
            const float* w = up ? (!sh_ ? A.in[15] + (size_t)e * 1024 * 256 : A.in[18]) : (!sh_ ? A.in[14] + (size_t)e * 1024 * 256 : A.in[17]);
            const int drow0 = (n0 >> 7) * 256 + (n0 & 127) + 128 * up;
            return XJob{(const char*)(w + (size_t)k0 * 256 + n0), (char*)(WGU + (size_t)e * 512 * 1024 + (size_t)drow0 * 1024 + k0), 256u * 4u, 1024u * 2u}; }
        const int q3 = q - 256, k0 = 64 * (q3 >> 5), n0 = 32 * (q3 & 31);
        const float* w = !sh_ ? A.in[16] + (size_t)e * 256 * 1024 : A.in[19];
        return XJob{(const char*)(w + (size_t)k0 * 1024 + n0), (char*)(WD + (size_t)e * 1024 * 256 + (size_t)n0 * 256 + k0), 1024u * 4u, 256u * 2u};
    };
    auto xload = [&](const XJob& J, f32x4 (&v)[8]) {
        const unsigned vo = (unsigned)(lane >> 3) * J.ldnB + (unsigned)(lane & 7) * 16u;
#pragma unroll
        for (int i = 0; i < 8; ++i) v[i] = *(const f32x4*)(J.src + (size_t)(8 * i) * J.ldnB + vo);
    };
    auto xfinish = [&](const XJob& J, const f32x4 (&v)[8]) {
        const int n4 = (lane & 7) * 4;
#pragma unroll
        for (int i = 0; i < 8; ++i) { const int kk = 8 * i + (lane >> 3); LAS float* d = scr + kk * 33 + n4; d[0] = v[i][0]; d[1] = v[i][1]; d[2] = v[i][2]; d[3] = v[i][3]; }
        LDS_WAIT(); asm volatile("" ::: "memory");
        const int c = lane & 7; const unsigned vo2 = (unsigned)(lane >> 3) * J.dldB + (unsigned)c * 16u;
#pragma unroll
        for (int jx = 0; jx < 4; ++jx) { const int n = (lane >> 3) + 8 * jx; const LAS float* sp = scr + (8 * c) * 33 + n;
            float x[8];
#pragma unroll
            for (int q = 0; q < 8; ++q) x[q] = sp[q * 33];
            u32x4 o; o.x = pk2(x[0], x[1]); o.y = pk2(x[2], x[3]); o.z = pk2(x[4], x[5]); o.w = pk2(x[6], x[7]);
            *(u32x4*)(J.dst + (size_t)(8 * jx) * J.dldB + vo2) = o; }
        LDS_WAIT(); asm volatile("" ::: "memory");
    };
    constexpr int NIT = 384 * NEX;
    int r = gw;
    if (r >= NIT) return;
    f32x4 va[8], vb[8], vc[8], vd[8];
#define CE_LD(dst, rr) do { const int r_ = (rr) < NIT ? (rr) : last; const XJob J_ = job(r_); xload(J_, dst); __builtin_amdgcn_fence(__ATOMIC_RELEASE, "wavefront"); } while (0)
#define CE_FIN(src, rr) do { if ((rr) < NIT) { const XJob J_ = job(rr); xfinish(J_, src); } } while (0)
    const int last = gw + ((NIT - 1 - gw) / NGW) * NGW;
    CE_LD(va, r); CE_LD(vb, r + NGW); CE_LD(vc, r + 2 * NGW);
    for (; r < NIT; r += 4 * NGW) {
        CE_LD(vd, r + 3 * NGW); CE_FIN(va, r);
        CE_LD(va, r + 4 * NGW); CE_FIN(vb, r + NGW);
        CE_LD(vb, r + 5 * NGW); CE_FIN(vc, r + 2 * NGW);
        CE_LD(vc, r + 6 * NGW); CE_FIN(vd, r + 3 * NGW);
    }
#undef CE_LD
#undef CE_FIN
}

template <bool BF16IN = false>
__device__ __forceinline__ void modnorm_row(const void* xrow_, const float* gain, const float* shift, const float* scale, int lane, f32x4 (&v)[4]) {
    float s = 0.f;
#pragma unroll
    for (int j = 0; j < 4; ++j) {
        if constexpr (BF16IN) { const u32x2 w = *((const u32x2*)xrow_ + lane + 64 * j); v[j] = (f32x4){bflo(w.x), bfhi(w.x), bflo(w.y), bfhi(w.y)}; }
        else v[j] = *((const f32x4*)xrow_ + lane + 64 * j);
        s += (v[j].x * v[j].x + v[j].y * v[j].y) + (v[j].z * v[j].z + v[j].w * v[j].w); }
    const float rstd = 1.f / sqrtf(wave_sum_dpp(s) * (1.f / DM) + EPS);
#pragma unroll
    for (int j = 0; j < 4; ++j) { const f32x4 g = *((const f32x4*)gain + lane + 64 * j), sh = *((const f32x4*)shift + lane + 64 * j), sc = *((const f32x4*)scale + lane + 64 * j);
        v[j] = (v[j] * rstd * g) * (sc + 1.f) + sh; }
}
__device__ __forceinline__ void phase1(const Args& A, const int wave) {
    const int lane = lane_opaque();
    const int gw = blockIdx.x * NWAVES + wave, NGW = gridDim.x * NWAVES;
    const float* x = A.in[0]; const float* mod = (const float*)(A.ws + WS_MOD); bf16_t* H = (bf16_t*)(A.ws + WS_H);
    for (int row = gw; row < T; row += NGW) {
        const float* mb = mod + (size_t)(row >> 12) * 6144; f32x4 v[4];
        modnorm_row(x + (size_t)row * DM, A.in[4], mb, mb + 1024, lane, v);
#pragma unroll
        for (int j = 0; j < 4; ++j) { u32x2 o; o.x = pk2(v[j].x, v[j].y); o.y = pk2(v[j].z, v[j].w); *((u32x2*)(H + (size_t)row * DM) + lane + 64 * j) = o; }
    }
}

__device__ __forceinline__ void kmean_units(const Args& A, unsigned char* lds_, const int wave, int u0, int ustep) {
    const int lane = lane_opaque(), tid = wave * 64 + lane;
    const bf16_t* KM = (const bf16_t*)(A.ws + WS_KM); float* KMEAN = (float*)(A.ws + WS_KMEAN);
    LAS float* part = (LAS float*)lds_;
    constexpr int NU = NB * 4 * 16;
    const int r4 = lane >> 4, c8 = (lane & 15) * 8;
#define KMU_LD(u_, v_) do { const bf16_t* base_ = KM + ((size_t)((u_) >> 4) * SEQ + ((u_) & 15) * 256 + wave * 32 + r4) * 128 + c8; \
        _Pragma("unroll") for (int j = 0; j < 8; ++j) v_[j] = *(const u32x4*)(base_ + (size_t)(4 * j) * 128); } while (0)
    u32x4 cur[8], nxt[8];
    if (u0 < NU) KMU_LD(u0, cur);
    for (int u = u0; u < NU; u += ustep) {
        const int un = u + ustep < NU ? u + ustep : u;
        KMU_LD(un, nxt);
        float a[8];
#pragma unroll
        for (int q = 0; q < 8; ++q) a[q] = 0.f;
#pragma unroll
        for (int j = 0; j < 8; ++j)
#pragma unroll
            for (int d = 0; d < 4; ++d) { a[2 * d] += bflo(cur[j][d]); a[2 * d + 1] += bfhi(cur[j][d]); }
#pragma unroll
        for (int q = 0; q < 8; ++q) { a[q] += __shfl_xor(a[q], 16); a[q] += __shfl_xor(a[q], 32); }
        if (lane < 16) { *(LAS f32x4*)(part + wave * 128 + c8) = (f32x4){a[0], a[1], a[2], a[3]}; *(LAS f32x4*)(part + wave * 128 + c8 + 4) = (f32x4){a[4], a[5], a[6], a[7]}; }
        __syncthreads();
        if (tid < 128) { float sm = 0.f; for (int p = 0; p < 8; ++p) sm += part[p * 128 + tid]; KMEAN[(size_t)u * 128 + tid] = sm * (1.f / 256.f); }
        __syncthreads();
#pragma unroll
        for (int j = 0; j < 8; ++j) cur[j] = nxt[j];
    }
#undef KMU_LD
}

namespace att {
typedef short s16x4 __attribute__((ext_vector_type(4)));
typedef float f32x16 __attribute__((ext_vector_type(16)));
constexpr int D = 128, NW = 8, QBLK = 32, KVBLK = 64;
constexpr int SHM_V = KVBLK * D * 2, SHM_K = KVBLK * D * 2;
constexpr int LDS_ATT = 2 * SHM_V + 2 * SHM_K + NW * 128 * 4;
constexpr float SCALE = 0.08838834764831845f, THR = 8.f;
#define KSWZ(row, colB) ((row) * 256 + ((colB) ^ (((row) & 7) << 4)))
#define SBAR() __builtin_amdgcn_sched_barrier(0)
__device__ __forceinline__ int v_st(int k, int c) { const int kk = (k & ~0xC) | ((k & 4) << 1) | ((k & 8) >> 1); return ((kk >> 3) * 4 + (c >> 5)) * 512 + ((kk & 7) * 32 + (c & 31)) * 2; }
__device__ __forceinline__ int v_rd_base(int lane) { return ((lane & 3) << 3) | (((lane >> 2) & 3) << 6) | (((lane >> 4) & 1) << 5) | (((lane >> 5) & 1) << 8); }
constexpr int v_rd_off(int d0, int ks, int half) { return d0 * 512 + ks * 4096 + half * 2048; }
__device__ __forceinline__ int crow(int r, int hi) { return (r & 3) + 8 * (r >> 2) + 4 * hi; }
__device__ __forceinline__ unsigned cvtpk(float lo, float hi) { unsigned r; asm volatile("v_cvt_pk_bf16_f32 %0, %1, %2" : "=v"(r) : "v"(lo), "v"(hi)); return r; }
__device__ __forceinline__ void mask_tile(f32x16& p0, f32x16& p1, int dq) {
    const float NEG = -__builtin_inff();
#pragma unroll
    for (int r = 0; r < 16; ++r) { const int c = (r & 3) + 8 * (r >> 2); if (dq - c < 0) p0[r] = NEG; if (dq - c - 32 < 0) p1[r] = NEG; }
}
__device__ __forceinline__ void bias_tile(f32x16& p0, f32x16& p1, unsigned long long mw, int hi) {
    const unsigned lo = (unsigned)mw >> (4 * hi), hh = (unsigned)(mw >> 32) >> (4 * hi);
#pragma unroll
    for (int r = 0; r < 16; ++r) { const int c = (r & 3) + 8 * (r >> 2);
        const unsigned x0 = (unsigned)__builtin_amdgcn_sbfe((int)lo, c, 1), x1 = (unsigned)__builtin_amdgcn_sbfe((int)hh, c, 1);
        p0[r] = __builtin_bit_cast(float, ~x0 & 0xFF800000u); p1[r] = __builtin_bit_cast(float, ~x1 & 0xFF800000u); }
}
__device__ __forceinline__ void partialSM(f32x16& p0, f32x16& p1, float& m_reg, float& mn, float& alpha, bool keep) {
    float pmax = p0[0];
#pragma unroll
    for (int r = 1; r < 16; ++r) pmax = fmaxf(pmax, p0[r]);
#pragma unroll
    for (int r = 0; r < 16; ++r) pmax = fmaxf(pmax, p1[r]);
    { auto rr = __builtin_amdgcn_permlane32_swap(__float_as_uint(pmax), __float_as_uint(pmax), false, false);
      pmax = fmaxf(__uint_as_float(rr[0]), __uint_as_float(rr[1])); }
    pmax = keep ? pmax : -__builtin_inff();
    constexpr float C2 = 1.4426950408889634f * SCALE;
    if (__builtin_expect(__all((pmax - m_reg) * SCALE <= THR), 1)) { mn = m_reg; alpha = 1.f; }
    else { mn = fmaxf(m_reg, pmax); alpha = __builtin_amdgcn_exp2f((m_reg - mn) * C2); m_reg = mn; }
    const float mnL = keep ? -mn * C2 : -__builtin_inff();
#pragma unroll
    for (int r = 0; r < 16; ++r) p0[r] = fmaf(p0[r], C2, mnL);
#pragma unroll
    for (int r = 0; r < 16; ++r) p1[r] = fmaf(p1[r], C2, mnL);
#pragma unroll
    for (int r = 0; r < 16; ++r) p0[r] = __builtin_amdgcn_exp2f(p0[r]);
}
__device__ __forceinline__ void finishSM(f32x16& p0, f32x16& p1, float alpha, float& l_reg, bf16x8& pa0, bf16x8& pa1, bf16x8& pa2, bf16x8& pa3) {
#pragma unroll
    for (int r = 0; r < 16; ++r) p1[r] = __builtin_amdgcn_exp2f(p1[r]);
    float ps = 0;
#pragma unroll
    for (int r = 0; r < 16; ++r) ps += p0[r];
#pragma unroll
    for (int r = 0; r < 16; ++r) ps += p1[r];
    { auto rr = __builtin_amdgcn_permlane32_swap(__float_as_uint(ps), __float_as_uint(ps), false, false);
      ps = __uint_as_float(rr[0]) + __uint_as_float(rr[1]); }
    l_reg = l_reg * alpha + ps;
#define PK4(P, B_, OUT) do { unsigned a0 = cvtpk(P[B_+0], P[B_+1]), a1 = cvtpk(P[B_+2], P[B_+3]);                          \
        unsigned b0 = cvtpk(P[B_+4], P[B_+5]), b1 = cvtpk(P[B_+6], P[B_+7]);                                             \
        auto r0 = __builtin_amdgcn_permlane32_swap(a0, b0, false, false); auto r1 = __builtin_amdgcn_permlane32_swap(a1, b1, false, false); \
        u32x4 w = {r0[0], r1[0], r0[1], r1[1]}; OUT = *reinterpret_cast<bf16x8*>(&w); } while (0)
    PK4(p0, 0, pa0); PK4(p0, 8, pa1); PK4(p1, 0, pa2); PK4(p1, 8, pa3);
#undef PK4
}
template <int KB>
__device__ __forceinline__ void qkt(f32x16& p0, f32x16& p1, const char* K_lds, int r32, int hi, const bf16x8* qr) {
    const char* kb[4];
#pragma unroll
    for (int dd = 0; dd < 4; ++dd) kb[dd] = K_lds + KB * SHM_K + KSWZ(r32, (dd * 16 + hi * 8) * 2);
#pragma unroll
    for (int d0 = 0; d0 < 8; ++d0) { const char* a = kb[d0 & 3] + (d0 >> 2) * 128;
        bf16x8 b0 = *reinterpret_cast<const bf16x8*>(a);
        bf16x8 b1 = *reinterpret_cast<const bf16x8*>(a + 32 * 256);
        p0 = __builtin_amdgcn_mfma_f32_32x32x16_bf16(b0, qr[d0], p0, 0, 0, 0);
        p1 = __builtin_amdgcn_mfma_f32_32x32x16_bf16(b1, qr[d0], p1, 0, 0, 0); }
}
template <int VB>
__device__ __forceinline__ void pv_tile(f32x16* o, int vb0, bf16x8 pa0, bf16x8 pa1, bf16x8 pa2, bf16x8 pa3) {
#define TRRD(dst, off) asm volatile("ds_read_b64_tr_b16 %0, %1 offset:%2" : "=&v"(dst) : "v"(vb0), "i"(off) : "memory")
#define PV_D0(d0) do { s16x4 l0, l1, l2, l3, h0, h1, h2, h3; constexpr int b_ = VB * SHM_V + v_rd_off(d0, 0, 0); \
        TRRD(l0, b_); TRRD(h0, b_ + 2048); TRRD(l1, b_ + 4096); TRRD(h1, b_ + 6144); TRRD(l2, b_ + 8192); TRRD(h2, b_ + 10240); TRRD(l3, b_ + 12288); TRRD(h3, b_ + 14336); \
        asm volatile("s_waitcnt lgkmcnt(0)" ::: "memory"); SBAR();   \
        o[d0] = __builtin_amdgcn_mfma_f32_32x32x16_bf16(pa0, (bf16x8){l0[0], l0[1], l0[2], l0[3], h0[0], h0[1], h0[2], h0[3]}, o[d0], 0, 0, 0);   \
        o[d0] = __builtin_amdgcn_mfma_f32_32x32x16_bf16(pa1, (bf16x8){l1[0], l1[1], l1[2], l1[3], h1[0], h1[1], h1[2], h1[3]}, o[d0], 0, 0, 0);   \
        o[d0] = __builtin_amdgcn_mfma_f32_32x32x16_bf16(pa2, (bf16x8){l2[0], l2[1], l2[2], l2[3], h2[0], h2[1], h2[2], h2[3]}, o[d0], 0, 0, 0);   \
        o[d0] = __builtin_amdgcn_mfma_f32_32x32x16_bf16(pa3, (bf16x8){l3[0], l3[1], l3[2], l3[3], h3[0], h3[1], h3[2], h3[3]}, o[d0], 0, 0, 0); } while (0)
    PV_D0(0); PV_D0(1); PV_D0(2); PV_D0(3);
#undef PV_D0
#undef TRRD
}
__device__ __forceinline__ __amdgpu_buffer_rsrc_t mkrsrc(const void* p, int bytes) {
    const unsigned long long a = (unsigned long long)p; const unsigned lo = __builtin_amdgcn_readfirstlane((unsigned)a), hi = __builtin_amdgcn_readfirstlane((unsigned)(a >> 32));
    return __builtin_amdgcn_make_buffer_rsrc((void*)(((unsigned long long)hi << 32) | lo), (short)0, bytes, 0x00020000);
}
#define BLD16(rs, vo, so) __builtin_bit_cast(bf16x8, __builtin_amdgcn_raw_buffer_load_b128((rs), (int)(vo), (int)(so), 0))
struct Blk { const bf16_t* Qw; const bf16_t* K; const bf16_t* V; bf16_t* Ow; float* Sq; int NT, qpos, own_t0; const unsigned long long* mrow; };
struct Seam { bf16x8 qr[8]; bf16x8 st0, st1; };
constexpr int OST = 1024;
#define VMW() asm volatile("s_waitcnt vmcnt(0)" ::: "memory")
#define VMWN(n) asm volatile("s_waitcnt vmcnt(%0)" :: "i"(n) : "memory")
#define SLOAD(rs, k0) do { S.st0 = BLD16(rs, kvoff, (k0) * 256); S.st1 = BLD16(rs, kvoff, (k0) * 256 + 8192); } while (0)
#define SWRITE_K(bf) do { *(bf16x8*)(K_lds + (bf) * SHM_K + kws) = S.st0; *(bf16x8*)(K_lds + (bf) * SHM_K + kws + 32 * 256) = S.st1; } while (0)
#define SWRITE_V(bf) do { *(bf16x8*)(V_lds + (bf) * SHM_V + vst0) = S.st0; *(bf16x8*)(V_lds + (bf) * SHM_V + vst1) = S.st1; } while (0)
__device__ __forceinline__ void att_prime(const Blk& cur, char* lds, Seam& S, int wid) {
    const int lane = lane_opaque(), tid = wid * 64 + lane, r32 = lane & 31, hi = lane >> 5;
    const int sr = tid >> 4, sc = (tid & 15) * 8, kws = KSWZ(sr, sc * 2); char* K_lds = lds + 2 * SHM_V;
    const unsigned kvoff = (unsigned)(sr * 256 + sc * 2), qoff = (unsigned)(r32 * 256 + hi * 16);
    const __amdgpu_buffer_rsrc_t rQ = mkrsrc(cur.Qw, 32 * 256), rK = mkrsrc(cur.K, SEQ * 256), rV = mkrsrc(cur.V, SEQ * 256);
#pragma unroll
    for (int d0 = 0; d0 < 8; ++d0) S.qr[d0] = BLD16(rQ, qoff + d0 * 32, 0);
    SLOAD(rK, 0); VMW(); SWRITE_K(0); SBAR(); SLOAD(rV, 0);
    __syncthreads();
}
template <int MODE>
__device__ __forceinline__ void att_block(const Blk& cur, const Blk& nxt, char* lds, Seam& S, int wid) {
    const int lane = lane_opaque(), tid = wid * 64 + lane, r32 = lane & 31, hi = lane >> 5;
    const int NT = cur.NT;
    const int qlo = cur.qpos, qm = qlo + r32 - 4 * hi;
    char* V_lds = lds; char* K_lds = lds + 2 * SHM_V;
    float* ws = (float*)(lds + 2 * SHM_V + 2 * SHM_K) + wid * 128; float* li_l = ws, * al_l = ws + 32; const unsigned* sel_l = (const unsigned*)(ws + 64);
    float m_reg = -1e30f, l_reg = 0; f32x16 o[4] = {};
    const int sr = tid >> 4, sc = (tid & 15) * 8, vst0 = v_st(sr, sc), vst1 = v_st(32 + sr, sc), kws = KSWZ(sr, sc * 2);
    const int vb0 = (int)(uintptr_t)V_lds + v_rd_base(lane);
    const unsigned kvoff = (unsigned)(sr * 256 + sc * 2), qoff = (unsigned)(r32 * 256 + hi * 16);
    const __amdgpu_buffer_rsrc_t Kh = mkrsrc(cur.K, SEQ * 256), Vh = mkrsrc(cur.V, SEQ * 256);
    const __amdgpu_buffer_rsrc_t rM = mkrsrc(MODE == 1 ? (const void*)cur.mrow : (const void*)cur.K, 64 * 512);
#define MLD(t) __builtin_bit_cast(unsigned long long, __builtin_amdgcn_raw_buffer_load_b64(rM, (int)((32 * (wid >> 2) + r32) * 8), (int)((t) * 512), 0))
#define RESC(a) do { if (__any((a) < 1.f)) { if (hi == 0) al_l[r32] = (a); asm volatile("s_waitcnt lgkmcnt(0)" ::: "memory");              \
                     for (int d_ = 0; d_ < 4; ++d_) for (int r = 0; r < 16; ++r) o[d_][r] *= al_l[crow(r, hi)]; } } while (0)
#define KBASE(t) ((t) * KVBLK)
#define MASKT(P0_, P1_, t) do { if (MODE == 0) { const int kb_ = KBASE(t); if ((t) >= cur.own_t0 && kb_ + KVBLK - 1 > qlo) mask_tile(P0_, P1_, qm - kb_); } } while (0)
#define KEEP(t) ((MODE == 0) ? (((t) >= cur.own_t0) || ((sel_l[r32] >> ((t) >> 2)) & 1u)) : true)
#define PINIT(P0_, P1_, t) do { if (MODE == 1) { bias_tile(P0_, P1_, mwq, hi); mwq = MLD(((t) + 1 < NT) ? (t) + 1 : (t)); } else { P0_ = f32x16{}; P1_ = f32x16{}; } } while (0)
#define SEAM_K0() do { VMWN(8); SWRITE_K(0); SBAR(); { const __amdgpu_buffer_rsrc_t rVn = mkrsrc(nxt.V, SEQ * 256); SLOAD(rVn, 0); } SBAR(); } while (0)
    f32x16 pA0, pA1, pB0, pB1; float mnA, mnB, alA, alB; bf16x8 pa0, pa1, pa2, pa3;
    unsigned long long mwq = 0ull; if (MODE == 1) mwq = MLD(0);
    VMW(); SWRITE_V(0); SBAR();
    if (NT > 1) SLOAD(Kh, KBASE(1));
    PINIT(pA0, pA1, 0);
    SBAR(); qkt<0>(pA0, pA1, K_lds, r32, hi, S.qr);
    if (NT > 1) { VMW(); SWRITE_K(1); SBAR(); SLOAD(Vh, KBASE(1)); }
    MASKT(pA0, pA1, 0); partialSM(pA0, pA1, m_reg, mnA, alA, KEEP(0));
    if (NT > 1) { VMW(); SWRITE_V(1); SBAR(); if (NT > 2) SLOAD(Kh, KBASE(2)); }
    __syncthreads();
#define HALF_STEP(PX0, PX1, mnX, alX, PY0, PY1, alY, t, KB, VB, SB) do {                                                      \
        PINIT(PX0, PX1, t);                                                                                                   \
        SBAR(); qkt<KB>(PX0, PX1, K_lds, r32, hi, S.qr);                                                                      \
        finishSM(PY0, PY1, alY, l_reg, pa0, pa1, pa2, pa3); SBAR();                                                           \
        if ((t) + 1 < NT) { VMW(); SWRITE_K(SB); SBAR(); SLOAD(Vh, KBASE((t) + 1)); SBAR(); }                                 \
        pv_tile<VB>(o, vb0, pa0, pa1, pa2, pa3); MASKT(PX0, PX1, (t)); partialSM(PX0, PX1, m_reg, mnX, alX, KEEP(t));        \
        __syncthreads();                                                                                                      \
        if ((t) + 1 < NT) { VMW(); SWRITE_V(SB); SBAR(); if ((t) + 2 < NT) SLOAD(Kh, KBASE((t) + 2)); }                       \
        RESC(alX); __syncthreads(); } while (0)
    for (int t = 1; t + 1 < NT; t += 2) {
        HALF_STEP(pB0, pB1, mnB, alB, pA0, pA1, alA, t, 1, 0, 0);
        HALF_STEP(pA0, pA1, mnA, alA, pB0, pB1, alB, t + 1, 0, 1, 1);
    }
    const bool even = (NT & 1) == 0;
    if (even) { PINIT(pB0, pB1, NT - 1); SBAR(); qkt<1>(pB0, pB1, K_lds, r32, hi, S.qr); SBAR(); }
    { const __amdgpu_buffer_rsrc_t rKn = mkrsrc(nxt.K, SEQ * 256); SLOAD(rKn, 0); } SBAR();
    { const __amdgpu_buffer_rsrc_t rQn = mkrsrc(nxt.Qw, 32 * 256);
#pragma unroll
      for (int d0 = 0; d0 < 8; ++d0) S.qr[d0] = BLD16(rQn, qoff + d0 * 32, 0); }
    SBAR();
    finishSM(pA0, pA1, alA, l_reg, pa0, pa1, pa2, pa3); SBAR();
    pv_tile<0>(o, vb0, pa0, pa1, pa2, pa3);
    if (even) { MASKT(pB0, pB1, NT - 1); partialSM(pB0, pB1, m_reg, mnB, alB, KEEP(NT - 1)); __syncthreads(); RESC(alB);
        finishSM(pB0, pB1, alB, l_reg, pa0, pa1, pa2, pa3); SBAR(); pv_tile<1>(o, vb0, pa0, pa1, pa2, pa3); }
    SBAR(); SEAM_K0();
    if (hi == 0) li_l[r32] = l_reg; asm volatile("s_waitcnt lgkmcnt(0)" ::: "memory");
    float rli[16];
#pragma unroll
    for (int r = 0; r < 16; ++r) rli[r] = __builtin_amdgcn_rcpf(li_l[crow(r, hi)]);
    bf16_t* Ow = cur.Ow;
#pragma unroll
    for (int r = 0; r < 16; ++r) { const int orow = crow(r, hi); float ss = 0.f;
#pragma unroll
        for (int d0 = 0; d0 < 4; ++d0) { const float v = o[d0][r] * rli[r]; ss += v * v;
            const float vn = __shfl_xor(v, 1);
            if ((r32 & 1) == 0) *(unsigned*)(Ow + (size_t)orow * OST + d0 * 32 + r32) = cvtpk(v, vn); }
        ss += __shfl_xor(ss, 1); ss += __shfl_xor(ss, 2); ss += __shfl_xor(ss, 4); ss += __shfl_xor(ss, 8); ss += __shfl_xor(ss, 16);
        if (r32 == 0) cur.Sq[(size_t)orow * 8] = ss; }
    __syncthreads();
#undef RESC
#undef KBASE
#undef MASKT
#undef KEEP
#undef PINIT
#undef SEAM_K0
#undef HALF_STEP
#undef MLD
}
__device__ __forceinline__ void moba_gate(const Seam& S, const float* km  , int own, char* lds, int wid) {
    const int lane = lane_opaque(), r32 = lane & 31, hi = lane >> 5;
    unsigned* sel_l = (unsigned*)((float*)(lds + 2 * SHM_V + 2 * SHM_K) + wid * 128 + 64);
    float* kl = (float*)(lds + 73728 + wid * 8192);
    { f32x4 t[8];
#pragma unroll
      for (int i = 0; i < 8; ++i) t[i] = *((const f32x4*)km + lane + 64 * i);
#pragma unroll
      for (int i = 0; i < 8; ++i) *((f32x4*)kl + lane + 64 * i) = t[i]; }
    float g[15];
#pragma unroll
    for (int n = 0; n < 15; ++n) { g[n] = -__builtin_inff();
        if (n < own) { float a = 0.f;
#pragma unroll
            for (int d0 = 0; d0 < 8; ++d0) { const float* kp = kl + n * 128 + d0 * 16 + hi * 8; const f32x4 k0 = *(const f32x4*)kp, k1 = *(const f32x4*)(kp + 4); const bf16x8 q = S.qr[d0];
                a += bf2f((unsigned short)q[0]) * k0[0] + bf2f((unsigned short)q[1]) * k0[1] + bf2f((unsigned short)q[2]) * k0[2] + bf2f((unsigned short)q[3]) * k0[3]
                   + bf2f((unsigned short)q[4]) * k1[0] + bf2f((unsigned short)q[5]) * k1[1] + bf2f((unsigned short)q[6]) * k1[2] + bf2f((unsigned short)q[7]) * k1[3]; }
            g[n] = a + __shfl_xor(a, 32); } }
    unsigned sel = 0u;
#pragma unroll
    for (int r = 0; r < 3; ++r) { int best = -1; float bv = -__builtin_inff();
#pragma unroll
        for (int n = 0; n < 15; ++n) if (n < own && !((sel >> n) & 1u) && g[n] > bv) { bv = g[n]; best = n; }
        if (best >= 0) sel |= 1u << best; }
    if (hi == 0) sel_l[r32] = sel;
    asm volatile("s_waitcnt lgkmcnt(0)" ::: "memory");
}

#undef ROW
#undef VMW
#undef VMWN
#undef SLOAD
#undef SWRITE_K
#undef SWRITE_V
}

namespace idx {
typedef _Float16 f16x8 __attribute__((ext_vector_type(8)));
typedef float f32x16 __attribute__((ext_vector_type(16)));
constexpr int HIST_OFF = 0, MASKL_OFF = 131072, META_OFF = 139264, CAP = 1024;
__device__ __forceinline__ unsigned fkey(float v) { const unsigned u = __builtin_bit_cast(unsigned, v); return u ^ ((unsigned)((int)u >> 31) | 0x80000000u); }
template <int CTRL> __device__ __forceinline__ int dpp_i0(int v) { return __builtin_amdgcn_update_dpp(0, v, CTRL, 0xF, 0xF, true); }
__device__ __forceinline__ int suffix_sum64(int v, int lane) {
    int s = v;
    s += dpp_i0<0x101>(s); s += dpp_i0<0x102>(s); s += dpp_i0<0x104>(s); s += dpp_i0<0x108>(s);
    const int t1 = __builtin_amdgcn_readlane(s, 16), t2 = __builtin_amdgcn_readlane(s, 32), t3 = __builtin_amdgcn_readlane(s, 48);
    const int r = lane >> 4;
    return s + (r == 0 ? t1 + t2 + t3 : r == 1 ? t2 + t3 : r == 2 ? t3 : 0);
}
__device__ __forceinline__ int kbin(unsigned key) {
    const unsigned nt = ~(unsigned)((int)key >> 31);
    const unsigned mag = (key ^ nt) & 0x7fffffffu;
    int e6 = (int)(mag >> 17) - 107 * 64; e6 = e6 < 0 ? 0 : e6; e6 = e6 > 2047 ? 2047 : e6;
    return 2048 + (int)((unsigned)e6 ^ nt);
}
__device__ __forceinline__ float fadd1(float a, float b) { float r; asm("v_add_f32_e32 %0, %1, %2" : "=v"(r) : "v"(a), "v"(b)); return r; }
#define IDX_LATOM_ADD(p, v) __hip_atomic_fetch_add((LAS unsigned*)(p), (v), __ATOMIC_RELAXED, __HIP_MEMORY_SCOPE_WORKGROUP)
#define IDX_LATOM_OR(p, v) __hip_atomic_fetch_or((LAS unsigned*)(p), (v), __ATOMIC_RELAXED, __HIP_MEMORY_SCOPE_WORKGROUP)
template <bool CHECK>
__device__ __forceinline__ void tile1(const f16x8 (&b)[4], const int t, const f16x8 (&a)[2][4], const float (&sg)[2][16], int q0, int qh, int lane, LAS unsigned* hist, unsigned* ks) {
    const int c = lane & 31, hi = lane >> 5;
    f32x16 acc[2] = {};
#pragma unroll
    for (int kk = 0; kk < 4; ++kk) { acc[0] = __builtin_amdgcn_mfma_f32_32x32x16_f16(a[0][kk], b[kk], acc[0], 0, 0, 0); acc[1] = __builtin_amdgcn_mfma_f32_32x32x16_f16(a[1][kk], b[kk], acc[1], 0, 0, 0); }
    const int s = t * 32 + c;
#pragma unroll
    for (int m = 0; m < 2; ++m)
#pragma unroll
        for (int k = 0; k < 2; ++k) { const int ql = 8 * qh + 4 * m + 2 * hi + k;
            float e_[8];
#pragma unroll
            for (int r = 0; r < 8; ++r) e_[r] = __builtin_amdgcn_fmed3f(acc[m][8 * k + r], 0.f, sg[m][8 * k + r]);
            const float v = fadd1(fadd1(fadd1(e_[0], e_[1]), fadd1(e_[2], e_[3])), fadd1(fadd1(e_[4], e_[5]), fadd1(e_[6], e_[7])));
            const unsigned key = fkey(v);
            ks[(2 * m + k) * 64] = key;
            const int bin = kbin(key);
            IDX_LATOM_ADD(hist + ql * 2048 + (bin >> 1), (!CHECK || s <= q0 + ql) ? (1u << (16 * (bin & 1))) : 0u); }
}
__device__ __forceinline__ void pass1(const f16_t* KIb  , const f16x8 (&a)[2][4], const float (&sg)[2][16], int q0, int qh, int kp, int lane, LAS unsigned char* lds, unsigned* ks  ) {
    LAS unsigned* hist = (LAS unsigned*)(lds + HIST_OFF);
    const int tmax = (q0 + 15) >> 5;
    if (kp > tmax) return;
    int tl = kp + ((tmax - kp) & ~3);
    const bool own = tl == tmax;
    const f16_t* kr = KIb + lane * 8;
    f16x8 b0[4], b1[4], b2[4], b3[4];
#define IDX_LD(dst, t_) do { const int tt_ = (t_) < tmax ? (t_) : tmax; const f16_t* p_ = kr + (size_t)tt_ * 2048; _Pragma("unroll") for (int kk = 0; kk < 4; ++kk) dst[kk] = *(const f16x8*)(p_ + kk * 512); __builtin_amdgcn_fence(__ATOMIC_RELEASE, "wavefront"); } while (0)
#define IDX_TILE(bb, tt) do { tile1<false>(bb, tt, a, sg, q0, qh, lane, hist, ks); ks += 256; } while (0)
    int t = kp;
    if (own) IDX_LD(b3, tmax);
    IDX_LD(b0, t); IDX_LD(b1, t + 4); IDX_LD(b2, t + 8);
    if (own) { tile1<true>(b3, tmax, a, sg, q0, qh, lane, hist, ks + ((tmax - kp) >> 2) * 256); tl -= 4; }
    for (; t + 12 <= tl; t += 16) {
        IDX_LD(b3, t + 12); IDX_TILE(b0, t);
        IDX_LD(b0, t + 16); IDX_TILE(b1, t + 4);
        IDX_LD(b1, t + 20); IDX_TILE(b2, t + 8);
        IDX_LD(b2, t + 24); IDX_TILE(b3, t + 12);
    }
    if (t <= tl) { IDX_TILE(b0, t); if (t + 4 <= tl) { IDX_TILE(b1, t + 4); if (t + 8 <= tl) IDX_TILE(b2, t + 8); } }
#undef IDX_LD
#undef IDX_TILE
}
__device__ __forceinline__ void pass2(int q0, int qh, int kp, int lane, LAS unsigned char* lds, const unsigned* ks) {
    const int c = lane & 31, hi = lane >> 5;
    LAS unsigned* hist = (LAS unsigned*)(lds + HIST_OFF); LAS unsigned* maskl = (LAS unsigned*)(lds + MASKL_OFF); LAS int* meta = (LAS int*)(lds + META_OFF);
    const int tmax = (q0 + 15) >> 5;
    if (kp > tmax) return;
    const int n = ((tmax - kp) >> 2) + 1;
    int thr[4];
#pragma unroll
    for (int j = 0; j < 4; ++j) thr[j] = meta[(8 * qh + 4 * (j >> 1) + 2 * hi + (j & 1)) * 4];
    unsigned ka[16], kb[16];
#define IDX_LDG(dst, g_) do { _Pragma("unroll") for (int u = 0; u < 4; ++u) { const int i_ = 4 * (g_) + u < n ? n - 1 - (4 * (g_) + u) : 0; _Pragma("unroll") for (int j = 0; j < 4; ++j) dst[4 * u + j] = ks[i_ * 256 + j * 64]; } \
        __builtin_amdgcn_fence(__ATOMIC_RELEASE, "wavefront"); } while (0)
#define IDX_PRG(src, g_) do { _Pragma("unroll") for (int u = 0; u < 4; ++u) { const int io_ = 4 * (g_) + u; if (io_ < n) { const int i_ = n - 1 - io_, t = kp + 4 * i_, s = t * 32 + c; \
        _Pragma("unroll") for (int m = 0; m < 2; ++m) { unsigned long long bal[2]; \
            _Pragma("unroll") for (int k = 0; k < 2; ++k) { const int ql = 8 * qh + 4 * m + 2 * hi + k; const unsigned key = src[4 * u + 2 * m + k]; const int bin = kbin(key); const bool valid = s <= q0 + ql; \
                bal[k] = __ballot(valid && bin > thr[2 * m + k]); \
                if (valid && bin == thr[2 * m + k]) { const unsigned p = IDX_LATOM_ADD((LAS unsigned*)(meta + ql * 4 + 2), 1u); \
                    if (p < (unsigned)CAP) { LAS unsigned* e = hist + ql * 2048 + 2 * p; e[0] = key; e[1] = (unsigned)s; } } } \
            if (lane == 0) { const int qb = 8 * qh + 4 * m; \
                maskl[(qb + 0) * 128 + t] = (unsigned)bal[0]; maskl[(qb + 2) * 128 + t] = (unsigned)(bal[0] >> 32); \
                maskl[(qb + 1) * 128 + t] = (unsigned)bal[1]; maskl[(qb + 3) * 128 + t] = (unsigned)(bal[1] >> 32); } } } } } while (0)
    const int ng = (n + 3) >> 2;
    IDX_LDG(ka, 0);
    for (int g = 0; g < ng; g += 2) {
        IDX_LDG(kb, g + 1); IDX_PRG(ka, g);
        IDX_LDG(ka, g + 2); IDX_PRG(kb, g + 1);
    }
#undef IDX_LDG
#undef IDX_PRG
}
struct Ops { f16x8 q[2][4]; float w[2]; f32x4 s[2][2][2]; };
__device__ __forceinline__ void load_raw(int b, int q0, const f16_t* QI, const float* WI, int wid, Ops& o) {
    const int lane = lane_opaque(), c = lane & 31, hi = lane >> 5, qh = wid & 1;
#pragma unroll
    for (int m = 0; m < 2; ++m) { const int qq = 2 * ((c >> 2) & 1) + (c >> 4), hd = 4 * ((c >> 3) & 1) + (c & 3);
        const size_t row = (size_t)b * SEQ + q0 + 8 * qh + 4 * m + qq;
        const f16_t* qr = QI + row * 512 + hd * 64 + hi * 8; o.w[m] = WI[row * 8 + hd];
#pragma unroll
        for (int kk = 0; kk < 4; ++kk) o.q[m][kk] = *(const f16x8*)(qr + kk * 16);
#pragma unroll
        for (int k = 0; k < 2; ++k) { const float* wp = WI + ((size_t)b * SEQ + q0 + 8 * qh + 4 * m + 2 * hi + k) * 8; o.s[m][k][0] = *(const f32x4*)wp; o.s[m][k][1] = *(const f32x4*)(wp + 4); } }
}
__device__ __forceinline__ void unit(int b, int q0, bool has_next, const f16_t* QI, const f16_t* KI, const float* WI, unsigned long long* MASK, unsigned* KS  , unsigned char* lds_, int wid, Ops& ops) {
    LAS unsigned char* lds = (LAS unsigned char*)lds_;
    const int lane = lane_opaque(), tid = wid * 64 + lane, c = lane & 31, hi = lane >> 5, qh = wid & 1, kp = wid >> 1;
    LAS unsigned* hist = (LAS unsigned*)(lds + HIST_OFF); LAS unsigned* maskl = (LAS unsigned*)(lds + MASKL_OFF); LAS int* meta = (LAS int*)(lds + META_OFF);
    for (int i = tid; i < 8192 + 512; i += NTHR) ((LAS u32x4*)hist)[i] = (u32x4){0u, 0u, 0u, 0u};
    if (tid < 64) meta[tid] = 0;
    f16x8 a[2][4]; float sg[2][16];
#pragma unroll
    for (int m = 0; m < 2; ++m) { const f16_t w = (f16_t)ops.w[m];
#pragma unroll
        for (int kk = 0; kk < 4; ++kk) a[m][kk] = ops.q[m][kk] * w;
#pragma unroll
        for (int r = 0; r < 16; ++r) { const float w2 = ops.s[m][r >> 3][(r >> 2) & 1][r & 3];
            sg[m][r] = (float)(f16_t)w2 < 0.f ? -__builtin_inff() : __builtin_inff(); } }
    const f16_t* KIb = KI + (size_t)b * SEQ * 64;
    __syncthreads();
    unsigned* ks = KS + (size_t)wid * 8192 + lane;
    pass1(KIb, a, sg, q0, qh, kp, lane, lds, ks);
    load_raw(b, has_next ? q0 + 16 : q0, QI, WI, wid, ops);
    __syncthreads();
#pragma unroll
    for (int k = 0; k < 2; ++k) { const int qi = 2 * wid + k, N = q0 + qi + 1;
        if (N > 256) {
            const LAS u32x4* h4 = (const LAS u32x4*)(hist + qi * 2048 + lane * 32);
            u32x4 hv[8];
#pragma unroll
            for (int i = 0; i < 8; ++i) hv[i] = h4[(i + lane) & 7];
            int tot = 0;
#pragma unroll
            for (int i = 0; i < 8; ++i)
#pragma unroll
                for (int d = 0; d < 4; ++d) { const unsigned w = hv[i][d]; tot += (int)(w & 0xffffu) + (int)(w >> 16); }
            const int suf = suffix_sum64(tot, lane);
            const unsigned long long ge = __ballot(suf >= 256);
            const int L = 63 - __clzll((long long)ge);
            const int above = __builtin_amdgcn_readlane(suf - tot, L);
            const unsigned w = hist[qi * 2048 + L * 32 + (lane >> 1)]; const int cnt = (lane & 1) ? (int)(w >> 16) : (int)(w & 0xffffu);
            const int sb = suffix_sum64(cnt, lane);
            const unsigned long long g2 = __ballot(above + sb >= 256);
            const int Bn = 63 - __clzll((long long)g2);
            if (lane == Bn) { meta[qi * 4] = L * 64 + Bn; meta[qi * 4 + 1] = 256 - (above + sb - cnt); }
        } else if (lane == 0) { meta[qi * 4] = -1; meta[qi * 4 + 1] = 0; }
    }
    __syncthreads();
    VM_WAIT();
    pass2(q0, qh, kp, lane, lds, ks);
    __syncthreads();
#pragma unroll
    for (int k = 0; k < 2; ++k) { const int qi = 2 * wid + k; const int need = __builtin_amdgcn_readfirstlane(meta[qi * 4 + 1]); int n = __builtin_amdgcn_readfirstlane(meta[qi * 4 + 2]); n = n < CAP ? n : CAP;
        const LAS unsigned* cl = hist + qi * 2048;
        if (n <= 64) {
            unsigned lo = 0u, hi2 = 0u;
            if (lane < n) { const u32x2 w = *(const LAS u32x2*)(cl + 2 * lane); lo = (w.x << 12) | (4095u - w.y); hi2 = w.x >> 20; }
            const unsigned long long mine = ((unsigned long long)hi2 << 32) | lo; int rank = 0;
            for (int j = 0; j < n; ++j) { const unsigned long long cj = ((unsigned long long)(unsigned)__builtin_amdgcn_readlane((int)hi2, j) << 32) | (unsigned)__builtin_amdgcn_readlane((int)lo, j); rank += cj > mine ? 1 : 0; }
            if (lane < n && rank < need) { const unsigned si = 4095u - (lo & 0xfffu); IDX_LATOM_OR(maskl + qi * 128 + (si >> 5), 1u << (si & 31)); }
        } else if (n <= 256) {
            unsigned long long cv[4];
#pragma unroll
            for (int e = 0; e < 4; ++e) { const int i = lane + 64 * e; cv[e] = 0ull;
                if (i < n) { const u32x2 w = *(const LAS u32x2*)(cl + 2 * i); cv[e] = ((unsigned long long)w.x << 12) | (unsigned long long)(4095u - w.y); } }
            unsigned long long Tv = 0ull;
            if (n > 0) for (int b = 43; b >= 0; --b) { const unsigned long long t = Tv | (1ull << b); int cnt = 0;
#pragma unroll
                for (int e = 0; e < 4; ++e) cnt += __popcll(__ballot(cv[e] >= t));
                if (cnt >= need) Tv = t; }
#pragma unroll
            for (int e = 0; e < 4; ++e) { const int i = lane + 64 * e; if (i < n && cv[e] >= Tv) { const unsigned si = 4095u - (unsigned)(cv[e] & 0xfffull); IDX_LATOM_OR(maskl + qi * 128 + (si >> 5), 1u << (si & 31)); } }
        } else {
            for (int i0 = 0; i0 < n; i0 += 64) { const int i = i0 + lane; const bool act = i < n; const unsigned ki = act ? cl[2 * i] : 0u, si = act ? cl[2 * i + 1] : 0u; int rank = 0;
                for (int j = 0; j < n; j += 2) { const u32x4 e = *(const LAS u32x4*)(cl + 2 * j);
                    rank += (e.x > ki || (e.x == ki && e.y < si)) ? 1 : 0; if (j + 1 < n) rank += (e.z > ki || (e.z == ki && e.w < si)) ? 1 : 0; }
                if (act && rank < need) IDX_LATOM_OR(maskl + qi * 128 + (si >> 5), 1u << (si & 31)); }
        }
    }
    __syncthreads();
    { const int qi = tid >> 5, w4 = tid & 31;
      const u32x4 v = *(const LAS u32x4*)(maskl + qi * 128 + w4 * 4);
      unsigned long long* tb_ = MASK + ((size_t)b * SEQ + (q0 & ~63)) * 64 + (q0 & 63) + qi;
      *(u32x2*)(tb_ + (size_t)(2 * w4) * 64) = (u32x2){v.x, v.y}; *(u32x2*)(tb_ + (size_t)(2 * w4 + 1) * 64) = (u32x2){v.z, v.w}; }
    __syncthreads();
}
#undef IDX_LATOM_ADD
#undef IDX_LATOM_OR
}


__device__ __forceinline__ void phase6(const Args& A, unsigned char* lds_, const int wave) {
    char* lds = (char*)lds_;
    att::Seam S;
#define P6_WS() unsigned char* ws = A.ws; asm volatile("" : "+s"(ws))
    for (int v = blockIdx.x; v < 256; v += gridDim.x) {
        {
            P6_WS();
            const bf16_t* QM = (const bf16_t*)(ws + WS_QM); const bf16_t* KM = (const bf16_t*)(ws + WS_KM); const bf16_t* VM = (const bf16_t*)(ws + WS_VM);
            bf16_t* OO = (bf16_t*)(ws + WS_H); float* SSQO = (float*)(ws + WS_OM); const float* KMEAN = (const float*)(ws + WS_KMEAN);
            const int bh = (v & 7) * 4 + (v >> 6), j = (v >> 3) & 7;
            for (int ps = 0; ps < 2; ++ps) { const int qb = ps ? 15 - j : j; const int qpos = qb * 256 + 32 * wave;
                if ((v & 3) == ps) { __syncthreads(); convert_experts(A, lds_, wave); __syncthreads(); }
                att::Blk cur; cur.Qw = QM + ((size_t)bh * SEQ + qpos) * 128; cur.K = KM + (size_t)bh * SEQ * 128; cur.V = VM + (size_t)bh * SEQ * 128;
                cur.Ow = OO + ((size_t)(bh >> 2) * SEQ + qpos) * 1024 + (bh & 3) * 128; cur.Sq = SSQO + ((size_t)(bh >> 2) * SEQ + qpos) * 8 + (bh & 3); cur.NT = 4 * (qb + 1); cur.qpos = qpos; cur.own_t0 = 4 * qb; cur.mrow = nullptr;
                att::att_prime(cur, lds, S, wave);
                att::moba_gate(S, KMEAN + (size_t)bh * 16 * 128, qb, lds, wave);
                att::att_block<0>(cur, cur, lds, S, wave); }
        }
        {
            P6_WS();
            const bf16_t* QD = (const bf16_t*)(ws + WS_QD); const bf16_t* KD = (const bf16_t*)(ws + WS_KD); const bf16_t* VD = (const bf16_t*)(ws + WS_VD);
            bf16_t* OO = (bf16_t*)(ws + WS_H); float* SSQO = (float*)(ws + WS_OM);
            const f16_t* QI = (const f16_t*)(ws + WS_QI); const f16_t* KI = (const f16_t*)(ws + WS_KI); const float* WI = (const float*)(ws + WS_WI);
            unsigned long long* MASK = (unsigned long long*)(ws + WS_MASK);
            const int b = 2 * (v & 3) + ((v >> 3) & 1), j = (v >> 4) + 16 * ((v >> 2) & 1);
            for (int ps = 0; ps < 2; ++ps) { const int qt = ps ? 63 - j : j;
                if ((v & 3) == 2 + ps) { __syncthreads(); convert_experts(A, lds_, wave); __syncthreads(); }
                { idx::Ops ops; idx::load_raw(b, 64 * qt, QI, WI, wave, ops);
                  for (int i = 0; i < 4; ++i) idx::unit(b, 64 * qt + 16 * i, i < 3, QI, KI, WI, MASK, (unsigned*)(ws + WS_KS) + (size_t)blockIdx.x * 65536, lds_, wave, ops); }
                VM_WAIT(); __syncthreads();
                const int qpos = 64 * qt + 32 * (wave >> 2), hd = wave & 3;
                att::Blk cur; cur.Qw = QD + ((size_t)(b * 4 + hd) * SEQ + qpos) * 128; cur.K = KD + (size_t)b * SEQ * 128; cur.V = VD + (size_t)b * SEQ * 128;
                cur.Ow = OO + ((size_t)b * SEQ + qpos) * 1024 + 512 + hd * 128; cur.Sq = SSQO + ((size_t)b * SEQ + qpos) * 8 + 4 + hd; cur.NT = qt + 1; cur.qpos = qpos; cur.own_t0 = 0; cur.mrow = MASK + ((size_t)b * SEQ + 64 * qt) * 64;
                att::att_prime(cur, lds, S, wave);
                att::att_block<1>(cur, cur, lds, S, wave); }
        }
    }
#undef P6_WS
}

__device__ __forceinline__ void phase9(const Args& A, const int wave) {
    const int lane = lane_opaque();
    const int gw = blockIdx.x * NWAVES + wave, NGW = gridDim.x * NWAVES;
    const bf16_t* x1 = (const bf16_t*)(A.ws + WS_X1); const float* mod = (const float*)(A.ws + WS_MOD); bf16_t* H2 = (bf16_t*)(A.ws + WS_H2);
    for (int row = gw; row < T; row += NGW) {
        const float* mb = mod + (size_t)(row >> 12) * 6144; f32x4 v[4];
        modnorm_row<true>(x1 + (size_t)row * DM, A.in[11], mb + 3072, mb + 4096, lane, v);
#pragma unroll
        for (int j = 0; j < 4; ++j) { unsigned h[4]; float l[4];
#pragma unroll
            for (int k = 0; k < 4; ++k) { h[k] = f2bf(v[j][k]); l[k] = v[j][k] - bf2f(h[k]); }
            u32x2 oh, ol; oh.x = h[0] | (h[1] << 16); oh.y = h[2] | (h[3] << 16); ol.x = pk2(l[0], l[1]); ol.y = pk2(l[2], l[3]);
            *((u32x2*)(H2 + (size_t)row * 2048) + lane + 64 * j) = oh; *((u32x2*)(H2 + (size_t)row * 2048 + 1024) + lane + 64 * j) = ol; }
    }
}

__device__ __forceinline__ void phase11(const Args& A, unsigned char* lds_, const int wave) {
    const int lane = lane_opaque();
    LAS int* sE = (LAS int*)((LAS unsigned char*)lds_ + wave * 1024); LAS float* sW = (LAS float*)(sE + 128);
    LAS int* hcnt = (LAS int*)((LAS unsigned char*)lds_ + 8192); LAS int* hbase = hcnt + NE;
    { const int t_ = wave * 64 + lane; if (t_ < NE) hcnt[t_] = 0; } __syncthreads();
    const int gw = blockIdx.x * NWAVES + wave, NGW = gridDim.x * NWAVES;
    unsigned char* ws = A.ws;
    const float* RLOG = (const float*)(ws + WS_RLOG); const float* bias = A.in[13];
    float* EW = (float*)(ws + WS_EW); int* LIST = (int*)(ws + WS_LIST); int* CNT = (int*)(ws + WS_CTL) + CW_CNT;
    const float NINF = -__builtin_inff();
    const int half = lane >> 5;
    float lgn[4];
#pragma unroll
    for (int j = 0; j < 4; ++j) { const int e = lane + 64 * j; lgn[j] = (gw < T) ? RLOG[(size_t)gw * 512 + e] + RLOG[(size_t)gw * 512 + 256 + e] : 0.f; }
    int it = 0;
    for (int row = gw; row < T; row += NGW, ++it) {
        float sc[4], bv[4];
#pragma unroll
        for (int j = 0; j < 4; ++j) { const int e = lane + 64 * j; const float lg = lgn[j];
            sc[j] = 1.f / (1.f + expf(-lg)); bv[j] = sc[j] + bias[e]; }
        if (row + NGW < T) {
#pragma unroll
            for (int j = 0; j < 4; ++j) { const int e = lane + 64 * j; lgn[j] = RLOG[(size_t)(row + NGW) * 512 + e] + RLOG[(size_t)(row + NGW) * 512 + 256 + e]; } }
        float gs[8];
#pragma unroll
        for (int j = 0; j < 4; ++j) { float m1l, m1h; half_max_dpp(bv[j], m1l, m1h); const float m1 = half ? m1h : m1l;
            const unsigned long long bal = __ballot(bv[j] == m1); const int fl = __ffs((unsigned)bal) - 1, fh = __ffs((unsigned)(bal >> 32)) - 1;
            const float v2 = ((lane & 31) == (half ? fh : fl)) ? NINF : bv[j]; float m2l, m2h; half_max_dpp(v2, m2l, m2h);
            gs[2 * j] = m1l + m2l; gs[2 * j + 1] = m1h + m2h; }
        unsigned gmask = 0u;
#pragma unroll
        for (int g = 0; g < 8; ++g) { int rank = 0;
#pragma unroll
            for (int o = 0; o < 8; ++o) rank += (gs[o] > gs[g] || (gs[o] == gs[g] && o < g)) ? 1 : 0;
            if (rank < 4) gmask |= 1u << g; }
        float val[4];
#pragma unroll
        for (int j = 0; j < 4; ++j) val[j] = ((gmask >> (half + 2 * j)) & 1u) ? bv[j] : NINF;
        int ei[8]; float ew[8]; float wsum = 0.f;
#pragma unroll
        for (int r = 0; r < 8; ++r) {
            const float lm = fmaxf(fmaxf(val[0], val[1]), fmaxf(val[2], val[3])); const float m = wave_max_dpp(lm);
            const unsigned long long b0 = __ballot(val[0] == m), b1 = __ballot(val[1] == m), b2 = __ballot(val[2] == m), b3 = __ballot(val[3] == m);
            const int js = b0 ? 0 : b1 ? 1 : b2 ? 2 : 3; const unsigned long long bs = b0 ? b0 : b1 ? b1 : b2 ? b2 : b3;
            const int ls = __ffsll((long long)bs) - 1; const int es = ls + 64 * js;
            const float mys = js == 0 ? sc[0] : js == 1 ? sc[1] : js == 2 ? sc[2] : sc[3];
            const float w = rdl_f(mys, ls);
#pragma unroll
            for (int j = 0; j < 4; ++j) val[j] = (lane == ls && js == j) ? NINF : val[j];
            ei[r] = es; ew[r] = w; wsum += w; }
        int my_e = 0; float my_w = 0.f;
#pragma unroll
        for (int r = 0; r < 8; ++r) if (lane == r) { my_e = ei[r]; my_w = ew[r] / wsum * 2.5f; }
        if (lane < 8) { sE[it * 8 + lane] = my_e; sW[it * 8 + lane] = my_w; }
    }
    LDS_WAIT();
    int eL[2], rkL[2], entL[2]; bool actL[2];
#pragma unroll
    for (int h = 0; h < 2; ++h) { const int p = lane + 64 * h, ti = p >> 3; const int row = gw + ti * NGW;
        actL[h] = ti < it; eL[h] = 0; rkL[h] = 0; entL[h] = row * 8 + (p & 7);
        if (actL[h]) { eL[h] = sE[p]; EW[entL[h]] = sW[p]; rkL[h] = __hip_atomic_fetch_add(hcnt + eL[h], 1, __ATOMIC_RELAXED, __HIP_MEMORY_SCOPE_WORKGROUP); } }
    __syncthreads();
    { const int t_ = wave * 64 + lane; if (t_ < NE) { const int c = hcnt[t_]; hbase[t_] = c > 0 ? atomicAdd(&CNT[t_ * CNT_STRIDE], c) : 0; } }
    __syncthreads();
#pragma unroll
    for (int h = 0; h < 2; ++h) if (actL[h]) LIST[(size_t)eL[h] * T + hbase[eL[h]] + rkL[h]] = entL[h];
}

__device__ __forceinline__ int moe_tables(const Args& A, unsigned char* lds_, const int wave) {
    LAS int* cnt = (LAS int*)((LAS unsigned char*)lds_ + TAB_OFF); LAS int* tstart = cnt + 264;
    const int* CNT = (const int*)(A.ws + WS_CTL) + CW_CNT;
    const int tid = wave * 64 + lane_opaque();
    if (tid < NE) cnt[tid] = __hip_atomic_load(CNT + tid * CNT_STRIDE, __ATOMIC_RELAXED, __HIP_MEMORY_SCOPE_AGENT);
    if (tid == NE) cnt[NE] = T;
    __syncthreads();
    if (wave == 0) {
        const int l = tid; const u32x4 c4 = *(const LAS u32x4*)(cnt + 4 * l);
        const int t0 = (int)(c4.x + 255u) >> 8, t1 = (int)(c4.y + 255u) >> 8, t2 = (int)(c4.z + 255u) >> 8, t3 = (int)(c4.w + 255u) >> 8, loc = (t0 + t1) + (t2 + t3);
        int p = loc;
        p += idx::dpp_i0<0x111>(p); p += idx::dpp_i0<0x112>(p); p += idx::dpp_i0<0x114>(p); p += idx::dpp_i0<0x118>(p);
        const int r0 = __builtin_amdgcn_readlane(p, 15), r1 = __builtin_amdgcn_readlane(p, 31), r2 = __builtin_amdgcn_readlane(p, 47);
        const int rr = l >> 4; p += rr == 0 ? 0 : rr == 1 ? r0 : rr == 2 ? r0 + r1 : r0 + r1 + r2;
        const int ex = p - loc;
        *(LAS u32x4*)(tstart + 4 * l) = (u32x4){(unsigned)ex, (unsigned)(ex + t0), (unsigned)(ex + t0 + t1), (unsigned)(ex + t0 + t1 + t2)};
        if (l == 63) { tstart[NE] = p; tstart[NEX] = p + ((T + 255) >> 8); }
    }
    __syncthreads();
    return tstart[NEX];
}


__device__ __forceinline__ void phase14(const Args& A, const int wave) {
    const int lane = lane_opaque();
    const int gw = blockIdx.x * NWAVES + wave, NGW = gridDim.x * NWAVES;
    float* out = A.out; const float* mod = (const float*)(A.ws + WS_MOD); const int* INV = (const int*)(A.ws + WS_INV);
    const unsigned char* CA = (const unsigned char*)(A.ws + WS_CA); const bf16_t* SH = (const bf16_t*)(A.ws + WS_SH); const bf16_t* X1 = (const bf16_t*)(A.ws + WS_X1);
#define P14_LOAD(pr_, row_, w_, x_, g2_) do { _Pragma("unroll") for (int k = 0; k < 8; ++k) { const int p = __builtin_amdgcn_readlane(pr_, k); w_[k] = *((const u32x4*)(CA + (size_t)p * DM) + lane); } \
        _Pragma("unroll") for (int q = 0; q < 4; ++q) g2_[q] = *((const f32x4*)(mod + (size_t)((row_) >> 12) * 6144 + 5120 + 16 * lane) + q); \
        w_[8] = *((const u32x4*)((const unsigned char*)SH + (size_t)(row_) * DM) + lane); \
        w_[10] = *((const u32x4*)(X1 + (size_t)(row_) * DM + 16 * lane)); w_[11] = *((const u32x4*)(X1 + (size_t)(row_) * DM + 16 * lane) + 1); } while (0)
#define P14_FIN(row_, w_, x_, g2_) do { float* orow = out + (size_t)(row_) * DM + 16 * lane; \
        float y[16]; _Pragma("unroll") for (int q = 0; q < 16; ++q) y[q] = 0.f; \
        _Pragma("unroll") for (int k = 0; k < 8; ++k) _Pragma("unroll") for (int d = 0; d < 4; ++d) { \
            const f32x2 lo = __builtin_amdgcn_cvt_pk_f32_fp8((int)w_[k][d], false), hi = __builtin_amdgcn_cvt_pk_f32_fp8((int)w_[k][d], true); \
            y[4 * d] += lo[0]; y[4 * d + 1] += lo[1]; y[4 * d + 2] += hi[0]; y[4 * d + 3] += hi[1]; } \
        float ysh[16]; _Pragma("unroll") for (int d = 0; d < 4; ++d) { \
            const f32x2 lo = __builtin_amdgcn_cvt_pk_f32_fp8((int)w_[8][d], false), hi = __builtin_amdgcn_cvt_pk_f32_fp8((int)w_[8][d], true); \
            ysh[4 * d] = lo[0]; ysh[4 * d + 1] = lo[1]; ysh[4 * d + 2] = hi[0]; ysh[4 * d + 3] = hi[1]; } \
        float v[16]; float s = 0.f; \
        _Pragma("unroll") for (int q = 0; q < 4; ++q) { const f32x4 g = g2_[q]; \
            _Pragma("unroll") for (int e = 0; e < 4; ++e) { const unsigned xw = w_[10 + (q >> 1)][2 * (q & 1) + (e >> 1)]; \
                const float xv = (e & 1) ? bfhi(xw) : bflo(xw); \
                v[4 * q + e] = xv + g[e] * (y[4 * q + e] * (1.f / 16.f) + ysh[4 * q + e] * 0.25f); s += v[4 * q + e] * v[4 * q + e]; } } \
        const float rstd = 1.f / sqrtf(wave_sum_dpp(s) * (1.f / DM) + EPS); \
        _Pragma("unroll") for (int q = 0; q < 4; ++q) { const f32x4 g = gfin[q]; \
            *((f32x4*)orow + q) = (f32x4){v[4 * q] * rstd * g[0], v[4 * q + 1] * rstd * g[1], v[4 * q + 2] * rstd * g[2], v[4 * q + 3] * rstd * g[3]}; } } while (0)
    f32x4 gfin[4];
#pragma unroll
    for (int q = 0; q < 4; ++q) gfin[q] = *((const f32x4*)(A.in[20] + 16 * lane) + q);
    int prA = (gw < T) ? INV[(size_t)gw * 8 + (lane & 7)] : 0, prB = (gw + NGW < T) ? INV[(size_t)(gw + NGW) * 8 + (lane & 7)] : 0;
    for (int row = gw; row < T; row += 2 * NGW) {
        const int rowB = row + NGW; const bool hasB = rowB < T;
        const int pa = prA, pb = prB;
        if (row + 2 * NGW < T) prA = INV[(size_t)(row + 2 * NGW) * 8 + (lane & 7)];
        if (row + 3 * NGW < T) prB = INV[(size_t)(row + 3 * NGW) * 8 + (lane & 7)];
        u32x4 wa[12], wb[12]; f32x4 xa[4], xb[4], ga[4], gb[4];
        P14_LOAD(pa, row, wa, xa, ga);
        if (hasB) P14_LOAD(pb, rowB, wb, xb, gb);
        P14_FIN(row, wa, xa, ga);
        if (hasB) P14_FIN(rowB, wb, xb, gb);
    }
#undef P14_LOAD
#undef P14_FIN
}

__global__ void __launch_bounds__(NTHR, 2) fwd(Args args) {
    extern __shared__ __attribute__((aligned(16))) unsigned char lds[];
    const int wave = __builtin_amdgcn_readfirstlane((int)threadIdx.x >> 6);
    volatile LAS unsigned* MISC = (volatile LAS unsigned*)((LAS unsigned char*)lds + MISC_OFF);
    if (wave == 0) MISC[lane_opaque()] = 0u;
    __syncthreads();
    const int lo = args.ph_lo, hi = args.ph_hi;
    unsigned char* ws = args.ws;
    XcdBarrier bar; bar.bar = (unsigned*)(ws + WS_CTL); bar.x = 0; bar.st = nullptr;
    if (hi - lo > 1) bar = xcd_barrier_post((unsigned*)(ws + WS_CTL), MISC, wave == 0 && lane_opaque() == 0);
    const int G = gridDim.x, cid = blockIdx.x;
#define IN(k) (lo <= (k) && (k) < hi)
#define SEAM(k) do { if (IN(k) && IN((k) + 1)) xcd_barrier(bar, wave); } while (0)
    LAS unsigned char* ring = (LAS unsigned char*)lds;

    if (IN(0)) { phase0(args, lds, wave); __syncthreads(); } SEAM(0);
    if (IN(1)) { phase1(args, wave); } SEAM(1);
    if (IN(2)) {
        pg8::DenseSched S; S.init(ws + WS_H, 2048u, ws + WS_WIN, 2048u, T, NPROJP, G, cid);
        pg8::EpiProjFused E{(bf16_t*)(ws + WS_QM), (bf16_t*)(ws + WS_KM), (bf16_t*)(ws + WS_VM), (bf16_t*)(ws + WS_QD), (bf16_t*)(ws + WS_CKVN), (float*)(ws + WS_KVRAW),
                            (f16_t*)(ws + WS_QI), (f16_t*)(ws + WS_KI), (float*)(ws + WS_WI), (const float*)(ws + WS_COSH), (const float*)(ws + WS_SINH), (const float*)(ws + WS_COSI), (const float*)(ws + WS_SINI)};
        pg8::gemm_phase<pg8::EpiProjFused, pg8::DenseSched, true>(ring, S, E, 1024, wave);
    }
    if (IN(2) && IN(4)) xcd_barrier(bar, wave);
    if (IN(4)) {
        const int ngemm = T / 256;
        if (G > ngemm && cid >= ngemm) kmean_units(args, lds, wave, cid - ngemm, G - ngemm);
        else {
            pg8::DenseSched S; S.init(ws + WS_CKVN, 512u, ws + WS_WKV, 512u, T, 256, G, cid);
            pg8::EpiKV E{(bf16_t*)(ws + WS_KD), (bf16_t*)(ws + WS_VD), (const float*)(ws + WS_KVRAW), (const float*)(ws + WS_COSH), (const float*)(ws + WS_SINH)};
            pg8::gemm_phase<pg8::EpiKV, pg8::DenseSched, true>(ring, S, E, 256, wave);
            if (G <= ngemm) { __syncthreads(); kmean_units(args, lds, wave, cid, G); }
        }
    }
    if (IN(4) && IN(6)) xcd_barrier(bar, wave);
    if (IN(6)) { phase6(args, lds, wave); __syncthreads(); }
    if (IN(6) && IN(8)) xcd_barrier(bar, wave);
    if (IN(8)) {
        pg8::DenseSched S; S.init(ws + WS_H, 2048u, ws + WS_WOUT, 2048u, T, 1024, G, cid);
        pg8::EpiResidNorm E{args.in[0], (bf16_t*)(ws + WS_X1), (const float*)(ws + WS_MOD), (const float*)(ws + WS_OM), (LAS float*)((LAS unsigned char*)lds + TOK_OFF)};
        pg8::gemm_phase<pg8::EpiResidNorm, pg8::DenseSched, true, true>(ring, S, E, 1024, wave);
    } SEAM(8);
    if (IN(9)) { phase9(args, wave); } SEAM(9);
    if (IN(10)) {
        pg8::DenseSched S; S.init(ws + WS_H2, 4096u, ws + WS_WR, 4096u, T, 512, G, cid);
        pg8::EpiF32 E{(float*)(ws + WS_RLOG), 512};
        pg8::gemm_phase<pg8::EpiF32, pg8::DenseSched, true>(ring, S, E, 2048, wave);
    } SEAM(10);
    if (IN(11)) { phase11(args, lds, wave); } SEAM(11);
    if (IN(12)) {
        const int total_rt = moe_tables(args, lds, wave);
        pg8::MoeTab tb{(const LAS int*)((LAS unsigned char*)lds + TAB_OFF), (const LAS int*)((LAS unsigned char*)lds + TAB_OFF) + 264};
        LAS int* tokl = (LAS int*)((LAS unsigned char*)lds + TOK_OFF);
        LAS int* utab = (LAS int*)((LAS unsigned char*)lds + TAB_OFF) + 528;
        pg8::MoeUpSched S{tb, (const char*)(ws + WS_H2), tokl, (const char*)(ws + WS_WGU), 2048u, total_rt * 2, G, cid, utab};
        { const int t_ = wave * 64 + lane_opaque(); if (t_ < pg8::UT_MAX) { pg8::Unit u; const bool ok = S.compute(t_, u); *(LAS u32x4*)(utab + 4 * t_) = ok ? (u32x4){(unsigned)u.e, (unsigned)u.rt, (unsigned)(u.pn | ((u.e == NE ? 256 : (tb.cnt[u.e] - u.pm * 256 < 256 ? tb.cnt[u.e] - u.pm * 256 : 256)) << 8)), (unsigned)u.pm} : (u32x4){~0u, 0u, 0u, 0u}; } __syncthreads(); }
        {
            const int lane = lane_opaque(), tid = wave * 64 + lane, half = tid >> 8, row = tid & 255;
            const int* list = (const int*)(ws + WS_LIST); const float* ew = (const float*)(ws + WS_EW); int* inv = (int*)(ws + WS_INV);
            int ue = -1, upm = 0, urt = 0;
            { pg8::Unit u; if (lane < MAX_UNITS && S.next(lane, u)) { ue = u.e; upm = u.pm; urt = u.rt; } }
            const int nun = __popcll(__ballot(ue >= 0));
            for (int i0 = 0; i0 < MAX_UNITS / 2; i0 += 5) {
                int ent[5], ke[5], kpos[5], krt[5]; bool val[5];
#pragma unroll
                for (int jj = 0; jj < 5; ++jj) { const int k = half + 2 * (i0 + jj), kc = k < MAX_UNITS ? k : 0;
                    ke[jj] = __builtin_amdgcn_readlane(ue, kc); krt[jj] = __builtin_amdgcn_readlane(urt, kc); kpos[jj] = __builtin_amdgcn_readlane(upm, kc) * 256 + row;
                    val[jj] = k < nun && ke[jj] != NE && kpos[jj] < tb.cnt[ke[jj] < 0 ? 0 : ke[jj]];
                    ent[jj] = list[(size_t)(val[jj] ? ke[jj] : 0) * T + (val[jj] ? kpos[jj] : 0)]; }
                float wv[5];
#pragma unroll
                for (int jj = 0; jj < 5; ++jj) { ent[jj] = val[jj] ? ent[jj] : 0; wv[jj] = ew[ent[jj]]; }
#pragma unroll
                for (int jj = 0; jj < 5; ++jj) { const int k = half + 2 * (i0 + jj);
                    if (k < nun) { unsigned tw = 0u;
                        if (ke[jj] == NE) tw = (unsigned)kpos[jj] | 0x3C000000u;
                        else if (val[jj]) { const f16_t wh = (f16_t)wv[jj]; tw = (unsigned)(ent[jj] >> 3) | ((unsigned)__builtin_bit_cast(unsigned short, wh) << 16); inv[ent[jj]] = krt[jj] * 256 + row; }
                        tokl[k * 256 + row] = (int)tw; } }
            }
            __syncthreads();
        }
        pg8::EpiAct E{(bf16_t*)(ws + WS_ACT), tokl};
        pg8::gemm_phase<pg8::EpiAct, pg8::MoeUpSched, true>(ring, S, E, 1024, wave);
    } SEAM(12);
    if (IN(13)) {
        const int total_rt = moe_tables(args, lds, wave);
        pg8::MoeTab tb{(const LAS int*)((LAS unsigned char*)lds + TAB_OFF), (const LAS int*)((LAS unsigned char*)lds + TAB_OFF) + 264};
        LAS int* utab = (LAS int*)((LAS unsigned char*)lds + TAB_OFF) + 528;
        pg8::MoeDownSched S{tb, (const char*)(ws + WS_ACT), (const char*)(ws + WS_WD), 512u, total_rt * 4, G, cid, utab};
        { const int t_ = wave * 64 + lane_opaque(); if (t_ < pg8::UT_MAX) { pg8::Unit u; const bool ok = S.compute(t_, u); *(LAS u32x4*)(utab + 4 * t_) = ok ? (u32x4){(unsigned)u.e, (unsigned)u.rt, (unsigned)(u.pn | ((u.e == NE ? 256 : (tb.cnt[u.e] - u.pm * 256 < 256 ? tb.cnt[u.e] - u.pm * 256 : 256)) << 8)), (unsigned)u.pm} : (u32x4){~0u, 0u, 0u, 0u}; } __syncthreads(); }
        pg8::EpiDown E{(bf16_t*)(ws + WS_CA), (bf16_t*)(ws + WS_SH)};
        pg8::gemm_phase<pg8::EpiDown, pg8::MoeDownSched, true>(ring, S, E, 256, wave);
    } SEAM(13);
    if (IN(14)) { phase14(args, wave); }
#undef IN
#undef SEAM
}

#ifndef N_LAUNCHES
#define N_LAUNCHES 1
#endif
extern "C" void kernel_launch(void* const* d_in, const int* in_sizes, int n_in, void* d_out, int out_size, void* d_ws, size_t ws_size, hipStream_t stream) {
    static int grid = 0;
    if (grid == 0) {
        if (n_in != 21 || in_sizes[0] != T * DM || out_size != T * DM || ws_size < WS_END) {
            fprintf(stderr, "kernel_launch: shape/workspace mismatch (n_in %d, in0 %d, out %d, ws %zu, need %zu); nothing launched\n", n_in, n_in > 0 ? in_sizes[0] : -1, out_size, ws_size, (size_t)WS_END); grid = -1; return; }
        int dev = 0, cus = 0, per_cu = 0;
        if (hipGetDevice(&dev) != hipSuccess || hipDeviceGetAttribute(&cus, hipDeviceAttributeMultiprocessorCount, dev) != hipSuccess) { grid = -1; return; }
        if (hipFuncSetAttribute((const void*)fwd, hipFuncAttributeMaxDynamicSharedMemorySize, LDS_BYTES) != hipSuccess) { fprintf(stderr, "kernel_launch: hipFuncSetAttribute failed\n"); grid = -1; return; }
        if (hipOccupancyMaxActiveBlocksPerMultiprocessor(&per_cu, (const void*)fwd, NTHR, LDS_BYTES) != hipSuccess || per_cu < 1) fprintf(stderr, "kernel_launch: occupancy query says %d\n", per_cu);
        (void)hipGetLastError();
        grid = cus;
    }
    if (grid < 0) return;
    (void)hipMemsetAsync((char*)d_ws + WS_CTL, 0, CTL_ZERO_BYTES, stream);
    Args a{};
    for (int i = 0; i < 21; ++i) a.in[i] = (const float*)d_in[i];
    a.out = (float*)d_out; a.ws = (unsigned char*)d_ws;
    if (N_LAUNCHES == 1) { a.ph_lo = 0; a.ph_hi = NPHASE; hipLaunchKernelGGL(fwd, dim3(grid), dim3(NTHR), LDS_BYTES, stream, a); }
    else for (int p = 0; p < NPHASE; ++p) { a.ph_lo = p; a.ph_hi = p + 1; hipLaunchKernelGGL(fwd, dim3(grid), dim3(NTHR), LDS_BYTES, stream, a); }
}
```

```cpp
#include <hip/hip_runtime.h>
#include <cstdio>
#include <cstdint>

#define GAS __attribute__((address_space(1)))
#define LAS __attribute__((address_space(3)))
typedef unsigned short bf16_t;
typedef short bf16x8 __attribute__((ext_vector_type(8)));
typedef float f32x4 __attribute__((ext_vector_type(4)));
typedef float f32x2 __attribute__((ext_vector_type(2)));
typedef unsigned u32x4 __attribute__((ext_vector_type(4)));
typedef unsigned u32x2 __attribute__((ext_vector_type(2)));
typedef _Float16 f16_t;

constexpr int NB = 8, SEQ = 4096, T = NB * SEQ, DM = 1024;
constexpr int NPROJ = 2888, NPROJP = 3072;
constexpr int NE = 256, NEX = 257;
constexpr int NWAVES = 8, NTHR = 512;
constexpr float EPS = 1e-6f;
constexpr int NPHASE = 15;

constexpr size_t MiB = 1u << 20;
constexpr size_t WS_CTL = 0, CTL_ZERO_BYTES = 65536;
constexpr int CW_CNT = 4096, CNT_STRIDE = 32;
constexpr size_t WS_MOD = 1 * MiB;
constexpr size_t WS_KMEAN = 1 * MiB + 256 * 1024;
constexpr size_t WS_COSH = 2 * MiB, WS_SINH = WS_COSH + 256 * 1024, WS_COSI = WS_SINH + 256 * 1024, WS_SINI = WS_COSI + 128 * 1024;
constexpr size_t WS_WIN = 4 * MiB;
constexpr size_t WS_WOUT = 10 * MiB;
constexpr size_t WS_WR = 12 * MiB;
constexpr size_t WS_WKV = 14 * MiB;
constexpr size_t WS_WD = 16 * MiB;
constexpr size_t WS_WGU = 145 * MiB;
constexpr size_t WS_H = 402 * MiB;
constexpr size_t WS_KS = 466 * MiB;
constexpr size_t WS_QM = 706 * MiB, WS_KM = 738 * MiB, WS_VM = 770 * MiB, WS_QD = 802 * MiB;
constexpr size_t WS_MASK = 834 * MiB;
constexpr size_t WS_CKVN = 834 * MiB, WS_KVRAW = 850 * MiB, WS_KD = 866 * MiB, WS_VD = 874 * MiB;
constexpr size_t WS_QI = 896 * MiB, WS_KI = 928 * MiB, WS_WI = 932 * MiB, WS_OM = 936 * MiB;
constexpr size_t WS_H2 = 402 * MiB;
constexpr size_t WS_SH = 530 * MiB;
constexpr size_t WS_RLOG = 530 * MiB;
constexpr size_t WS_EW = 835 * MiB, WS_LIST = 836 * MiB;
constexpr size_t WS_ACT = 658 * MiB;
constexpr size_t WS_CA = 145 * MiB;
constexpr size_t WS_INV = 834 * MiB;
constexpr size_t WS_X1 = 944 * MiB;
constexpr size_t WS_END = 1024 * MiB;
static_assert(WS_WD + (size_t)NEX * 1024 * 256 * 2 <= WS_WGU && WS_WGU + (size_t)NEX * 512 * 1024 * 2 <= WS_H, "weights map");
static_assert(WS_LIST + (size_t)NE * T * 4 <= WS_KD + 16 * MiB && WS_ACT + 360448ull * 512 <= WS_INV, "moe map");

constexpr int RING_BYTES = 131072;
constexpr int MISC_OFF = 157 * 1024;
constexpr int TAB_OFF = MISC_OFF + 256;
constexpr int TOK_OFF = RING_BYTES, MAX_UNITS = 20;
static_assert(TOK_OFF + MAX_UNITS * 1024 <= MISC_OFF, "lds map");
constexpr int LDS_BYTES = 160 * 1024;

__device__ __forceinline__ unsigned f2bf(float f) { unsigned u = __builtin_bit_cast(unsigned, f); return (u + 0x7fffu + ((u >> 16) & 1u)) >> 16; }
__device__ __forceinline__ float bf2f(unsigned h) { return __builtin_bit_cast(float, h << 16); }
__device__ __forceinline__ unsigned pk2(float lo, float hi) { unsigned r; asm("v_cvt_pk_bf16_f32 %0, %1, %2" : "=v"(r) : "v"(lo), "v"(hi)); return r; }
__device__ __forceinline__ float bflo(unsigned w) { return __builtin_bit_cast(float, w << 16); }
__device__ __forceinline__ float bfhi(unsigned w) { return __builtin_bit_cast(float, w & 0xffff0000u); }
__device__ __forceinline__ int lane_opaque() { int l; asm volatile("v_mbcnt_lo_u32_b32 %0, -1, 0\n\tv_mbcnt_hi_u32_b32 %0, -1, %0" : "=v"(l)); return l; }


template <int CTRL> __device__ __forceinline__ float dpp_mov_f(float v) { return __builtin_bit_cast(float, __builtin_amdgcn_update_dpp(__builtin_bit_cast(int, v), __builtin_bit_cast(int, v), CTRL, 0xF, 0xF, false)); }
__device__ __forceinline__ float row_max16(float v) {
    asm("s_nop 1\n\tv_max_f32_dpp %0, %0, %0 quad_perm:[1,0,3,2] row_mask:0xf bank_mask:0xf\n\t"
        "s_nop 1\n\tv_max_f32_dpp %0, %0, %0 quad_perm:[2,3,0,1] row_mask:0xf bank_mask:0xf\n\t"
        "s_nop 1\n\tv_max_f32_dpp %0, %0, %0 row_half_mirror row_mask:0xf bank_mask:0xf\n\t"
        "s_nop 1\n\tv_max_f32_dpp %0, %0, %0 row_mirror row_mask:0xf bank_mask:0xf" : "+v"(v));
    return v;
}
__device__ __forceinline__ float rdl_f(float v, int l) { return __builtin_bit_cast(float, __builtin_amdgcn_readlane(__builtin_bit_cast(int, v), l)); }
__device__ __forceinline__ float wave_sum_dpp(float v) {
    v += dpp_mov_f<0xB1>(v); v += dpp_mov_f<0x4E>(v); v += dpp_mov_f<0x141>(v); v += dpp_mov_f<0x140>(v);
    return (rdl_f(v, 0) + rdl_f(v, 16)) + (rdl_f(v, 32) + rdl_f(v, 48));
}
__device__ __forceinline__ float wave_max_dpp(float v) {
    v = row_max16(v);
    asm("s_nop 1\n\tv_max_f32_dpp %0, %0, %0 row_bcast:15 row_mask:0xa bank_mask:0xf\n\t"
        "s_nop 1\n\tv_max_f32_dpp %0, %0, %0 row_bcast:31 row_mask:0xc bank_mask:0xf" : "+v"(v));
    return rdl_f(v, 63);
}
__device__ __forceinline__ void half_max_dpp(float v, float& lo, float& hi) {
    v = row_max16(v);
    asm("s_nop 1\n\tv_max_f32_dpp %0, %0, %0 row_bcast:15 row_mask:0xa bank_mask:0xf" : "+v"(v));
    lo = rdl_f(v, 31); hi = rdl_f(v, 63);
}
#define VM_WAIT() asm volatile("s_waitcnt vmcnt(0)" ::: "memory")
#define LDS_WAIT() asm volatile("s_waitcnt lgkmcnt(0)" ::: "memory")

struct Args { const float* in[21]; float* out; unsigned char* ws; int ph_lo, ph_hi; };

#define XB_TMO      128
#define XB_XCNT(j)  (256  + 64 * (j))
#define XB_XSUB(j)  (1280 + 64 * (j))
#define XB_XGEN(j)  (2304 + 64 * (j))
#define XB_TOP      3328
#define XB_TOPGEN   3392
#define XCD_BAR_WORDS 3456
#define XB_SPIN_CAP (1u << 22)
__device__ __forceinline__ unsigned xb_ld(unsigned* p)              { return __hip_atomic_load(p, __ATOMIC_RELAXED, __HIP_MEMORY_SCOPE_AGENT); }
__device__ __forceinline__ unsigned xb_add(unsigned* p, unsigned v) { return __hip_atomic_fetch_add(p, v, __ATOMIC_RELAXED, __HIP_MEMORY_SCOPE_AGENT); }
__device__ __forceinline__ unsigned xb_xcc_id() { return (unsigned)__builtin_amdgcn_s_getreg((3 << 11) | 20) & 0xFu; }
#define XB_SPIN(cond, bar) do { unsigned _sp = 0; while (cond) { __builtin_amdgcn_s_sleep(1); \
    if ((++_sp & 255u) == 0u) { if (xb_ld(&(bar)[XB_TMO])) break; if (_sp > XB_SPIN_CAP) { atomicAdd(&(bar)[XB_TMO], 1u); break; } } } } while (0)
struct XcdBarrier { unsigned* bar; unsigned x; volatile LAS unsigned* st; };
__device__ __forceinline__ XcdBarrier xcd_barrier_post(unsigned* bar, volatile LAS unsigned* st, bool t0) {
    XcdBarrier b; b.bar = bar; b.x = xb_xcc_id(); b.st = st;
    if (t0) (void)xb_add(&bar[XB_XCNT(b.x)], 1u);
    return b;
}
__device__ __forceinline__ void xcd_barrier_complete(unsigned* bar, unsigned x, unsigned& nloc, unsigned& nx) {
    const unsigned G = gridDim.x * gridDim.y * gridDim.z;
    unsigned sum, cnt, mine, sp = 0u;
    for (;;) {
        sum = 0u; cnt = 0u; mine = 0u;
#pragma unroll
        for (unsigned j = 0; j < 16; ++j) { const unsigned c = xb_ld(&bar[XB_XCNT(j)]); sum += c; cnt += (c > 0u) ? 1u : 0u; mine = (j == x) ? c : mine; }
        if (sum == G) break;
        __builtin_amdgcn_s_sleep(1);
        if ((++sp & 255u) == 0u) { if (xb_ld(&bar[XB_TMO])) break; if (sp > XB_SPIN_CAP) { atomicAdd(&bar[XB_TMO], 1u); break; } }
    }
    nloc = mine > 0u ? mine : 1u; nx = cnt > 0u ? cnt : 1u;
}
__device__ __forceinline__ void xcd_barrier(const XcdBarrier& b, int wave) {
    asm volatile("s_waitcnt vmcnt(0)" ::: "memory");
    __syncthreads();
    if (wave == 0 && lane_opaque() == 0) {
        unsigned* bar = b.bar;
        __builtin_amdgcn_s_waitcnt(0);
        unsigned nloc = b.st[0], nx = b.st[1];
        if (nloc == 0u) { xcd_barrier_complete(bar, b.x, nloc, nx); b.st[0] = nloc; b.st[1] = nx; }
        const unsigned old = xb_add(&bar[XB_XSUB(b.x)], 1u);
        const unsigned gen = old / nloc;
        if (old + 1u == (gen + 1u) * nloc) {
            __builtin_amdgcn_fence(__ATOMIC_RELEASE, "agent");
            asm volatile("s_waitcnt vmcnt(0)" ::: "memory");
            const unsigned og = xb_add(&bar[XB_TOP], 1u);
            const unsigned tg = og / nx;
            if (og + 1u == (tg + 1u) * nx) xb_add(&bar[XB_TOPGEN], 1u);
            else XB_SPIN(xb_ld(&bar[XB_TOPGEN]) == tg, bar);
            __builtin_amdgcn_fence(__ATOMIC_ACQUIRE, "agent");
            xb_add(&bar[XB_XGEN(b.x)], 1u);
            asm volatile("s_waitcnt vmcnt(0)" ::: "memory");
        } else {
            XB_SPIN(xb_ld(&bar[XB_XGEN(b.x)]) == gen, bar);
            __builtin_amdgcn_fence(__ATOMIC_ACQUIRE, "agent");
            asm volatile("s_waitcnt vmcnt(0)" ::: "memory");
        }
    }
    __syncthreads();
}

namespace pg8 {
constexpr int BM = 256, BK = 64, HALF = 128, HTB = HALF * BK * 2, NXCD = 8, WGM = 8;
__host__ __device__ __forceinline__ int lds_byte(int r, int c) { const int st = (r >> 4) * 2 + (c >> 5), rr = r & 15, cc = c & 31, ob = rr * 64 + cc * 2; return st * 1024 + (ob ^ (((ob >> 9) & 1) << 5)); }
__host__ __device__ __forceinline__ void stage_rc(int b, int& R, int& C) { const int st = b / 1024, sb = b % 1024, swz = sb ^ (((sb >> 9) & 1) << 5); R = (st >> 1) * 16 + swz / 64; C = (st & 1) * 32 + (swz % 64) / 2; }
__host__ __device__ __forceinline__ int perm32(int rho) { const int n = rho >> 4, i = rho & 15; return 8 * (i >> 2) + 4 * n + (i & 3); }

struct Unit { int pm, pn, e, rt, slot; };

struct DenseSched {
    const char* A; const char* B; unsigned lda, ldb; int nM, nN, nwg, G, c;
    __device__ __forceinline__ void init(const void* A_, unsigned lda_, const void* B_, unsigned ldb_, int M, int N, int G_, int c_) { A = (const char*)A_; B = (const char*)B_; lda = lda_; ldb = ldb_; nM = M / BM; nN = N / BM; nwg = nM * nN; G = G_; c = c_; }
    __device__ __forceinline__ bool next(int i, Unit& u) const {
        const long L = (long)i * G + c; if (L >= nwg) return false;
        int wgid = (int)L; { const int q = nwg / NXCD, r = nwg % NXCD, xcd = wgid % NXCD, off = wgid / NXCD; wgid = (xcd < r ? xcd * (q + 1) : r * (q + 1) + (xcd - r) * q) + off; }
        const int nig = WGM * nN, gid = wgid / nig, fm = gid * WGM, gsz = (nM - fm) < WGM ? (nM - fm) : WGM;
        u.pm = fm + ((wgid % nig) % gsz); u.pn = (wgid % nig) / gsz; u.e = 0; u.rt = u.pm; u.slot = i; return true;
    }
    __device__ __forceinline__ const char* a_ubase(const Unit& u) const { return A + (size_t)u.pm * BM * lda; }
    __device__ __forceinline__ void a_off(const Unit& u, const int (&R)[2], const int (&C)[2], unsigned (&o)[2][2]) const {
#pragma unroll
        for (int h = 0; h < 2; ++h)
#pragma unroll
            for (int i = 0; i < 2; ++i) o[h][i] = (unsigned)(h * HALF + R[i]) * lda + (unsigned)C[i] * 2u;
    }
    __device__ __forceinline__ const char* b_base(const Unit& u) const { return B + (size_t)u.pn * BM * ldb; }
};

template <class Epi, class Sched, bool ALIGN_EPI, bool MIDHOOK = false>
__device__ __forceinline__ void gemm_phase(LAS unsigned char* lds, const Sched& S, const Epi& E, const int K, const int wid) {
    const int lane = lane_opaque(), tid = wid * 64 + lane, wr = wid >> 2, wc = wid & 3, fr = lane & 15, fq = lane >> 4;
    const int nt = K / BK;
    int Rr[2], Cc[2]; unsigned voffB[2];
#pragma unroll
    for (int i = 0; i < 2; ++i) { int R, C; stage_rc(tid * 16 + i * 8192, R, C); Rr[i] = R; Cc[i] = C; const int Rb = Epi::PERM ? ((R & ~31) + perm32(R & 31)) : R;
        voffB[i] = (unsigned)Rb * S.ldb + (unsigned)C * 2u; }
    const size_t kstep = (size_t)(BK * 2);
    const size_t hstepB = (size_t)HALF * S.ldb;
    const unsigned ldsw = (unsigned)wid * 1024u;
    const int aoff = lds_byte(wr * 64 + fr, fq * 8), boff = lds_byte(wc * 32 + fr, fq * 8);
#define PG8_SA(b, h) (((b) * 2 + (h)) * HTB)
#define PG8_SB(b, h) ((4 + (b) * 2 + (h)) * HTB)
#define PG8_STAGE(bufoff, gbase, voff) do { _Pragma("unroll") for (int _i = 0; _i < 2; ++_i) \
        __builtin_amdgcn_global_load_lds((const unsigned*)((const char*)(gbase) + (voff)[_i]), (LAS unsigned*)(lds + (bufoff) + ldsw + _i * 8192), 16, 0, 0); } while (0)
#define PG8_LDA(dst, b, h) do { _Pragma("unroll") for (int m = 0; m < 4; ++m) _Pragma("unroll") for (int k = 0; k < 2; ++k) dst[m][k] = *(const LAS bf16x8*)(lds + PG8_SA(b, h) + aoff + m * 2048 + k * 1024); } while (0)
#define PG8_LDB(dst, b, h) do { _Pragma("unroll") for (int n = 0; n < 2; ++n) _Pragma("unroll") for (int k = 0; k < 2; ++k) dst[n][k] = *(const LAS bf16x8*)(lds + PG8_SB(b, h) + boff + n * 2048 + k * 1024); } while (0)
#define PG8_MMA(ai, bj, At, Bt) do { __builtin_amdgcn_s_setprio(1); _Pragma("unroll") for (int m = 0; m < 4; ++m) _Pragma("unroll") for (int n = 0; n < 2; ++n) _Pragma("unroll") for (int k = 0; k < 2; ++k) \
        acc[ai][bj][m][n] = __builtin_amdgcn_mfma_f32_16x16x32_bf16(Bt[n][k], At[m][k], acc[ai][bj][m][n], 0, 0, 0); __builtin_amdgcn_s_setprio(0); } while (0)
#define PG8_WAIT_V(n) asm volatile("s_waitcnt vmcnt(" #n ")" ::: "memory")
#define PG8_WAIT_L(n) asm volatile("s_waitcnt lgkmcnt(" #n ")" ::: "memory")
#define PG8_BAR __builtin_amdgcn_s_barrier()
#define PG8_SCHED __builtin_amdgcn_sched_barrier(0)
    Unit cur, nxt; int ui = 0;
    if (!S.next(0, cur)) return;
    if constexpr (MIDHOOK) E.begin(cur, wid);
    f32x4 acc[2][2][4][2];
#pragma unroll
    for (int a = 0; a < 2; ++a)
#pragma unroll
        for (int b = 0; b < 2; ++b)
#pragma unroll
            for (int m = 0; m < 4; ++m)
#pragma unroll
                for (int n = 0; n < 2; ++n) acc[a][b][m][n] = (f32x4){0.f, 0.f, 0.f, 0.f};
    bf16x8 At[4][2], B0[2][2], B1[2][2];
    unsigned oc[2][2];
    S.a_off(cur, Rr, Cc, oc);
    const char* cA = S.a_ubase(cur);
    const char* cB = S.b_base(cur);
    PG8_STAGE(PG8_SB(0, 0), cB, voffB); PG8_STAGE(PG8_SB(0, 1), cB + hstepB, voffB); PG8_STAGE(PG8_SA(0, 0), cA, oc[0]); PG8_STAGE(PG8_SA(0, 1), cA, oc[1]);
    if (wr == 1) PG8_BAR;
    PG8_WAIT_V(2); PG8_BAR;
    PG8_STAGE(PG8_SB(1, 0), cB + kstep, voffB); PG8_STAGE(PG8_SA(1, 0), cA + kstep, oc[0]); PG8_STAGE(PG8_SB(1, 1), cB + hstepB + kstep, voffB);
    PG8_WAIT_V(6); PG8_BAR;
    for (;;) {
        const bool has_next = S.next(ui + 1, nxt);
        if constexpr (MIDHOOK) { if (has_next) E.begin(nxt, wid); }
        const char* nB = has_next ? S.b_base(nxt) : cB; const char* nA = has_next ? S.a_ubase(nxt) : cA;
#pragma nounroll
        for (int t = 0; t < nt; t += 2) {
            const bool last = (t == nt - 2);
            if constexpr (MIDHOOK) { if (t == nt / 2) E.mid(acc, cur, wr, fr); }
            const char* a1 = cA + (size_t)(t + 1) * kstep;
            const char* a2 = last ? nA : cA + (size_t)(t + 2) * kstep; const char* b2 = last ? nB : cB + (size_t)(t + 2) * kstep;
            const char* a3 = a2 + kstep; const char* b3 = b2 + kstep;
            PG8_LDB(B0, 0, 0); PG8_LDB(B1, 0, 1); PG8_SCHED; PG8_LDA(At, 0, 0); PG8_STAGE(PG8_SA(1, 1), a1, oc[1]);
            if (last && has_next) S.a_off(nxt, Rr, Cc, oc);
            PG8_WAIT_V(8); PG8_WAIT_L(0); PG8_BAR; PG8_MMA(0, 0, At, B0); PG8_MMA(0, 1, At, B1); PG8_BAR; PG8_SCHED;
            PG8_LDA(At, 0, 1); PG8_STAGE(PG8_SB(0, 0), b2, voffB); PG8_STAGE(PG8_SB(0, 1), b2 + hstepB, voffB); PG8_STAGE(PG8_SA(0, 0), a2, oc[0]);
            PG8_WAIT_V(8); PG8_WAIT_L(0); PG8_BAR; PG8_MMA(1, 0, At, B0); PG8_MMA(1, 1, At, B1); PG8_BAR; PG8_SCHED;
            PG8_LDB(B0, 1, 0); PG8_LDB(B1, 1, 1); PG8_SCHED; PG8_LDA(At, 1, 0); PG8_STAGE(PG8_SA(0, 1), a2, oc[1]);
            PG8_WAIT_V(8); PG8_WAIT_L(0); PG8_BAR; PG8_MMA(0, 0, At, B0); PG8_MMA(0, 1, At, B1); PG8_BAR; PG8_SCHED;
            PG8_LDA(At, 1, 1); PG8_STAGE(PG8_SB(1, 0), b3, voffB); PG8_STAGE(PG8_SB(1, 1), b3 + hstepB, voffB); PG8_STAGE(PG8_SA(1, 0), a3, oc[0]);
            PG8_WAIT_V(8); PG8_WAIT_L(0); PG8_BAR; PG8_MMA(1, 0, At, B0); PG8_MMA(1, 1, At, B1); PG8_BAR; PG8_SCHED;
        }
        if constexpr (ALIGN_EPI) { if (wr == 0) PG8_BAR; }
        E(acc, cur, wr, wc, fr, fq);
        if (!has_next) break;
#pragma unroll
        for (int a = 0; a < 2; ++a)
#pragma unroll
            for (int b = 0; b < 2; ++b)
#pragma unroll
                for (int m = 0; m < 4; ++m)
#pragma unroll
                    for (int n = 0; n < 2; ++n) acc[a][b][m][n] = (f32x4){0.f, 0.f, 0.f, 0.f};
        cur = nxt; cB = nB; cA = nA; ++ui;
        if constexpr (ALIGN_EPI) { if (wr == 1) PG8_BAR; }
    }
    PG8_WAIT_V(0);
    if constexpr (!ALIGN_EPI) { if (wr == 0) PG8_BAR; }
    PG8_BAR;
#undef PG8_SA
#undef PG8_SB
#undef PG8_STAGE
#undef PG8_LDA
#undef PG8_LDB
#undef PG8_MMA
#undef PG8_WAIT_V
#undef PG8_WAIT_L
#undef PG8_BAR
#undef PG8_SCHED
}

struct EpiProjFused {
    static constexpr bool PERM = true;
    bf16_t* QM; bf16_t* KM; bf16_t* VM; bf16_t* QD; bf16_t* CKV; float* SSQ; f16_t* QI; f16_t* KI; float* WI;
    const float* cosH; const float* sinH; const float* cosI; const float* sinI;
    __device__ __forceinline__ void operator()(const f32x4 (&acc)[2][2][4][2], const Unit& u, int wr, int wc, int fr, int fq) const {
        typedef _Float16 f16x8v __attribute__((ext_vector_type(8)));
        const int pn = u.pn, rowb = u.pm * BM + wr * 64 + fr;
        if (pn < 8) {
            const int sec = pn >> 1; bf16_t* dstb = sec == 0 ? QM : sec == 1 ? KM : sec == 2 ? VM : QD;
            const bool rope = (sec != 2) && (wc == 0);
            const int i0 = 8 * (fq & 1);
#define EPF_LD(it_, A0, A1, A2, A3) do { const int s_ = (rowb + ((it_) >> 2) * HALF + ((it_) & 3) * 16) & 4095; \
                A0 = *(const f32x4*)(cosH + s_ * 16 + i0); A1 = *(const f32x4*)(cosH + s_ * 16 + i0 + 4); A2 = *(const f32x4*)(sinH + s_ * 16 + i0); A3 = *(const f32x4*)(sinH + s_ * 16 + i0 + 4); } while (0)
            if (rope) {
                f32x4 nb[3][4]; EPF_LD(0, nb[0][0], nb[0][1], nb[0][2], nb[0][3]); EPF_LD(1, nb[1][0], nb[1][1], nb[1][2], nb[1][3]);
#pragma unroll
                for (int it = 0; it < 8; ++it) { const int ai = it >> 2, m = it & 3; const int row = rowb + ai * HALF + m * 16, b = row >> 12, s = row & 4095;
                    if (it + 2 < 8) { EPF_LD(it + 2, nb[(it + 2) % 3][0], nb[(it + 2) % 3][1], nb[(it + 2) % 3][2], nb[(it + 2) % 3][3]); __builtin_amdgcn_sched_barrier(0); }
                    const f32x4 c0 = nb[it % 3][0], c1 = nb[it % 3][1], s0 = nb[it % 3][2], s1 = nb[it % 3][3];
#pragma unroll
                    for (int bj = 0; bj < 2; ++bj) { f32x4 v0 = acc[ai][bj][m][0], v1 = acc[ai][bj][m][1]; f32x4 y0, y1;
#pragma unroll
                        for (int j = 0; j < 4; ++j) { y0[j] = __shfl_xor(v0[j], 32); y1[j] = __shfl_xor(v1[j], 32); }
                        const float sg = fq < 2 ? -1.f : 1.f;
                        v0 = v0 * c0 + sg * (y0 * s0); v1 = v1 * c1 + sg * (y1 * s1);
                        u32x4 w; w.x = pk2(v0[0], v0[1]); w.y = pk2(v0[2], v0[3]); w.z = pk2(v1[0], v1[1]); w.w = pk2(v1[2], v1[3]);
                        const int h = 2 * (pn & 1) + bj;
                        *(u32x4*)(dstb + ((size_t)(b * 4 + h) * SEQ + s) * 128 + wc * 32 + 8 * fq) = w; } }
            } else {
#pragma unroll
                for (int it = 0; it < 8; ++it) { const int ai = it >> 2, m = it & 3; const int row = rowb + ai * HALF + m * 16, b = row >> 12, s = row & 4095;
#pragma unroll
                    for (int bj = 0; bj < 2; ++bj) { const f32x4 v0 = acc[ai][bj][m][0], v1 = acc[ai][bj][m][1];
                        u32x4 w; w.x = pk2(v0[0], v0[1]); w.y = pk2(v0[2], v0[3]); w.z = pk2(v1[0], v1[1]); w.w = pk2(v1[2], v1[3]);
                        const int h = 2 * (pn & 1) + bj;
                        *(u32x4*)(dstb + ((size_t)(b * 4 + h) * SEQ + s) * 128 + wc * 32 + 8 * fq) = w; } }
            }
#undef EPF_LD
        } else if (pn == 8) {
#pragma unroll
            for (int ai = 0; ai < 2; ++ai)
#pragma unroll
                for (int m = 0; m < 4; ++m) { const int row = rowb + ai * HALF + m * 16; float ss = 0.f;
#pragma unroll
                    for (int bj = 0; bj < 2; ++bj) { const f32x4 v0 = acc[ai][bj][m][0], v1 = acc[ai][bj][m][1];
                        ss += (v0[0] * v0[0] + v0[1] * v0[1]) + (v0[2] * v0[2] + v0[3] * v0[3]) + (v1[0] * v1[0] + v1[1] * v1[1]) + (v1[2] * v1[2] + v1[3] * v1[3]);
                        u32x4 w; w.x = pk2(v0[0], v0[1]); w.y = pk2(v0[2], v0[3]); w.z = pk2(v1[0], v1[1]); w.w = pk2(v1[2], v1[3]);
                        *(u32x4*)(CKV + (size_t)row * 256 + bj * HALF + wc * 32 + 8 * fq) = w; }
                    ss += __shfl_xor(ss, 16); ss += __shfl_xor(ss, 32);
                    if (fq == 0) SSQ[(size_t)row * 4 + wc] = ss; }
        } else if (pn < 11) {
            const bool rope = (wc & 1) == 0;
#define EQI_LD(it_, A0, A1, A2, A3) do { const int s_ = (rowb + ((it_) >> 2) * HALF + ((it_) & 3) * 16) & 4095; \
                A0 = *(const f32x4*)(cosI + s_ * 8); A1 = *(const f32x4*)(cosI + s_ * 8 + 4); A2 = *(const f32x4*)(sinI + s_ * 8); A3 = *(const f32x4*)(sinI + s_ * 8 + 4); } while (0)
#define EQI_ST(v0_, v1_) do { f16x8v o; o[0] = (f16_t)v0_[0]; o[1] = (f16_t)v0_[1]; o[2] = (f16_t)v0_[2]; o[3] = (f16_t)v0_[3]; o[4] = (f16_t)v1_[0]; o[5] = (f16_t)v1_[1]; o[6] = (f16_t)v1_[2]; o[7] = (f16_t)v1_[3]; \
                *(f16x8v*)(QI + (size_t)row * 512 + (pn - 9) * 256 + bj * HALF + wc * 32 + 8 * fq) = o; } while (0)
            if (rope) {
                f32x4 nb[3][4]; EQI_LD(0, nb[0][0], nb[0][1], nb[0][2], nb[0][3]); EQI_LD(1, nb[1][0], nb[1][1], nb[1][2], nb[1][3]);
#pragma unroll
                for (int it = 0; it < 8; ++it) { const int ai = it >> 2, m = it & 3; const int row = rowb + ai * HALF + m * 16;
                    if (it + 2 < 8) { EQI_LD(it + 2, nb[(it + 2) % 3][0], nb[(it + 2) % 3][1], nb[(it + 2) % 3][2], nb[(it + 2) % 3][3]); __builtin_amdgcn_sched_barrier(0); }
                    const f32x4 c0 = nb[it % 3][0], c1 = nb[it % 3][1], s0 = nb[it % 3][2], s1 = nb[it % 3][3];
#pragma unroll
                    for (int bj = 0; bj < 2; ++bj) { f32x4 v0 = acc[ai][bj][m][0], v1 = acc[ai][bj][m][1]; f32x4 y0, y1;
#pragma unroll
                        for (int j = 0; j < 4; ++j) { y0[j] = __shfl_xor(v0[j], 16); y1[j] = __shfl_xor(v1[j], 16); }
                        if (fq < 2) { const float sg = fq == 0 ? -1.f : 1.f; v0 = v0 * c0 + sg * (y0 * s0); v1 = v1 * c1 + sg * (y1 * s1); }
                        EQI_ST(v0, v1); } }
            } else {
#pragma unroll
                for (int it = 0; it < 8; ++it) { const int ai = it >> 2, m = it & 3; const int row = rowb + ai * HALF + m * 16;
#pragma unroll
                    for (int bj = 0; bj < 2; ++bj) { const f32x4 v0 = acc[ai][bj][m][0], v1 = acc[ai][bj][m][1]; EQI_ST(v0, v1); } }
            }
#undef EQI_LD
#undef EQI_ST
        } else {
            if (wc < 2) {
#pragma unroll
                for (int ai = 0; ai < 2; ++ai)
#pragma unroll
                    for (int m = 0; m < 4; ++m) { const int row = rowb + ai * HALF + m * 16, s = row & 4095;
                        f32x4 v0 = acc[ai][0][m][0], v1 = acc[ai][0][m][1];
                        if (wc == 0) { f32x4 y0, y1;
#pragma unroll
                            for (int j = 0; j < 4; ++j) { y0[j] = __shfl_xor(v0[j], 16); y1[j] = __shfl_xor(v1[j], 16); }
                            if (fq < 2) { const f32x4 c0 = *(const f32x4*)(cosI + s * 8), c1 = *(const f32x4*)(cosI + s * 8 + 4), s0 = *(const f32x4*)(sinI + s * 8), s1 = *(const f32x4*)(sinI + s * 8 + 4);
                                const float sg = fq == 0 ? -1.f : 1.f; v0 = v0 * c0 + sg * (y0 * s0); v1 = v1 * c1 + sg * (y1 * s1); } }
                        f16x8v o; o[0] = (f16_t)v0[0]; o[1] = (f16_t)v0[1]; o[2] = (f16_t)v0[2]; o[3] = (f16_t)v0[3]; o[4] = (f16_t)v1[0]; o[5] = (f16_t)v1[1]; o[6] = (f16_t)v1[2]; o[7] = (f16_t)v1[3];
                        *(f16x8v*)(KI + (size_t)(row >> 5) * 2048 + (wc * 4 + fq) * 256 + (row & 31) * 8) = o; }
            } else if (wc == 2 && fq == 0) {
#pragma unroll
                for (int ai = 0; ai < 2; ++ai)
#pragma unroll
                    for (int m = 0; m < 4; ++m) { const int row = rowb + ai * HALF + m * 16; const float k = 0.35355339059327373f;
                        *(f32x4*)(WI + (size_t)row * 8) = acc[ai][0][m][0] * k; *(f32x4*)(WI + (size_t)row * 8 + 4) = acc[ai][0][m][1] * k; }
            }
        }
    }
};
struct EpiKV {
    static constexpr bool PERM = true;
    bf16_t* KD; bf16_t* VD; const float* SSQ; const float* cosH; const float* sinH;
    __device__ __forceinline__ void operator()(const f32x4 (&acc)[2][2][4][2], const Unit& u, int wr, int wc, int fr, int fq) const {
        const int rowb = u.pm * BM + wr * 64 + fr;
        float rs[8];
        { f32x4 q[8];
#pragma unroll
          for (int it = 0; it < 8; ++it) q[it] = *(const f32x4*)(SSQ + (size_t)(rowb + (it >> 2) * HALF + (it & 3) * 16) * 4);
#pragma unroll
          for (int it = 0; it < 8; ++it) rs[it] = 1.f / sqrtf(((q[it][0] + q[it][1]) + (q[it][2] + q[it][3])) * (1.f / 256.f) + EPS); }
        const int i0 = 8 * (fq & 1);
#define EKV_LD(it_, A0, A1, A2, A3) do { const int s_ = (rowb + ((it_) >> 2) * HALF + ((it_) & 3) * 16) & 4095; \
            A0 = *(const f32x4*)(cosH + s_ * 16 + i0); A1 = *(const f32x4*)(cosH + s_ * 16 + i0 + 4); A2 = *(const f32x4*)(sinH + s_ * 16 + i0); A3 = *(const f32x4*)(sinH + s_ * 16 + i0 + 4); } while (0)
#define EKV_ST(v0_, v1_) do { u32x4 w; w.x = pk2(v0_[0], v0_[1]); w.y = pk2(v0_[2], v0_[3]); w.z = pk2(v1_[0], v1_[1]); w.w = pk2(v1_[2], v1_[3]); \
            *(u32x4*)(KD + (size_t)row * 128 + wc * 32 + 8 * fq) = w; \
            const f32x4 u0 = acc[ai][1][m][0] * rstd, u1 = acc[ai][1][m][1] * rstd; \
            u32x4 x; x.x = pk2(u0[0], u0[1]); x.y = pk2(u0[2], u0[3]); x.z = pk2(u1[0], u1[1]); x.w = pk2(u1[2], u1[3]); \
            *(u32x4*)(VD + (size_t)row * 128 + wc * 32 + 8 * fq) = x; } while (0)
        if (wc == 0) {
            f32x4 n0, n1, n2, n3; EKV_LD(0, n0, n1, n2, n3);
#pragma unroll
            for (int it = 0; it < 8; ++it) { const int ai = it >> 2, m = it & 3; const int row = rowb + ai * HALF + m * 16; const float rstd = rs[it];
                const f32x4 c0 = n0, c1 = n1, s0 = n2, s1 = n3;
                if (it < 7) { EKV_LD(it + 1, n0, n1, n2, n3); __builtin_amdgcn_sched_barrier(0); }
                f32x4 v0 = acc[ai][0][m][0] * rstd, v1 = acc[ai][0][m][1] * rstd; f32x4 y0, y1;
#pragma unroll
                for (int j = 0; j < 4; ++j) { y0[j] = __shfl_xor(v0[j], 32); y1[j] = __shfl_xor(v1[j], 32); }
                const float sg = fq < 2 ? -1.f : 1.f; v0 = v0 * c0 + sg * (y0 * s0); v1 = v1 * c1 + sg * (y1 * s1);
                EKV_ST(v0, v1); }
        } else {
#pragma unroll
            for (int it = 0; it < 8; ++it) { const int ai = it >> 2, m = it & 3; const int row = rowb + ai * HALF + m * 16; const float rstd = rs[it];
                const f32x4 v0 = acc[ai][0][m][0] * rstd, v1 = acc[ai][0][m][1] * rstd;
                EKV_ST(v0, v1); }
        }
#undef EKV_LD
#undef EKV_ST
    }
};
struct EpiF32 {
    static constexpr bool PERM = true;
    float* O; int ldc;
    __device__ __forceinline__ void operator()(const f32x4 (&acc)[2][2][4][2], const Unit& u, int wr, int wc, int fr, int fq) const {
        const int row0 = u.pm * BM + wr * 64 + fr, col0 = u.pn * BM + wc * 32 + 8 * fq;
#pragma unroll
        for (int ai = 0; ai < 2; ++ai)
#pragma unroll
            for (int m = 0; m < 4; ++m) { float* rowp = O + (size_t)(row0 + ai * HALF + m * 16) * ldc + col0;
#pragma unroll
                for (int bj = 0; bj < 2; ++bj) { *(f32x4*)(rowp + bj * HALF) = acc[ai][bj][m][0]; *(f32x4*)(rowp + bj * HALF + 4) = acc[ai][bj][m][1]; } }
    }
};

struct EpiResidNorm {
    static constexpr bool PERM = true;
    const float* X; bf16_t* O; const float* mod; const float* SSQO; LAS float* tab;
    __device__ __forceinline__ void begin(const Unit& u, int wid) const {
        const int tid = wid * 64 + lane_opaque();
        if (tid < BM) { const float* p = SSQO + (size_t)(u.pm * BM + tid) * 8; const f32x4 a = *(const f32x4*)p, b = *(const f32x4*)(p + 4);
            const float rm = 1.f / sqrtf(((a[0] + a[1]) + (a[2] + a[3])) * (1.f / 512.f) + EPS), rd = 1.f / sqrtf(((b[0] + b[1]) + (b[2] + b[3])) * (1.f / 512.f) + EPS);
            *(LAS f32x2*)(tab + (u.slot % 3) * 512 + tid * 2) = (f32x2){rm / rd, rd}; }
    }
    __device__ __forceinline__ void mid(f32x4 (&acc)[2][2][4][2], const Unit& u, int wr, int fr) const {
        const LAS float* t = tab + (u.slot % 3) * 512 + (wr * 64 + fr) * 2;
#pragma unroll
        for (int ai = 0; ai < 2; ++ai)
#pragma unroll
            for (int m = 0; m < 4; ++m) { const float q = t[(ai * HALF + m * 16) * 2];
#pragma unroll
                for (int bj = 0; bj < 2; ++bj) { acc[ai][bj][m][0] = acc[ai][bj][m][0] * q; acc[ai][bj][m][1] = acc[ai][bj][m][1] * q; } }
    }
    __device__ __forceinline__ void operator()(const f32x4 (&acc)[2][2][4][2], const Unit& u, int wr, int wc, int fr, int fq) const {
        const int row0 = u.pm * BM + wr * 64 + fr, col0 = u.pn * BM + wc * 32 + 8 * fq;
        const float* g = mod + (size_t)((u.pm * BM) >> 12) * 6144 + 2048 + col0;
        const LAS float* t = tab + (u.slot % 3) * 512 + (wr * 64 + fr) * 2 + 1;
        f32x4 gg[2][2];
#pragma unroll
        for (int bj = 0; bj < 2; ++bj) { gg[bj][0] = *(const f32x4*)(g + bj * HALF); gg[bj][1] = *(const f32x4*)(g + bj * HALF + 4); }
#define ERN_LD(it_, B) do { const size_t o_ = (size_t)(row0 + ((it_) >> 2) * HALF + ((it_) & 3) * 16) * DM + col0; \
            B[0][0] = *(const f32x4*)(X + o_); B[0][1] = *(const f32x4*)(X + o_ + 4); B[1][0] = *(const f32x4*)(X + o_ + HALF); B[1][1] = *(const f32x4*)(X + o_ + HALF + 4); } while (0)
        f32x4 xx[3][2][2];
        ERN_LD(0, xx[0]); ERN_LD(1, xx[1]);
#pragma unroll
        for (int it = 0; it < 8; ++it) { const int ai = it >> 2, m = it & 3; const float rd = t[(ai * HALF + m * 16) * 2];
            if (it + 2 < 8) { ERN_LD(it + 2, xx[(it + 2) % 3]); __builtin_amdgcn_sched_barrier(0); }
#pragma unroll
            for (int bj = 0; bj < 2; ++bj) { const size_t o = (size_t)(row0 + ai * HALF + m * 16) * DM + col0 + bj * HALF;
                const f32x4 r0 = xx[it % 3][bj][0] + gg[bj][0] * rd * acc[ai][bj][m][0], r1 = xx[it % 3][bj][1] + gg[bj][1] * rd * acc[ai][bj][m][1];
                u32x4 w; w.x = pk2(r0[0], r0[1]); w.y = pk2(r0[2], r0[3]); w.z = pk2(r1[0], r1[1]); w.w = pk2(r1[2], r1[3]);
                *(u32x4*)(O + o) = w; } }
#undef ERN_LD
    }
};
struct MoeTab { const LAS int* cnt; const LAS int* tstart; };
constexpr int UT_MAX = 32;
__device__ __forceinline__ int moe_find(const MoeTab& tb, int rt) {
    int lo = 0, hi = NEX;
    while (hi - lo > 1) { const int mid = (lo + hi) >> 1; if (tb.tstart[mid] <= rt) lo = mid; else hi = mid; }
    return lo;
}
struct MoeUpSched {
    MoeTab tb; const char* H2; const LAS int* tokl; const char* WGU; unsigned ldb; int total, G, c; const LAS int* utab;
    __device__ __forceinline__ bool next(int i, Unit& u) const {
        if (i < UT_MAX) { const u32x4 v = *(const LAS u32x4*)(utab + 4 * i); if ((int)v.x < 0) return false; u.e = (int)v.x; u.rt = (int)v.y; u.pn = (int)v.z & 0xff; u.pm = (int)v.w; u.slot = i | (((int)v.z >> 8) << 16); return true; }
        return compute(i, u);
    }
    __device__ __forceinline__ bool compute(int i, Unit& u) const {
        if (G == 256) { const int xcd = c & 7, k = c >> 3; u.rt = i * 128 + xcd * 16 + (k >> 1); u.pn = k & 1; if (u.rt * 2 >= total) return false; }
        else { const int L = i * G + c; if (L >= total) return false; u.rt = L >> 1; u.pn = L & 1; }
        u.e = moe_find(tb, u.rt); u.pm = u.rt - tb.tstart[u.e]; u.slot = i | (256 << 16); return true;
    }
    __device__ __forceinline__ const char* a_ubase(const Unit&) const { return H2; }
    __device__ __forceinline__ void a_off(const Unit& u, const int (&R)[2], const int (&C)[2], unsigned (&o)[2][2]) const {
#pragma unroll
        for (int h = 0; h < 2; ++h)
#pragma unroll
            for (int i = 0; i < 2; ++i) o[h][i] = (unsigned)(tokl[(u.slot & 0xffff) * BM + h * HALF + R[i]] & 0x7fff) * 4096u + (unsigned)C[i] * 2u;
    }
    __device__ __forceinline__ const char* b_base(const Unit& u) const { return WGU + ((size_t)u.e * 512 + (size_t)u.pn * 256) * 2048; }
};
struct EpiAct {
    static constexpr bool PERM = true;
    bf16_t* ACT; const LAS int* tokl;
    __device__ __forceinline__ void operator()(const f32x4 (&acc)[2][2][4][2], const Unit& u, int wr, int wc, int fr, int fq) const {
        const int row0 = u.rt * BM + wr * 64 + fr, col0 = u.pn * 128 + wc * 32 + 8 * fq;
#pragma unroll
        for (int ai = 0; ai < 2; ++ai)
#pragma unroll
            for (int m = 0; m < 4; ++m) { float a[8];
                const unsigned tw = (unsigned)tokl[(u.slot & 0xffff) * BM + ai * HALF + wr * 64 + m * 16 + fr];
                const float gw = (float)__builtin_bit_cast(f16_t, (unsigned short)(tw >> 16));
#pragma unroll
                for (int n = 0; n < 2; ++n)
#pragma unroll
                    for (int j = 0; j < 4; ++j) { const float gt = acc[ai][0][m][n][j], up = acc[ai][1][m][n][j]; a[n * 4 + j] = gt * __builtin_amdgcn_rcpf(1.f + __expf(-gt)) * up * gw; }
                u32x4 w; w.x = pk2(a[0], a[1]); w.y = pk2(a[2], a[3]); w.z = pk2(a[4], a[5]); w.w = pk2(a[6], a[7]);
                if (ai * HALF + wr * 64 + m * 16 + fr < (u.slot >> 16)) *(u32x4*)(ACT + (size_t)(row0 + ai * HALF + m * 16) * 256 + col0) = w; }
    }
};
struct MoeDownSched {
    MoeTab tb; const char* ACT; const char* WD; unsigned ldb; int total, G, c; const LAS int* utab;
    __device__ __forceinline__ bool next(int i, Unit& u) const {
        if (i < UT_MAX) { const u32x4 v = *(const LAS u32x4*)(utab + 4 * i); if ((int)v.x < 0) return false; u.e = (int)v.x; u.rt = (int)v.y; u.pn = (int)v.z & 0xff; u.pm = (int)v.w; u.slot = i | (((int)v.z >> 8) << 16); return true; }
        return compute(i, u);
    }
    __device__ __forceinline__ bool compute(int i, Unit& u) const {
        if (G == 256) { const int xcd = c & 7, k = c >> 3; u.rt = i * 64 + xcd * 8 + (k >> 2); u.pn = k & 3; if (u.rt * 4 >= total) return false; }
        else { const int L = i * G + c; if (L >= total) return false; u.rt = L >> 2; u.pn = L & 3; }
        u.e = moe_find(tb, u.rt); u.pm = u.rt - tb.tstart[u.e]; u.slot = i | (256 << 16); return true;
    }
    __device__ __forceinline__ const char* a_ubase(const Unit& u) const { return ACT + (size_t)u.rt * BM * 512; }
    __device__ __forceinline__ void a_off(const Unit& u, const int (&R)[2], const int (&C)[2], unsigned (&o)[2][2]) const {
#pragma unroll
        for (int h = 0; h < 2; ++h)
#pragma unroll
            for (int i = 0; i < 2; ++i) o[h][i] = (unsigned)(h * HALF + R[i]) * 512u + (unsigned)C[i] * 2u;
    }
    __device__ __forceinline__ const char* b_base(const Unit& u) const { return WD + ((size_t)u.e * 1024 + (size_t)u.pn * 256) * 512; }
};
struct EpiDown {
    static constexpr bool PERM = true;
    bf16_t* CA; bf16_t* SH;
    __device__ __forceinline__ void operator()(const f32x4 (&acc)[2][2][4][2], const Unit& u, int wr, int wc, int fr, int fq) const {
        const int col0 = u.pn * BM + wc * 32 + 8 * fq;
        {
            const bool shd = u.e == NE;
            unsigned char* base = (shd ? (unsigned char*)SH + ((size_t)u.pm * BM + wr * 64 + fr) * DM : (unsigned char*)CA + ((size_t)u.rt * BM + wr * 64 + fr) * DM) + (col0 - 8 * (fq & 1));
#pragma unroll
            for (int ai = 0; ai < 2; ++ai)
#pragma unroll
                for (int mp = 0; mp < 4; mp += 2)
#pragma unroll
                    for (int bj = 0; bj < 2; ++bj) { unsigned wx[2], wy[2];
#pragma unroll
                        for (int q = 0; q < 2; ++q) { f32x4 v0 = acc[ai][bj][mp + q][0], v1 = acc[ai][bj][mp + q][1];
#pragma unroll
                            for (int j2 = 0; j2 < 4; ++j2) { v0[j2] = __builtin_amdgcn_fmed3f(v0[j2], -448.f, 448.f); v1[j2] = __builtin_amdgcn_fmed3f(v1[j2], -448.f, 448.f); }
                            int t = 0;
                            t = __builtin_amdgcn_cvt_pk_fp8_f32(v0[0], v0[1], t, false); t = __builtin_amdgcn_cvt_pk_fp8_f32(v0[2], v0[3], t, true); wx[q] = (unsigned)t;
                            t = __builtin_amdgcn_cvt_pk_fp8_f32(v1[0], v1[1], t, false); t = __builtin_amdgcn_cvt_pk_fp8_f32(v1[2], v1[3], t, true); wy[q] = (unsigned)t; }
                        const auto sx = __builtin_amdgcn_permlane16_swap(wx[0], wx[1], false, false), sy = __builtin_amdgcn_permlane16_swap(wy[0], wy[1], false, false);
                        u32x4 w; w.x = sx[0]; w.y = sy[0]; w.z = sx[1]; w.w = sy[1];
                        if (ai * HALF + wr * 64 + (mp + (fq & 1)) * 16 + fr < (u.slot >> 16)) *(u32x4*)(base + (size_t)(ai * HALF + (mp + (fq & 1)) * 16) * DM + bj * HALF) = w; }
        }
    }
};
}

__constant__ float c_invH[16] = {1.000000000e+00f, 4.403665960e-01f, 1.939227432e-01f, 8.539710194e-02f, 3.760603070e-02f, 1.656044088e-02f, 7.292664610e-03f, 3.211446106e-03f,
                                 1.414213562e-03f, 6.227724371e-04f, 2.742481884e-04f, 1.207697351e-04f, 5.318295734e-05f, 2.341999971e-05f, 1.031338525e-05f, 4.541670478e-06f};
__constant__ float c_invI[8] = {1.000000000e+00f, 1.939227432e-01f, 3.760603070e-02f, 7.292664610e-03f, 1.414213562e-03f, 2.742481884e-04f, 5.318295734e-05f, 1.031338525e-05f};

struct TrJob { const float* W; int ldn, nvalid; bf16_t* WT; int dld, dcol, rmode, rbase, vmode, k0, n0; const float* kgain; };
template <bool CHECK = true>
__device__ __forceinline__ void tr_load(const TrJob& J, int lane, f32x4 (&v)[8]) {
    const int n4 = (lane & 7) * 4; const bool ok = !CHECK || J.n0 + n4 < J.nvalid;
#pragma unroll
    for (int i = 0; i < 8; ++i) { const int kk = 8 * i + (lane >> 3); v[i] = ok ? *(const f32x4*)(J.W + (size_t)(J.k0 + kk) * J.ldn + J.n0 + n4) : (f32x4){0.f, 0.f, 0.f, 0.f}; }
}
__device__ __forceinline__ void tr_finish(const TrJob& J, int lane, const f32x4 (&v)[8], LAS float* scr) {
    const int n4 = (lane & 7) * 4;
    float kg[8];
    { const float* kp = (J.kgain ? J.kgain + J.k0 : c_invH) + 8 * (lane & 7) * (J.kgain ? 1 : 0);
#pragma unroll
      for (int q = 0; q < 8; ++q) kg[q] = kp[q];
      if (!J.kgain) {
#pragma unroll
          for (int q = 0; q < 8; ++q) kg[q] = 1.f; } }
#pragma unroll
    for (int i = 0; i < 8; ++i) { const int kk = 8 * i + (lane >> 3); LAS float* d = scr + kk * 33 + n4; d[0] = v[i][0]; d[1] = v[i][1]; d[2] = v[i][2]; d[3] = v[i][3]; }
    LDS_WAIT(); asm volatile("" ::: "memory");
    const int c = lane & 7;
#pragma unroll
    for (int j = 0; j < 4; ++j) { const int n = (lane >> 3) + 8 * j; const LAS float* s = scr + (8 * c) * 33 + n;
        float x[8];
#pragma unroll
        for (int q = 0; q < 8; ++q) { x[q] = s[q * 33] * kg[q]; if (J.vmode == 2) x[q] = x[q] - bf2f(f2bf(x[q])); }
        u32x4 o; o.x = pk2(x[0], x[1]); o.y = pk2(x[2], x[3]); o.z = pk2(x[4], x[5]); o.w = pk2(x[6], x[7]);
        const int ng = J.n0 + n; const int drow = J.rmode ? ((ng >> 7) * 256 + (ng & 127) + J.rbase) : (J.rbase + ng);
        *(u32x4*)(J.WT + (size_t)drow * J.dld + J.dcol + J.k0 + 8 * c) = o; }
    LDS_WAIT(); asm volatile("" ::: "memory");
}
__device__ __forceinline__ void tr_item(const float* W, int ldn, int nvalid, bf16_t* WT, int dld, int dcol, int rmode, int rbase, int vmode, int k0, int n0, LAS float* scr, int lane, const float* kgain = nullptr) {
    const TrJob J{W, ldn, nvalid, WT, dld, dcol, rmode, rbase, vmode, k0, n0, kgain}; f32x4 v[8]; tr_load(J, lane, v); tr_finish(J, lane, v, scr);
}

__device__ __forceinline__ void phase0(const Args& A, unsigned char* lds_, const int wave) {
    LAS unsigned char* lds = (LAS unsigned char*)lds_;
    const int lane = lane_opaque(), tid = wave * 64 + lane, G = gridDim.x;
    unsigned char* ws = A.ws;
    {
        LAS float* cact = (LAS float*)lds;
        LAS float* part = cact + 8192;
        const float* c = A.in[1]; const float* w_ada = A.in[2]; const float* b_ada = A.in[3]; float* mod = (float*)(ws + WS_MOD);
        for (int i = tid; i < 8192; i += NTHR) { const float v = c[i]; cact[i] = v / (1.f + expf(-v)); }
        __syncthreads();
        for (int chunk = blockIdx.x; chunk < 256; chunk += G) {
            const int n0 = chunk * 24, j = tid % 24, q = tid / 24;
            float a0 = 0.f, a1 = 0.f, a2 = 0.f, a3 = 0.f, a4 = 0.f, a5 = 0.f, a6 = 0.f, a7 = 0.f;
            if (tid < 504) {
                float wv[49];
#pragma unroll
                for (int i = 0; i < 49; ++i) { const int k = q + 21 * i; wv[i] = k < 1024 ? w_ada[(size_t)k * 6144 + n0 + j] : 0.f; }
#pragma unroll
                for (int i = 0; i < 49; ++i) { const int k = q + 21 * i < 1024 ? q + 21 * i : 1023; const float w = wv[i];
                    a0 += cact[k] * w; a1 += cact[1024 + k] * w; a2 += cact[2048 + k] * w; a3 += cact[3072 + k] * w;
                    a4 += cact[4096 + k] * w; a5 += cact[5120 + k] * w; a6 += cact[6144 + k] * w; a7 += cact[7168 + k] * w; } }
            if (tid < 504) { LAS float* p = part + (q * 8) * 24 + j; p[0] = a0; p[24] = a1; p[48] = a2; p[72] = a3; p[96] = a4; p[120] = a5; p[144] = a6; p[168] = a7; }
            __syncthreads();
            if (tid < 192) { const int b = tid / 24, jj = tid % 24; float s = b_ada[n0 + jj];
                for (int qq = 0; qq < 21; ++qq) s += part[(qq * 8 + b) * 24 + jj];
                mod[b * 6144 + n0 + jj] = s; }
            __syncthreads();
        }
    }
    {
        float* cosH = (float*)(ws + WS_COSH); float* sinH = (float*)(ws + WS_SINH); float* cosI = (float*)(ws + WS_COSI); float* sinI = (float*)(ws + WS_SINI);
        for (int i = blockIdx.x * NTHR + tid; i < SEQ * 24; i += G * NTHR) {
            int pos, f; float inv; bool isH = i < SEQ * 16;
            if (isH) { pos = i >> 4; f = i & 15; inv = c_invH[f]; } else { const int k = i - SEQ * 16; pos = k >> 3; f = k & 7; inv = c_invI[f]; }
            const float ang = (float)pos * inv;
            double t = (double)ang * 0.15915494309189533577; t -= rint(t);
            const float rev = (float)t;
            const float cs = __builtin_amdgcn_cosf(rev), sn = __builtin_amdgcn_sinf(rev);
            if (isH) { cosH[i] = cs; sinH[i] = sn; } else { cosI[i - SEQ * 16] = cs; sinI[i - SEQ * 16] = sn; }
        }
    }
    {
        LAS float* scr = (LAS float*)(lds + 65536 + wave * 8448);
        const int gw = blockIdx.x * NWAVES + wave, NGW = G * NWAVES;
        bf16_t* WIN = (bf16_t*)(ws + WS_WIN); bf16_t* WOUT = (bf16_t*)(ws + WS_WOUT); bf16_t* WR = (bf16_t*)(ws + WS_WR); bf16_t* WKV = (bf16_t*)(ws + WS_WKV);
        constexpr int I_IN = 16 * 96, I_KV = 4 * 8, I_OUT = 16 * 32, I_R = 16 * 8;
        constexpr int NITEMS = I_IN + I_KV + I_OUT + 3 * I_R;
        for (int it = gw; it < NITEMS; it += NGW) {
            int r = it;
            if (r < I_IN) { tr_item(A.in[5], NPROJ, NPROJ, WIN, 1024, 0, 0, 0, 0, 64 * (r / 96), 32 * (r % 96), scr, lane); continue; } r -= I_IN;
            if (r < I_KV) { tr_item(A.in[7], 256, 256, WKV, 256, 0, 0, 0, 0, 64 * (r / 8), 32 * (r % 8), scr, lane, A.in[6]); continue; } r -= I_KV;
            if (r < I_OUT) { const int k0_ = 64 * (r / 32); tr_item(A.in[10], 1024, 1024, WOUT, 1024, 0, 0, 0, 0, k0_, 32 * (r % 32), scr, lane, k0_ < 512 ? A.in[8] : A.in[9] - 512); continue; } r -= I_OUT;
            if (r < I_R) { tr_item(A.in[12], 256, 256, WR, 2048, 0, 0, 0, 1, 64 * (r / 8), 32 * (r % 8), scr, lane); continue; } r -= I_R;
            if (r < I_R) { tr_item(A.in[12], 256, 256, WR, 2048, 1024, 0, 0, 1, 64 * (r / 8), 32 * (r % 8), scr, lane); continue; } r -= I_R;
            tr_item(A.in[12], 256, 256, WR, 2048, 0, 0, 256, 2, 64 * (r / 8), 32 * (r % 8), scr, lane);
        }
        for (int i = blockIdx.x * NTHR + tid; i < 256 * 128; i += G * NTHR) { const int rr = 256 + (i >> 7), cc = 1024 + (i & 127) * 8; *(u32x4*)(WR + (size_t)rr * 2048 + cc) = (u32x4){0u, 0u, 0u, 0u}; }
    }
}


__device__ __forceinline__ void convert_experts(const Args& A, unsigned char* lds_, const int wave) {
    LAS unsigned char* lds = (LAS unsigned char*)lds_;
    const int lane = lane_opaque();
    unsigned char* ws = A.ws;
    LAS float* scr = (LAS float*)(lds + wave * 8448);
    const int gw = blockIdx.x * NWAVES + wave, NGW = gridDim.x * NWAVES;
    bf16_t* WD = (bf16_t*)(ws + WS_WD); bf16_t* WGU = (bf16_t*)(ws + WS_WGU);
    struct XJob { const char* src; char* dst; unsigned ldnB, dldB; float sc; };
    auto job = [&](int r) -> XJob {
        const int e = r / 384, q = r % 384; const bool sh_ = (e == NE);
        if (q < 256) { const int q2 = q & 127, k0 = 64 * (q2 >> 3), n0 = 32 * (q2 & 7), up = q >> 7;
            const float* w = up ? (!sh_ ? A.in[15] + (size_t)e * 1024 * 256 : A.in[18]) : (!sh_ ? A.in[14] + (size_t)e * 1024 * 256 : A.in[17]);
            const int drow0 = (n0 >> 7) * 256 + (n0 & 127) + 128 * up;
            return XJob{(const char*)(w + (size_t)k0 * 256 + n0), (char*)(WGU + (size_t)e * 512 * 1024 + (size_t)drow0 * 1024 + k0), 256u * 4u, 1024u * 2u, 1.f}; }
        const int q3 = q - 256, k0 = 64 * (q3 >> 5), n0 = 32 * (q3 & 31);
        const float* w = !sh_ ? A.in[16] + (size_t)e * 256 * 1024 : A.in[19];
        return XJob{(const char*)(w + (size_t)k0 * 1024 + n0), (char*)(WD + (size_t)e * 1024 * 256 + (size_t)n0 * 256 + k0), 1024u * 4u, 256u * 2u, sh_ ? 4.f : 16.f};
    };
    auto xload = [&](const XJob& J, f32x4 (&v)[8]) {
        const unsigned vo = (unsigned)(lane >> 3) * J.ldnB + (unsigned)(lane & 7) * 16u;
#pragma unroll
        for (int i = 0; i < 8; ++i) v[i] = *(const f32x4*)(J.src + (size_t)(8 * i) * J.ldnB + vo);
    };
    auto xfinish = [&](const XJob& J, const f32x4 (&v)[8]) {
        const int n4 = (lane & 7) * 4;
#pragma unroll
        for (int i = 0; i < 8; ++i) { const int kk = 8 * i + (lane >> 3); LAS float* d = scr + kk * 33 + n4; d[0] = v[i][0]; d[1] = v[i][1]; d[2] = v[i][2]; d[3] = v[i][3]; }
        LDS_WAIT(); asm volatile("" ::: "memory");
        const int c = lane & 7; const unsigned vo2 = (unsigned)(lane >> 3) * J.dldB + (unsigned)c * 16u;
#pragma unroll
        for (int jx = 0; jx < 4; ++jx) { const int n = (lane >> 3) + 8 * jx; const LAS float* sp = scr + (8 * c) * 33 + n;
            float x[8];
#pragma unroll
            for (int q = 0; q < 8; ++q) x[q] = sp[q * 33] * J.sc;
            u32x4 o; o.x = pk2(x[0], x[1]); o.y = pk2(x[2], x[3]); o.z = pk2(x[4], x[5]); o.w = pk2(x[6], x[7]);
            *(u32x4*)(J.dst + (size_t)(8 * jx) * J.dldB + vo2) = o; }
        LDS_WAIT(); asm volatile("" ::: "memory");
    };
    constexpr int NIT = 384 * NEX;
    int r = gw;
    if (r >= NIT) return;
    f32x4 va[8], vb[8], vc[8], vd[8];
#define CE_LD(dst, rr) do { const int r_ = (rr) < NIT ? (rr) : last; const XJob J_ = job(r_); xload(J_, dst); __builtin_amdgcn_fence(__ATOMIC_RELEASE, "wavefront"); } while (0)
#define CE_FIN(src, rr) do { if ((rr) < NIT) { const XJob J_ = job(rr); xfinish(J_, src); } } while (0)
    const int last = gw + ((NIT - 1 - gw) / NGW) * NGW;
    CE_LD(va, r); CE_LD(vb, r + NGW); CE_LD(vc, r + 2 * NGW);
    for (; r < NIT; r += 4 * NGW) {
        CE_LD(vd, r + 3 * NGW); CE_FIN(va, r);
        CE_LD(va, r + 4 * NGW); CE_FIN(vb, r + NGW);
        CE_LD(vb, r + 5 * NGW); CE_FIN(vc, r + 2 * NGW);
        CE_LD(vc, r + 6 * NGW); CE_FIN(vd, r + 3 * NGW);
    }
#undef CE_LD
#undef CE_FIN
}

__device__ __forceinline__ void modnorm_fin(f32x4 (&v)[4], const f32x4 (&g)[4], const f32x4 (&sh)[4], const f32x4 (&sc)[4]) {
    float s = 0.f;
#pragma unroll
    for (int j = 0; j < 4; ++j) s += (v[j].x * v[j].x + v[j].y * v[j].y) + (v[j].z * v[j].z + v[j].w * v[j].w);
    const float rstd = 1.f / sqrtf(wave_sum_dpp(s) * (1.f / DM) + EPS);
#pragma unroll
    for (int j = 0; j < 4; ++j) v[j] = (v[j] * rstd * g[j]) * (sc[j] + 1.f) + sh[j];
}
#define MN_LD4(dst_, ptr_) do { _Pragma("unroll") for (int j_ = 0; j_ < 4; ++j_) dst_[j_] = *((const f32x4*)(ptr_) + lane + 64 * j_); } while (0)
__device__ __forceinline__ void phase1(const Args& A, const int wave) {
    const int lane = lane_opaque();
    const int gw = blockIdx.x * NWAVES + wave, NGW = gridDim.x * NWAVES;
    const float* x = A.in[0]; const float* mod = (const float*)(A.ws + WS_MOD); bf16_t* H = (bf16_t*)(A.ws + WS_H);
    f32x4 g[4]; MN_LD4(g, A.in[4]);
    f32x4 ca[4], cb[4], na[4], nb[4];
    if (gw < T) { MN_LD4(ca, x + (size_t)gw * DM); MN_LD4(cb, x + (size_t)(gw + NGW < T ? gw + NGW : gw) * DM); }
    for (int row = gw; row < T; row += 2 * NGW) {
        const int rowB = row + NGW; const bool hasB = rowB < T; const int rB = hasB ? rowB : row;
        const float* mbA = mod + (size_t)(row >> 12) * 6144; const float* mbB = mod + (size_t)(rB >> 12) * 6144;
        f32x4 shA[4], scA[4], shB[4], scB[4];
        MN_LD4(shA, mbA); MN_LD4(scA, mbA + 1024); MN_LD4(shB, mbB); MN_LD4(scB, mbB + 1024);
        const int nA = row + 2 * NGW < T ? row + 2 * NGW : row, nB = row + 3 * NGW < T ? row + 3 * NGW : row;
        MN_LD4(na, x + (size_t)nA * DM); MN_LD4(nb, x + (size_t)nB * DM);
        modnorm_fin(ca, g, shA, scA);
#pragma unroll
        for (int j = 0; j < 4; ++j) { u32x2 o; o.x = pk2(ca[j].x, ca[j].y); o.y = pk2(ca[j].z, ca[j].w); *((u32x2*)(H + (size_t)row * DM) + lane + 64 * j) = o; }
        if (hasB) { modnorm_fin(cb, g, shB, scB);
#pragma unroll
            for (int j = 0; j < 4; ++j) { u32x2 o; o.x = pk2(cb[j].x, cb[j].y); o.y = pk2(cb[j].z, cb[j].w); *((u32x2*)(H + (size_t)rowB * DM) + lane + 64 * j) = o; } }
#pragma unroll
        for (int j = 0; j < 4; ++j) { ca[j] = na[j]; cb[j] = nb[j]; }
    }
}

__device__ __forceinline__ void kmean_units(const Args& A, unsigned char* lds_, const int wave, int u0, int ustep) {
    const int lane = lane_opaque(), tid = wave * 64 + lane;
    const bf16_t* KM = (const bf16_t*)(A.ws + WS_KM); float* KMEAN = (float*)(A.ws + WS_KMEAN);
    LAS float* part = (LAS float*)lds_;
    constexpr int NU = NB * 4 * 16;
    const int r4 = lane >> 4, c8 = (lane & 15) * 8;
#define KMU_LD(u_, v_) do { const bf16_t* base_ = KM + ((size_t)((u_) >> 4) * SEQ + ((u_) & 15) * 256 + wave * 32 + r4) * 128 + c8; \
        _Pragma("unroll") for (int j = 0; j < 8; ++j) v_[j] = *(const u32x4*)(base_ + (size_t)(4 * j) * 128); } while (0)
    u32x4 cur[8], nxt[8];
    if (u0 < NU) KMU_LD(u0, cur);
    for (int u = u0; u < NU; u += ustep) {
        const int un = u + ustep < NU ? u + ustep : u;
        KMU_LD(un, nxt);
        float a[8];
#pragma unroll
        for (int q = 0; q < 8; ++q) a[q] = 0.f;
#pragma unroll
        for (int j = 0; j < 8; ++j)
#pragma unroll
            for (int d = 0; d < 4; ++d) { a[2 * d] += bflo(cur[j][d]); a[2 * d + 1] += bfhi(cur[j][d]); }
#pragma unroll
        for (int q = 0; q < 8; ++q) { a[q] += __shfl_xor(a[q], 16); a[q] += __shfl_xor(a[q], 32); }
        if (lane < 16) { *(LAS f32x4*)(part + wave * 128 + c8) = (f32x4){a[0], a[1], a[2], a[3]}; *(LAS f32x4*)(part + wave * 128 + c8 + 4) = (f32x4){a[4], a[5], a[6], a[7]}; }
        __syncthreads();
        if (tid < 128) { float sm = 0.f; for (int p = 0; p < 8; ++p) sm += part[p * 128 + tid]; KMEAN[(size_t)u * 128 + tid] = sm * (1.f / 256.f); }
        __syncthreads();
#pragma unroll
        for (int j = 0; j < 8; ++j) cur[j] = nxt[j];
    }
#undef KMU_LD
}

namespace att {
typedef short s16x4 __attribute__((ext_vector_type(4)));
typedef float f32x16 __attribute__((ext_vector_type(16)));
constexpr int D = 128, NW = 8, QBLK = 32, KVBLK = 64;
constexpr int SHM_V = KVBLK * D * 2, SHM_K = KVBLK * D * 2;
constexpr int LDS_ATT = 2 * SHM_V + 2 * SHM_K + NW * 128 * 4;
constexpr float SCALE = 0.08838834764831845f, THR = 8.f;
#define KSWZ(row, colB) ((row) * 256 + ((colB) ^ (((row) & 7) << 4)))
#define SBAR() __builtin_amdgcn_sched_barrier(0)
__device__ __forceinline__ int v_st(int k, int c) { const int kk = (k & ~0xC) | ((k & 4) << 1) | ((k & 8) >> 1); return ((kk >> 3) * 4 + (c >> 5)) * 512 + ((kk & 7) * 32 + (c & 31)) * 2; }
__device__ __forceinline__ int v_rd_base(int lane) { return ((lane & 3) << 3) | (((lane >> 2) & 3) << 6) | (((lane >> 4) & 1) << 5) | (((lane >> 5) & 1) << 8); }
constexpr int v_rd_off(int d0, int ks, int half) { return d0 * 512 + ks * 4096 + half * 2048; }
__device__ __forceinline__ int crow(int r, int hi) { return (r & 3) + 8 * (r >> 2) + 4 * hi; }
__device__ __forceinline__ unsigned cvtpk(float lo, float hi) { unsigned r; asm volatile("v_cvt_pk_bf16_f32 %0, %1, %2" : "=v"(r) : "v"(lo), "v"(hi)); return r; }
__device__ __forceinline__ void mask_tile(f32x16& p0, f32x16& p1, int dq) {
    const float NEG = -__builtin_inff();
#pragma unroll
    for (int r = 0; r < 16; ++r) { const int c = (r & 3) + 8 * (r >> 2); if (dq - c < 0) p0[r] = NEG; if (dq - c - 32 < 0) p1[r] = NEG; }
}
__device__ __forceinline__ void bias_tile(f32x16& p0, f32x16& p1, unsigned long long mw, int hi) {
    const unsigned lo = (unsigned)mw >> (4 * hi), hh = (unsigned)(mw >> 32) >> (4 * hi);
#pragma unroll
    for (int r = 0; r < 16; ++r) { const int c = (r & 3) + 8 * (r >> 2);
        const unsigned x0 = (unsigned)__builtin_amdgcn_sbfe((int)lo, c, 1), x1 = (unsigned)__builtin_amdgcn_sbfe((int)hh, c, 1);
        p0[r] = __builtin_bit_cast(float, ~x0 & 0xFF800000u); p1[r] = __builtin_bit_cast(float, ~x1 & 0xFF800000u); }
}
__device__ __forceinline__ void partialSM(f32x16& p0, f32x16& p1, float& m_reg, float& mn, float& alpha, bool keep) {
    float pmax = p0[0];
#pragma unroll
    for (int r = 1; r < 16; ++r) pmax = fmaxf(pmax, p0[r]);
#pragma unroll
    for (int r = 0; r < 16; ++r) pmax = fmaxf(pmax, p1[r]);
    { auto rr = __builtin_amdgcn_permlane32_swap(__float_as_uint(pmax), __float_as_uint(pmax), false, false);
      pmax = fmaxf(__uint_as_float(rr[0]), __uint_as_float(rr[1])); }
    pmax = keep ? pmax : -__builtin_inff();
    constexpr float C2 = 1.4426950408889634f * SCALE;
    if (__builtin_expect(__all((pmax - m_reg) * SCALE <= THR), 1)) { mn = m_reg; alpha = 1.f; }
    else { mn = fmaxf(m_reg, pmax); alpha = __builtin_amdgcn_exp2f((m_reg - mn) * C2); m_reg = mn; }
    const float mnL = keep ? -mn * C2 : -__builtin_inff();
#pragma unroll
    for (int r = 0; r < 16; ++r) p0[r] = fmaf(p0[r], C2, mnL);
#pragma unroll
    for (int r = 0; r < 16; ++r) p1[r] = fmaf(p1[r], C2, mnL);
#pragma unroll
    for (int r = 0; r < 16; ++r) p0[r] = __builtin_amdgcn_exp2f(p0[r]);
}
__device__ __forceinline__ void finishSM(f32x16& p0, f32x16& p1, float alpha, float& l_reg, bf16x8& pa0, bf16x8& pa1, bf16x8& pa2, bf16x8& pa3) {
#pragma unroll
    for (int r = 0; r < 16; ++r) p1[r] = __builtin_amdgcn_exp2f(p1[r]);
    float ps = 0;
#pragma unroll
    for (int r = 0; r < 16; ++r) ps += p0[r];
#pragma unroll
    for (int r = 0; r < 16; ++r) ps += p1[r];
    { auto rr = __builtin_amdgcn_permlane32_swap(__float_as_uint(ps), __float_as_uint(ps), false, false);
      ps = __uint_as_float(rr[0]) + __uint_as_float(rr[1]); }
    l_reg = l_reg * alpha + ps;
#define PK4(P, B_, OUT) do { unsigned a0 = cvtpk(P[B_+0], P[B_+1]), a1 = cvtpk(P[B_+2], P[B_+3]);                          \
        unsigned b0 = cvtpk(P[B_+4], P[B_+5]), b1 = cvtpk(P[B_+6], P[B_+7]);                                             \
        auto r0 = __builtin_amdgcn_permlane32_swap(a0, b0, false, false); auto r1 = __builtin_amdgcn_permlane32_swap(a1, b1, false, false); \
        u32x4 w = {r0[0], r1[0], r0[1], r1[1]}; OUT = *reinterpret_cast<bf16x8*>(&w); } while (0)
    PK4(p0, 0, pa0); PK4(p0, 8, pa1); PK4(p1, 0, pa2); PK4(p1, 8, pa3);
#undef PK4
}
template <int KB>
__device__ __forceinline__ void qkt(f32x16& p0, f32x16& p1, const char* K_lds, int r32, int hi, const bf16x8* qr) {
    const char* kb[4];
#pragma unroll
    for (int dd = 0; dd < 4; ++dd) kb[dd] = K_lds + KB * SHM_K + KSWZ(r32, (dd * 16 + hi * 8) * 2);
#pragma unroll
    for (int d0 = 0; d0 < 8; ++d0) { const char* a = kb[d0 & 3] + (d0 >> 2) * 128;
        bf16x8 b0 = *reinterpret_cast<const bf16x8*>(a);
        bf16x8 b1 = *reinterpret_cast<const bf16x8*>(a + 32 * 256);
        p0 = __builtin_amdgcn_mfma_f32_32x32x16_bf16(b0, qr[d0], p0, 0, 0, 0);
        p1 = __builtin_amdgcn_mfma_f32_32x32x16_bf16(b1, qr[d0], p1, 0, 0, 0); }
}
template <int VB>
__device__ __forceinline__ void pv_tile(f32x16* o, int vb0, bf16x8 pa0, bf16x8 pa1, bf16x8 pa2, bf16x8 pa3) {
#define TRRD(dst, off) asm volatile("ds_read_b64_tr_b16 %0, %1 offset:%2" : "=&v"(dst) : "v"(vb0), "i"(off) : "memory")
#define PV_D0(d0) do { s16x4 l0, l1, l2, l3, h0, h1, h2, h3; constexpr int b_ = VB * SHM_V + v_rd_off(d0, 0, 0); \
        TRRD(l0, b_); TRRD(h0, b_ + 2048); TRRD(l1, b_ + 4096); TRRD(h1, b_ + 6144); TRRD(l2, b_ + 8192); TRRD(h2, b_ + 10240); TRRD(l3, b_ + 12288); TRRD(h3, b_ + 14336); \
        asm volatile("s_waitcnt lgkmcnt(0)" ::: "memory"); SBAR();   \
        o[d0] = __builtin_amdgcn_mfma_f32_32x32x16_bf16(pa0, (bf16x8){l0[0], l0[1], l0[2], l0[3], h0[0], h0[1], h0[2], h0[3]}, o[d0], 0, 0, 0);   \
        o[d0] = __builtin_amdgcn_mfma_f32_32x32x16_bf16(pa1, (bf16x8){l1[0], l1[1], l1[2], l1[3], h1[0], h1[1], h1[2], h1[3]}, o[d0], 0, 0, 0);   \
        o[d0] = __builtin_amdgcn_mfma_f32_32x32x16_bf16(pa2, (bf16x8){l2[0], l2[1], l2[2], l2[3], h2[0], h2[1], h2[2], h2[3]}, o[d0], 0, 0, 0);   \
        o[d0] = __builtin_amdgcn_mfma_f32_32x32x16_bf16(pa3, (bf16x8){l3[0], l3[1], l3[2], l3[3], h3[0], h3[1], h3[2], h3[3]}, o[d0], 0, 0, 0); } while (0)
    PV_D0(0); PV_D0(1); PV_D0(2); PV_D0(3);
#undef PV_D0
#undef TRRD
}
__device__ __forceinline__ __amdgpu_buffer_rsrc_t mkrsrc(const void* p, int bytes) {
    const unsigned long long a = (unsigned long long)p; const unsigned lo = __builtin_amdgcn_readfirstlane((unsigned)a), hi = __builtin_amdgcn_readfirstlane((unsigned)(a >> 32));
    return __builtin_amdgcn_make_buffer_rsrc((void*)(((unsigned long long)hi << 32) | lo), (short)0, bytes, 0x00020000);
}
#define BLD16(rs, vo, so) __builtin_bit_cast(bf16x8, __builtin_amdgcn_raw_buffer_load_b128((rs), (int)(vo), (int)(so), 0))
struct Blk { const bf16_t* Qw; const bf16_t* K; const bf16_t* V; bf16_t* Ow; float* Sq; int NT, qpos, own_t0; const unsigned long long* mrow; };
struct Seam { bf16x8 qr[8]; bf16x8 st0, st1; };
constexpr int OST = 1024;
#define VMW() asm volatile("s_waitcnt vmcnt(0)" ::: "memory")
#define VMWN(n) asm volatile("s_waitcnt vmcnt(%0)" :: "i"(n) : "memory")
#define SLOAD(rs, k0) do { S.st0 = BLD16(rs, kvoff, (k0) * 256); S.st1 = BLD16(rs, kvoff, (k0) * 256 + 8192); } while (0)
#define SWRITE_K(bf) do { *(bf16x8*)(K_lds + (bf) * SHM_K + kws) = S.st0; *(bf16x8*)(K_lds + (bf) * SHM_K + kws + 32 * 256) = S.st1; } while (0)
#define SWRITE_V(bf) do { *(bf16x8*)(V_lds + (bf) * SHM_V + vst0) = S.st0; *(bf16x8*)(V_lds + (bf) * SHM_V + vst1) = S.st1; } while (0)
__device__ __forceinline__ void att_prime(const Blk& cur, char* lds, Seam& S, int wid) {
    const int lane = lane_opaque(), tid = wid * 64 + lane, r32 = lane & 31, hi = lane >> 5;
    const int sr = tid >> 4, sc = (tid & 15) * 8, kws = KSWZ(sr, sc * 2); char* K_lds = lds + 2 * SHM_V;
    const unsigned kvoff = (unsigned)(sr * 256 + sc * 2), qoff = (unsigned)(r32 * 256 + hi * 16);
    const __amdgpu_buffer_rsrc_t rQ = mkrsrc(cur.Qw, 32 * 256), rK = mkrsrc(cur.K, SEQ * 256), rV = mkrsrc(cur.V, SEQ * 256);
#pragma unroll
    for (int d0 = 0; d0 < 8; ++d0) S.qr[d0] = BLD16(rQ, qoff + d0 * 32, 0);
    SLOAD(rK, 0); VMW(); SWRITE_K(0); SBAR(); SLOAD(rV, 0);
    __syncthreads();
}
template <int MODE>
__device__ __forceinline__ void att_block(const Blk& cur, const Blk& nxt, char* lds, Seam& S, int wid) {
    const int lane = lane_opaque(), tid = wid * 64 + lane, r32 = lane & 31, hi = lane >> 5;
    const int NT = cur.NT;
    const int qlo = cur.qpos, qm = qlo + r32 - 4 * hi;
    char* V_lds = lds; char* K_lds = lds + 2 * SHM_V;
    float* ws = (float*)(lds + 2 * SHM_V + 2 * SHM_K) + wid * 128; float* li_l = ws, * al_l = ws + 32; const unsigned* sel_l = (const unsigned*)(ws + 64);
    float m_reg = -1e30f, l_reg = 0; f32x16 o[4] = {};
    const int sr = tid >> 4, sc = (tid & 15) * 8, vst0 = v_st(sr, sc), vst1 = v_st(32 + sr, sc), kws = KSWZ(sr, sc * 2);
    const int vb0 = (int)(uintptr_t)V_lds + v_rd_base(lane);
    const unsigned kvoff = (unsigned)(sr * 256 + sc * 2), qoff = (unsigned)(r32 * 256 + hi * 16);
    const __amdgpu_buffer_rsrc_t Kh = mkrsrc(cur.K, SEQ * 256), Vh = mkrsrc(cur.V, SEQ * 256);
    const __amdgpu_buffer_rsrc_t rM = mkrsrc(MODE == 1 ? (const void*)cur.mrow : (const void*)cur.K, 64 * 512);
#define MLD(t) __builtin_bit_cast(unsigned long long, __builtin_amdgcn_raw_buffer_load_b64(rM, (int)((32 * (wid >> 2) + r32) * 8), (int)((t) * 512), 0))
#define RESC(a) do { if (__any((a) < 1.f)) { if (hi == 0) al_l[r32] = (a); asm volatile("s_waitcnt lgkmcnt(0)" ::: "memory");              \
                     for (int d_ = 0; d_ < 4; ++d_) for (int r = 0; r < 16; ++r) o[d_][r] *= al_l[crow(r, hi)]; } } while (0)
#define KBASE(t) ((t) * KVBLK)
#define MASKT(P0_, P1_, t) do { if (MODE == 0) { const int kb_ = KBASE(t); if ((t) >= cur.own_t0 && kb_ + KVBLK - 1 > qlo) mask_tile(P0_, P1_, qm - kb_); } } while (0)
#define KEEP(t) ((MODE == 0) ? (((t) >= cur.own_t0) || ((sel_l[r32] >> ((t) >> 2)) & 1u)) : true)
#define PINIT(P0_, P1_, t) do { if (MODE == 1) { bias_tile(P0_, P1_, mwq, hi); mwq = MLD(((t) + 1 < NT) ? (t) + 1 : (t)); } else { P0_ = f32x16{}; P1_ = f32x16{}; } } while (0)
#define SEAM_K0() do { VMWN(8); SWRITE_K(0); SBAR(); { const __amdgpu_buffer_rsrc_t rVn = mkrsrc(nxt.V, SEQ * 256); SLOAD(rVn, 0); } SBAR(); } while (0)
    f32x16 pA0, pA1, pB0, pB1; float mnA, mnB, alA, alB; bf16x8 pa0, pa1, pa2, pa3;
    unsigned long long mwq = 0ull; if (MODE == 1) mwq = MLD(0);
    VMW(); SWRITE_V(0); SBAR();
    if (NT > 1) SLOAD(Kh, KBASE(1));
    PINIT(pA0, pA1, 0);
    SBAR(); qkt<0>(pA0, pA1, K_lds, r32, hi, S.qr);
    if (NT > 1) { VMW(); SWRITE_K(1); SBAR(); SLOAD(Vh, KBASE(1)); }
    MASKT(pA0, pA1, 0); partialSM(pA0, pA1, m_reg, mnA, alA, KEEP(0));
    if (NT > 1) { VMW(); SWRITE_V(1); SBAR(); if (NT > 2) SLOAD(Kh, KBASE(2)); }
    __syncthreads();
#define HALF_STEP(PX0, PX1, mnX, alX, PY0, PY1, alY, t, KB, VB, SB) do {                                                      \
        PINIT(PX0, PX1, t);                                                                                                   \
        SBAR(); qkt<KB>(PX0, PX1, K_lds, r32, hi, S.qr);                                                                      \
        finishSM(PY0, PY1, alY, l_reg, pa0, pa1, pa2, pa3); SBAR();                                                           \
        if ((t) + 1 < NT) { VMW(); SWRITE_K(SB); SBAR(); SLOAD(Vh, KBASE((t) + 1)); SBAR(); }                                 \
        pv_tile<VB>(o, vb0, pa0, pa1, pa2, pa3); MASKT(PX0, PX1, (t)); partialSM(PX0, PX1, m_reg, mnX, alX, KEEP(t));        \
        __syncthreads();                                                                                                      \
        if ((t) + 1 < NT) { VMW(); SWRITE_V(SB); SBAR(); if ((t) + 2 < NT) SLOAD(Kh, KBASE((t) + 2)); }                       \
        RESC(alX); __syncthreads(); } while (0)
    for (int t = 1; t + 1 < NT; t += 2) {
        HALF_STEP(pB0, pB1, mnB, alB, pA0, pA1, alA, t, 1, 0, 0);
        HALF_STEP(pA0, pA1, mnA, alA, pB0, pB1, alB, t + 1, 0, 1, 1);
    }
    const bool even = (NT & 1) == 0;
    if (even) { PINIT(pB0, pB1, NT - 1); SBAR(); qkt<1>(pB0, pB1, K_lds, r32, hi, S.qr); SBAR(); }
    { const __amdgpu_buffer_rsrc_t rKn = mkrsrc(nxt.K, SEQ * 256); SLOAD(rKn, 0); } SBAR();
    { const __amdgpu_buffer_rsrc_t rQn = mkrsrc(nxt.Qw, 32 * 256);
#pragma unroll
      for (int d0 = 0; d0 < 8; ++d0) S.qr[d0] = BLD16(rQn, qoff + d0 * 32, 0); }
    SBAR();
    finishSM(pA0, pA1, alA, l_reg, pa0, pa1, pa2, pa3); SBAR();
    pv_tile<0>(o, vb0, pa0, pa1, pa2, pa3);
    if (even) { MASKT(pB0, pB1, NT - 1); partialSM(pB0, pB1, m_reg, mnB, alB, KEEP(NT - 1)); __syncthreads(); RESC(alB);
        finishSM(pB0, pB1, alB, l_reg, pa0, pa1, pa2, pa3); SBAR(); pv_tile<1>(o, vb0, pa0, pa1, pa2, pa3); }
    SBAR(); SEAM_K0();
    if (hi == 0) li_l[r32] = l_reg; asm volatile("s_waitcnt lgkmcnt(0)" ::: "memory");
    float rli[16];
#pragma unroll
    for (int r = 0; r < 16; ++r) rli[r] = __builtin_amdgcn_rcpf(li_l[crow(r, hi)]);
    bf16_t* Ow = cur.Ow;
#pragma unroll
    for (int r = 0; r < 16; ++r) { const int orow = crow(r, hi); float ss = 0.f;
#pragma unroll
        for (int d0 = 0; d0 < 4; ++d0) { const float v = o[d0][r] * rli[r]; ss += v * v;
            const float vn = __shfl_xor(v, 1);
            if ((r32 & 1) == 0) *(unsigned*)(Ow + (size_t)orow * OST + d0 * 32 + r32) = cvtpk(v, vn); }
        ss += __shfl_xor(ss, 1); ss += __shfl_xor(ss, 2); ss += __shfl_xor(ss, 4); ss += __shfl_xor(ss, 8); ss += __shfl_xor(ss, 16);
        if (r32 == 0) cur.Sq[(size_t)orow * 8] = ss; }
    __syncthreads();
#undef RESC
#undef KBASE
#undef MASKT
#undef KEEP
#undef PINIT
#undef SEAM_K0
#undef HALF_STEP
#undef MLD
}
__device__ __forceinline__ void moba_gate(const Seam& S, const float* km  , int own, char* lds, int wid) {
    const int lane = lane_opaque(), r32 = lane & 31, hi = lane >> 5;
    unsigned* sel_l = (unsigned*)((float*)(lds + 2 * SHM_V + 2 * SHM_K) + wid * 128 + 64);
    float* kl = (float*)(lds + 73728 + wid * 8192);
    { f32x4 t[8];
#pragma unroll
      for (int i = 0; i < 8; ++i) t[i] = *((const f32x4*)km + lane + 64 * i);
#pragma unroll
      for (int i = 0; i < 8; ++i) *((f32x4*)kl + lane + 64 * i) = t[i]; }
    float g[15];
#pragma unroll
    for (int n = 0; n < 15; ++n) { g[n] = -__builtin_inff();
        if (n < own) { float a = 0.f;
#pragma unroll
            for (int d0 = 0; d0 < 8; ++d0) { const float* kp = kl + n * 128 + d0 * 16 + hi * 8; const f32x4 k0 = *(const f32x4*)kp, k1 = *(const f32x4*)(kp + 4); const bf16x8 q = S.qr[d0];
                a += bf2f((unsigned short)q[0]) * k0[0] + bf2f((unsigned short)q[1]) * k0[1] + bf2f((unsigned short)q[2]) * k0[2] + bf2f((unsigned short)q[3]) * k0[3]
                   + bf2f((unsigned short)q[4]) * k1[0] + bf2f((unsigned short)q[5]) * k1[1] + bf2f((unsigned short)q[6]) * k1[2] + bf2f((unsigned short)q[7]) * k1[3]; }
            g[n] = a + __shfl_xor(a, 32); } }
    unsigned sel = 0u;
#pragma unroll
    for (int r = 0; r < 3; ++r) { int best = -1; float bv = -__builtin_inff();
#pragma unroll
        for (int n = 0; n < 15; ++n) if (n < own && !((sel >> n) & 1u) && g[n] > bv) { bv = g[n]; best = n; }
        if (best >= 0) sel |= 1u << best; }
    if (hi == 0) sel_l[r32] = sel;
    asm volatile("s_waitcnt lgkmcnt(0)" ::: "memory");
}

#undef ROW
#undef VMW
#undef VMWN
#undef SLOAD
#undef SWRITE_K
#undef SWRITE_V
}

namespace idx {
typedef _Float16 f16x8 __attribute__((ext_vector_type(8)));
typedef float f32x16 __attribute__((ext_vector_type(16)));
constexpr int HIST_OFF = 0, MASKL_OFF = 131072, META_OFF = 139264, CAP = 1024;
__device__ __forceinline__ unsigned fkey(float v) { const unsigned u = __builtin_bit_cast(unsigned, v); return u ^ ((unsigned)((int)u >> 31) | 0x80000000u); }
template <int CTRL> __device__ __forceinline__ int dpp_i0(int v) { return __builtin_amdgcn_update_dpp(0, v, CTRL, 0xF, 0xF, true); }
__device__ __forceinline__ int suffix_sum64(int v, int lane) {
    int s = v;
    s += dpp_i0<0x101>(s); s += dpp_i0<0x102>(s); s += dpp_i0<0x104>(s); s += dpp_i0<0x108>(s);
    const int t1 = __builtin_amdgcn_readlane(s, 16), t2 = __builtin_amdgcn_readlane(s, 32), t3 = __builtin_amdgcn_readlane(s, 48);
    const int r = lane >> 4;
    return s + (r == 0 ? t1 + t2 + t3 : r == 1 ? t2 + t3 : r == 2 ? t3 : 0);
}
__device__ __forceinline__ int kbin(unsigned key) {
    const unsigned nt = ~(unsigned)((int)key >> 31);
    const unsigned mag = (key ^ nt) & 0x7fffffffu;
    int e6 = (int)(mag >> 17) - 107 * 64; e6 = e6 < 0 ? 0 : e6; e6 = e6 > 2047 ? 2047 : e6;
    return 2048 + (int)((unsigned)e6 ^ nt);
}
__device__ __forceinline__ float fadd1(float a, float b) { float r; asm("v_add_f32_e32 %0, %1, %2" : "=v"(r) : "v"(a), "v"(b)); return r; }
#define IDX_LATOM_ADD(p, v) __hip_atomic_fetch_add((LAS unsigned*)(p), (v), __ATOMIC_RELAXED, __HIP_MEMORY_SCOPE_WORKGROUP)
#define IDX_LATOM_OR(p, v) __hip_atomic_fetch_or((LAS unsigned*)(p), (v), __ATOMIC_RELAXED, __HIP_MEMORY_SCOPE_WORKGROUP)
template <bool CHECK>
__device__ __forceinline__ void tile1(const f16x8 (&b)[4], const int t, const f16x8 (&a)[2][4], const float (&sg)[2][16], int q0, int qh, int lane, LAS unsigned* hist, unsigned* ks) {
    const int c = lane & 31, hi = lane >> 5;
    f32x16 acc[2] = {};
#pragma unroll
    for (int kk = 0; kk < 4; ++kk) { acc[0] = __builtin_amdgcn_mfma_f32_32x32x16_f16(a[0][kk], b[kk], acc[0], 0, 0, 0); acc[1] = __builtin_amdgcn_mfma_f32_32x32x16_f16(a[1][kk], b[kk], acc[1], 0, 0, 0); }
    const int s = t * 32 + c;
#pragma unroll
    for (int m = 0; m < 2; ++m)
#pragma unroll
        for (int k = 0; k < 2; ++k) { const int ql = 8 * qh + 4 * m + 2 * hi + k;
            float e_[8];
#pragma unroll
            for (int r = 0; r < 8; ++r) e_[r] = __builtin_amdgcn_fmed3f(acc[m][8 * k + r], 0.f, sg[m][8 * k + r]);
            const float v = fadd1(fadd1(fadd1(e_[0], e_[1]), fadd1(e_[2], e_[3])), fadd1(fadd1(e_[4], e_[5]), fadd1(e_[6], e_[7])));
            const unsigned key = fkey(v);
            ks[(2 * m + k) * 64] = key;
            const int bin = kbin(key);
            IDX_LATOM_ADD(hist + ql * 2048 + (bin >> 1), (!CHECK || s <= q0 + ql) ? (1u << (16 * (bin & 1))) : 0u); }
}
__device__ __forceinline__ void pass1(const f16_t* KIb  , const f16x8 (&a)[2][4], const float (&sg)[2][16], int q0, int qh, int kp, int lane, LAS unsigned char* lds, unsigned* ks  ) {
    LAS unsigned* hist = (LAS unsigned*)(lds + HIST_OFF);
    const int tmax = (q0 + 15) >> 5;
    if (kp > tmax) return;
    int tl = kp + ((tmax - kp) & ~3);
    const bool own = tl == tmax;
    const f16_t* kr = KIb + lane * 8;
    f16x8 b0[4], b1[4], b2[4], b3[4];
#define IDX_LD(dst, t_) do { const int tt_ = (t_) < tmax ? (t_) : tmax; const f16_t* p_ = kr + (size_t)tt_ * 2048; _Pragma("unroll") for (int kk = 0; kk < 4; ++kk) dst[kk] = *(const f16x8*)(p_ + kk * 512); __builtin_amdgcn_fence(__ATOMIC_RELEASE, "wavefront"); } while (0)
#define IDX_TILE(bb, tt) do { tile1<false>(bb, tt, a, sg, q0, qh, lane, hist, ks); ks += 256; } while (0)
    int t = kp;
    if (own) IDX_LD(b3, tmax);
    IDX_LD(b0, t); IDX_LD(b1, t + 4); IDX_LD(b2, t + 8);
    if (own) { tile1<true>(b3, tmax, a, sg, q0, qh, lane, hist, ks + ((tmax - kp) >> 2) * 256); tl -= 4; }
    for (; t + 12 <= tl; t += 16) {
        IDX_LD(b3, t + 12); IDX_TILE(b0, t);
        IDX_LD(b0, t + 16); IDX_TILE(b1, t + 4);
        IDX_LD(b1, t + 20); IDX_TILE(b2, t + 8);
        IDX_LD(b2, t + 24); IDX_TILE(b3, t + 12);
    }
    if (t <= tl) { IDX_TILE(b0, t); if (t + 4 <= tl) { IDX_TILE(b1, t + 4); if (t + 8 <= tl) IDX_TILE(b2, t + 8); } }
#undef IDX_LD
#undef IDX_TILE
}
__device__ __forceinline__ void pass2(int q0, int qh, int kp, int lane, LAS unsigned char* lds, const unsigned* ks) {
    const int c = lane & 31, hi = lane >> 5;
    LAS unsigned* hist = (LAS unsigned*)(lds + HIST_OFF); LAS unsigned* maskl = (LAS unsigned*)(lds + MASKL_OFF); LAS int* meta = (LAS int*)(lds + META_OFF);
    const int tmax = (q0 + 15) >> 5;
    if (kp > tmax) return;
    const int n = ((tmax - kp) >> 2) + 1;
    int thr[4];
#pragma unroll
    for (int j = 0; j < 4; ++j) thr[j] = meta[(8 * qh + 4 * (j >> 1) + 2 * hi + (j & 1)) * 4];
    unsigned ka[16], kb[16];
#define IDX_LDG(dst, g_) do { _Pragma("unroll") for (int u = 0; u < 4; ++u) { const int i_ = 4 * (g_) + u < n ? n - 1 - (4 * (g_) + u) : 0; _Pragma("unroll") for (int j = 0; j < 4; ++j) dst[4 * u + j] = ks[i_ * 256 + j * 64]; } \
        __builtin_amdgcn_fence(__ATOMIC_RELEASE, "wavefront"); } while (0)
#define IDX_PRG(src, g_) do { _Pragma("unroll") for (int u = 0; u < 4; ++u) { const int io_ = 4 * (g_) + u; if (io_ < n) { const int i_ = n - 1 - io_, t = kp + 4 * i_, s = t * 32 + c; \
        _Pragma("unroll") for (int m = 0; m < 2; ++m) { unsigned long long bal[2]; \
            _Pragma("unroll") for (int k = 0; k < 2; ++k) { const int ql = 8 * qh + 4 * m + 2 * hi + k; const unsigned key = src[4 * u + 2 * m + k]; const int bin = kbin(key); const bool valid = s <= q0 + ql; \
                bal[k] = __ballot(valid && bin > thr[2 * m + k]); \
                if (valid && bin == thr[2 * m + k]) { const unsigned p = IDX_LATOM_ADD((LAS unsigned*)(meta + ql * 4 + 2), 1u); \
                    if (p < (unsigned)CAP) { LAS unsigned* e = hist + ql * 2048 + 2 * p; e[0] = key; e[1] = (unsigned)s; } } } \
            if (lane == 0) { const int qb = 8 * qh + 4 * m; \
                maskl[(qb + 0) * 128 + t] = (unsigned)bal[0]; maskl[(qb + 2) * 128 + t] = (unsigned)(bal[0] >> 32); \
                maskl[(qb + 1) * 128 + t] = (unsigned)bal[1]; maskl[(qb + 3) * 128 + t] = (unsigned)(bal[1] >> 32); } } } } } while (0)
    const int ng = (n + 3) >> 2;
    IDX_LDG(ka, 0);
    for (int g = 0; g < ng; g += 2) {
        IDX_LDG(kb, g + 1); IDX_PRG(ka, g);
        IDX_LDG(ka, g + 2); IDX_PRG(kb, g + 1);
    }
#undef IDX_LDG
#undef IDX_PRG
}
struct Ops { f16x8 q[2][4]; float w[2]; f32x4 s[2][2][2]; };
__device__ __forceinline__ void load_raw(int b, int q0, const f16_t* QI, const float* WI, int wid, Ops& o) {
    const int lane = lane_opaque(), c = lane & 31, hi = lane >> 5, qh = wid & 1;
#pragma unroll
    for (int m = 0; m < 2; ++m) { const int qq = 2 * ((c >> 2) & 1) + (c >> 4), hd = 4 * ((c >> 3) & 1) + (c & 3);
        const size_t row = (size_t)b * SEQ + q0 + 8 * qh + 4 * m + qq;
        const f16_t* qr = QI + row * 512 + hd * 64 + hi * 8; o.w[m] = WI[row * 8 + hd];
#pragma unroll
        for (int kk = 0; kk < 4; ++kk) o.q[m][kk] = *(const f16x8*)(qr + kk * 16);
#pragma unroll
        for (int k = 0; k < 2; ++k) { const float* wp = WI + ((size_t)b * SEQ + q0 + 8 * qh + 4 * m + 2 * hi + k) * 8; o.s[m][k][0] = *(const f32x4*)wp; o.s[m][k][1] = *(const f32x4*)(wp + 4); } }
}
__device__ __forceinline__ void unit(int b, int q0, bool has_next, const f16_t* QI, const f16_t* KI, const float* WI, unsigned long long* MASK, unsigned* KS  , unsigned char* lds_, int wid, Ops& ops) {
    LAS unsigned char* lds = (LAS unsigned char*)lds_;
    const int lane = lane_opaque(), tid = wid * 64 + lane, c = lane & 31, hi = lane >> 5, qh = wid & 1, kp = wid >> 1;
    LAS unsigned* hist = (LAS unsigned*)(lds + HIST_OFF); LAS unsigned* maskl = (LAS unsigned*)(lds + MASKL_OFF); LAS int* meta = (LAS int*)(lds + META_OFF);
    for (int i = tid; i < 8192 + 512; i += NTHR) ((LAS u32x4*)hist)[i] = (u32x4){0u, 0u, 0u, 0u};
    if (tid < 64) meta[tid] = 0;
    f16x8 a[2][4]; float sg[2][16];
#pragma unroll
    for (int m = 0; m < 2; ++m) { const f16_t w = (f16_t)ops.w[m];
#pragma unroll
        for (int kk = 0; kk < 4; ++kk) a[m][kk] = ops.q[m][kk] * w;
#pragma unroll
        for (int r = 0; r < 16; ++r) { const float w2 = ops.s[m][r >> 3][(r >> 2) & 1][r & 3];
            sg[m][r] = (float)(f16_t)w2 < 0.f ? -__builtin_inff() : __builtin_inff(); } }
    const f16_t* KIb = KI + (size_t)b * SEQ * 64;
    __syncthreads();
    unsigned* ks = KS + (size_t)wid * 8192 + lane;
    pass1(KIb, a, sg, q0, qh, kp, lane, lds, ks);
    load_raw(b, has_next ? q0 + 16 : q0, QI, WI, wid, ops);
    __syncthreads();
#pragma unroll
    for (int k = 0; k < 2; ++k) { const int qi = 2 * wid + k, N = q0 + qi + 1;
        if (N > 256) {
            const LAS u32x4* h4 = (const LAS u32x4*)(hist + qi * 2048 + lane * 32);
            u32x4 hv[8];
#pragma unroll
            for (int i = 0; i < 8; ++i) hv[i] = h4[(i + lane) & 7];
            int tot = 0;
#pragma unroll
            for (int i = 0; i < 8; ++i)
#pragma unroll
                for (int d = 0; d < 4; ++d) { const unsigned w = hv[i][d]; tot += (int)(w & 0xffffu) + (int)(w >> 16); }
            const int suf = suffix_sum64(tot, lane);
            const unsigned long long ge = __ballot(suf >= 256);
            const int L = 63 - __clzll((long long)ge);
            const int above = __builtin_amdgcn_readlane(suf - tot, L);
            const unsigned w = hist[qi * 2048 + L * 32 + (lane >> 1)]; const int cnt = (lane & 1) ? (int)(w >> 16) : (int)(w & 0xffffu);
            const int sb = suffix_sum64(cnt, lane);
            const unsigned long long g2 = __ballot(above + sb >= 256);
            const int Bn = 63 - __clzll((long long)g2);
            if (lane == Bn) { meta[qi * 4] = L * 64 + Bn; meta[qi * 4 + 1] = 256 - (above + sb - cnt); }
        } else if (lane == 0) { meta[qi * 4] = -1; meta[qi * 4 + 1] = 0; }
    }
    __syncthreads();
    VM_WAIT();
    pass2(q0, qh, kp, lane, lds, ks);
    __syncthreads();
#pragma unroll
    for (int k = 0; k < 2; ++k) { const int qi = 2 * wid + k; const int need = __builtin_amdgcn_readfirstlane(meta[qi * 4 + 1]); int n = __builtin_amdgcn_readfirstlane(meta[qi * 4 + 2]); n = n < CAP ? n : CAP;
        const LAS unsigned* cl = hist + qi * 2048;
        if (n <= 64) {
            unsigned lo = 0u, hi2 = 0u;
            if (lane < n) { const u32x2 w = *(const LAS u32x2*)(cl + 2 * lane); lo = (w.x << 12) | (4095u - w.y); hi2 = w.x >> 20; }
            const unsigned long long mine = ((unsigned long long)hi2 << 32) | lo; int rank = 0;
            for (int j = 0; j < n; ++j) { const unsigned long long cj = ((unsigned long long)(unsigned)__builtin_amdgcn_readlane((int)hi2, j) << 32) | (unsigned)__builtin_amdgcn_readlane((int)lo, j); rank += cj > mine ? 1 : 0; }
            if (lane < n && rank < need) { const unsigned si = 4095u - (lo & 0xfffu); IDX_LATOM_OR(maskl + qi * 128 + (si >> 5), 1u << (si & 31)); }
        } else if (n <= 256) {
            unsigned long long cv[4];
#pragma unroll
            for (int e = 0; e < 4; ++e) { const int i = lane + 64 * e; cv[e] = 0ull;
                if (i < n) { const u32x2 w = *(const LAS u32x2*)(cl + 2 * i); cv[e] = ((unsigned long long)w.x << 12) | (unsigned long long)(4095u - w.y); } }
            unsigned long long Tv = 0ull;
            if (n > 0) for (int b = 43; b >= 0; --b) { const unsigned long long t = Tv | (1ull << b); int cnt = 0;
#pragma unroll
                for (int e = 0; e < 4; ++e) cnt += __popcll(__ballot(cv[e] >= t));
                if (cnt >= need) Tv = t; }
#pragma unroll
            for (int e = 0; e < 4; ++e) { const int i = lane + 64 * e; if (i < n && cv[e] >= Tv) { const unsigned si = 4095u - (unsigned)(cv[e] & 0xfffull); IDX_LATOM_OR(maskl + qi * 128 + (si >> 5), 1u << (si & 31)); } }
        } else {
            for (int i0 = 0; i0 < n; i0 += 64) { const int i = i0 + lane; const bool act = i < n; const unsigned ki = act ? cl[2 * i] : 0u, si = act ? cl[2 * i + 1] : 0u; int rank = 0;
                for (int j = 0; j < n; j += 2) { const u32x4 e = *(const LAS u32x4*)(cl + 2 * j);
                    rank += (e.x > ki || (e.x == ki && e.y < si)) ? 1 : 0; if (j + 1 < n) rank += (e.z > ki || (e.z == ki && e.w < si)) ? 1 : 0; }
                if (act && rank < need) IDX_LATOM_OR(maskl + qi * 128 + (si >> 5), 1u << (si & 31)); }
        }
    }
    __syncthreads();
    { const int qi = tid >> 5, w4 = tid & 31;
      const u32x4 v = *(const LAS u32x4*)(maskl + qi * 128 + w4 * 4);
      unsigned long long* tb_ = MASK + ((size_t)b * SEQ + (q0 & ~63)) * 64 + (q0 & 63) + qi;
      *(u32x2*)(tb_ + (size_t)(2 * w4) * 64) = (u32x2){v.x, v.y}; *(u32x2*)(tb_ + (size_t)(2 * w4 + 1) * 64) = (u32x2){v.z, v.w}; }
    __syncthreads();
}
#undef IDX_LATOM_ADD
#undef IDX_LATOM_OR
}


__device__ __forceinline__ void phase6(const Args& A, unsigned char* lds_, const int wave) {
    char* lds = (char*)lds_;
    att::Seam S;
#define P6_WS() unsigned char* ws = A.ws; asm volatile("" : "+s"(ws))
    for (int v = blockIdx.x; v < 256; v += gridDim.x) {
        {
            P6_WS();
            const bf16_t* QM = (const bf16_t*)(ws + WS_QM); const bf16_t* KM = (const bf16_t*)(ws + WS_KM); const bf16_t* VM = (const bf16_t*)(ws + WS_VM);
            bf16_t* OO = (bf16_t*)(ws + WS_H); float* SSQO = (float*)(ws + WS_OM); const float* KMEAN = (const float*)(ws + WS_KMEAN);
            const int bh = (v & 7) * 4 + (v >> 6), j = (v >> 3) & 7;
            for (int ps = 0; ps < 2; ++ps) { const int qb = ps ? 15 - j : j; const int qpos = qb * 256 + 32 * wave;
                if ((v & 3) == ps) { __syncthreads(); convert_experts(A, lds_, wave); __syncthreads(); }
                att::Blk cur; cur.Qw = QM + ((size_t)bh * SEQ + qpos) * 128; cur.K = KM + (size_t)bh * SEQ * 128; cur.V = VM + (size_t)bh * SEQ * 128;
                cur.Ow = OO + ((size_t)(bh >> 2) * SEQ + qpos) * 1024 + (bh & 3) * 128; cur.Sq = SSQO + ((size_t)(bh >> 2) * SEQ + qpos) * 8 + (bh & 3); cur.NT = 4 * (qb + 1); cur.qpos = qpos; cur.own_t0 = 4 * qb; cur.mrow = nullptr;
                att::att_prime(cur, lds, S, wave);
                att::moba_gate(S, KMEAN + (size_t)bh * 16 * 128, qb, lds, wave);
                att::att_block<0>(cur, cur, lds, S, wave); }
        }
        {
            P6_WS();
            const bf16_t* QD = (const bf16_t*)(ws + WS_QD); const bf16_t* KD = (const bf16_t*)(ws + WS_KD); const bf16_t* VD = (const bf16_t*)(ws + WS_VD);
            bf16_t* OO = (bf16_t*)(ws + WS_H); float* SSQO = (float*)(ws + WS_OM);
            const f16_t* QI = (const f16_t*)(ws + WS_QI); const f16_t* KI = (const f16_t*)(ws + WS_KI); const float* WI = (const float*)(ws + WS_WI);
            unsigned long long* MASK = (unsigned long long*)(ws + WS_MASK);
            const int b = 2 * (v & 3) + ((v >> 3) & 1), j = (v >> 4) + 16 * ((v >> 2) & 1);
            for (int ps = 0; ps < 2; ++ps) { const int qt = ps ? 63 - j : j;
                if ((v & 3) == 2 + ps) { __syncthreads(); convert_experts(A, lds_, wave); __syncthreads(); }
                { idx::Ops ops; idx::load_raw(b, 64 * qt, QI, WI, wave, ops);
                  for (int i = 0; i < 4; ++i) idx::unit(b, 64 * qt + 16 * i, i < 3, QI, KI, WI, MASK, (unsigned*)(ws + WS_KS) + (size_t)blockIdx.x * 65536, lds_, wave, ops); }
                VM_WAIT(); __syncthreads();
                const int qpos = 64 * qt + 32 * (wave >> 2), hd = wave & 3;
                att::Blk cur; cur.Qw = QD + ((size_t)(b * 4 + hd) * SEQ + qpos) * 128; cur.K = KD + (size_t)b * SEQ * 128; cur.V = VD + (size_t)b * SEQ * 128;
                cur.Ow = OO + ((size_t)b * SEQ + qpos) * 1024 + 512 + hd * 128; cur.Sq = SSQO + ((size_t)b * SEQ + qpos) * 8 + 4 + hd; cur.NT = qt + 1; cur.qpos = qpos; cur.own_t0 = 0; cur.mrow = MASK + ((size_t)b * SEQ + 64 * qt) * 64;
                att::att_prime(cur, lds, S, wave);
                att::att_block<1>(cur, cur, lds, S, wave); }
        }
    }
#undef P6_WS
}

__device__ __forceinline__ void phase9(const Args& A, const int wave) {
    const int lane = lane_opaque();
    const int gw = blockIdx.x * NWAVES + wave, NGW = gridDim.x * NWAVES;
    const bf16_t* x1 = (const bf16_t*)(A.ws + WS_X1); const float* mod = (const float*)(A.ws + WS_MOD); bf16_t* H2 = (bf16_t*)(A.ws + WS_H2);
#define P9_LDX(dst_, r_) do { _Pragma("unroll") for (int j_ = 0; j_ < 4; ++j_) dst_[j_] = *((const u32x2*)(x1 + (size_t)(r_) * DM) + lane + 64 * j_); } while (0)
#define P9_FIN(raw_, row_, sh_, sc_) do { f32x4 v[4]; \
        _Pragma("unroll") for (int j = 0; j < 4; ++j) v[j] = (f32x4){bflo(raw_[j].x), bfhi(raw_[j].x), bflo(raw_[j].y), bfhi(raw_[j].y)}; \
        modnorm_fin(v, g, sh_, sc_); \
        _Pragma("unroll") for (int j = 0; j < 4; ++j) { unsigned h[4]; float l[4]; \
            _Pragma("unroll") for (int k = 0; k < 4; ++k) { h[k] = f2bf(v[j][k]); l[k] = v[j][k] - bf2f(h[k]); } \
            u32x2 oh, ol; oh.x = h[0] | (h[1] << 16); oh.y = h[2] | (h[3] << 16); ol.x = pk2(l[0], l[1]); ol.y = pk2(l[2], l[3]); \
            *((u32x2*)(H2 + (size_t)(row_) * 2048) + lane + 64 * j) = oh; *((u32x2*)(H2 + (size_t)(row_) * 2048 + 1024) + lane + 64 * j) = ol; } } while (0)
    f32x4 g[4]; MN_LD4(g, A.in[11]);
    u32x2 ca[4], cb[4], na[4], nb[4];
    if (gw < T) { P9_LDX(ca, gw); P9_LDX(cb, gw + NGW < T ? gw + NGW : gw); }
    for (int row = gw; row < T; row += 2 * NGW) {
        const int rowB = row + NGW; const bool hasB = rowB < T; const int rB = hasB ? rowB : row;
        const float* mbA = mod + (size_t)(row >> 12) * 6144; const float* mbB = mod + (size_t)(rB >> 12) * 6144;
        f32x4 shA[4], scA[4], shB[4], scB[4];
        MN_LD4(shA, mbA + 3072); MN_LD4(scA, mbA + 4096); MN_LD4(shB, mbB + 3072); MN_LD4(scB, mbB + 4096);
        const int nA = row + 2 * NGW < T ? row + 2 * NGW : row, nB = row + 3 * NGW < T ? row + 3 * NGW : row;
        P9_LDX(na, nA); P9_LDX(nb, nB);
        P9_FIN(ca, row, shA, scA);
        if (hasB) P9_FIN(cb, rowB, shB, scB);
#pragma unroll
        for (int j = 0; j < 4; ++j) { ca[j] = na[j]; cb[j] = nb[j]; }
    }
#undef P9_LDX
#undef P9_FIN
}

__device__ __forceinline__ void phase11(const Args& A, unsigned char* lds_, const int wave) {
    const int lane = lane_opaque();
    LAS int* sE = (LAS int*)((LAS unsigned char*)lds_ + wave * 1024); LAS float* sW = (LAS float*)(sE + 128);
    LAS int* hcnt = (LAS int*)((LAS unsigned char*)lds_ + 8192); LAS int* hbase = hcnt + NE;
    { const int t_ = wave * 64 + lane; if (t_ < NE) hcnt[t_] = 0; } __syncthreads();
    const int gw = blockIdx.x * NWAVES + wave, NGW = gridDim.x * NWAVES;
    unsigned char* ws = A.ws;
    const float* RLOG = (const float*)(ws + WS_RLOG); const float* bias = A.in[13];
    float* EW = (float*)(ws + WS_EW); int* LIST = (int*)(ws + WS_LIST); int* CNT = (int*)(ws + WS_CTL) + CW_CNT;
    const float NINF = -__builtin_inff();
    const int half = lane >> 5;
    float ra[4], rb[4], bs[4];
    { const int g0 = gw < T ? gw : T - 1;
#pragma unroll
      for (int j = 0; j < 4; ++j) { const int e = lane + 64 * j; ra[j] = RLOG[(size_t)g0 * 512 + e]; rb[j] = RLOG[(size_t)g0 * 512 + 256 + e]; bs[j] = bias[e]; } }
    int it = 0;
    for (int row = gw; row < T; row += NGW, ++it) {
        float sc[4], bv[4];
#pragma unroll
        for (int j = 0; j < 4; ++j) { const float lg = ra[j] + rb[j];
            sc[j] = __builtin_amdgcn_rcpf(1.f + __expf(-lg)); bv[j] = sc[j] + bs[j]; }
        { const int rn = row + NGW < T ? row + NGW : row;
#pragma unroll
          for (int j = 0; j < 4; ++j) { const int e = lane + 64 * j; ra[j] = RLOG[(size_t)rn * 512 + e]; rb[j] = RLOG[(size_t)rn * 512 + 256 + e]; } }
        __builtin_amdgcn_sched_barrier(0);
        float gs[8];
#pragma unroll
        for (int j = 0; j < 4; ++j) { float m1l, m1h; half_max_dpp(bv[j], m1l, m1h); const float m1 = half ? m1h : m1l;
            const unsigned long long bal = __ballot(bv[j] == m1); const int fl = __ffs((unsigned)bal) - 1, fh = __ffs((unsigned)(bal >> 32)) - 1;
            const float v2 = ((lane & 31) == (half ? fh : fl)) ? NINF : bv[j]; float m2l, m2h; half_max_dpp(v2, m2l, m2h);
            gs[2 * j] = m1l + m2l; gs[2 * j + 1] = m1h + m2h; }
        const int gi = lane & 7; float mine = gs[0];
#pragma unroll
        for (int g = 1; g < 8; ++g) mine = (gi == g) ? gs[g] : mine;
        int rank = 0;
#pragma unroll
        for (int o = 0; o < 8; ++o) rank += (gs[o] > mine || (gs[o] == mine && o < gi)) ? 1 : 0;
        const unsigned gmask = (unsigned)__ballot(rank < 4) & 0xffu;
        float val[4];
#pragma unroll
        for (int j = 0; j < 4; ++j) val[j] = ((gmask >> (half + 2 * j)) & 1u) ? bv[j] : NINF;
        int ei[8]; float ew[8]; float wsum = 0.f;
#pragma unroll
        for (int r = 0; r < 8; ++r) {
            const float lm = fmaxf(fmaxf(val[0], val[1]), fmaxf(val[2], val[3])); const float m = wave_max_dpp(lm);
            const unsigned long long b0 = __ballot(val[0] == m), b1 = __ballot(val[1] == m), b2 = __ballot(val[2] == m), b3 = __ballot(val[3] == m);
            const int js = b0 ? 0 : b1 ? 1 : b2 ? 2 : 3; const unsigned long long bs = b0 ? b0 : b1 ? b1 : b2 ? b2 : b3;
            const int ls = __ffsll((long long)bs) - 1; const int es = ls + 64 * js;
            const float mys = js == 0 ? sc[0] : js == 1 ? sc[1] : js == 2 ? sc[2] : sc[3];
            const float w = rdl_f(mys, ls);
#pragma unroll
            for (int j = 0; j < 4; ++j) val[j] = (lane == ls && js == j) ? NINF : val[j];
            ei[r] = es; ew[r] = w; wsum += w; }
        int my_e = 0; float my_w = 0.f; const float wn = 2.5f / wsum;
#pragma unroll
        for (int r = 0; r < 8; ++r) if (lane == r) { my_e = ei[r]; my_w = ew[r] * wn; }
        if (lane < 8) { sE[it * 8 + lane] = my_e; sW[it * 8 + lane] = my_w; }
    }
    LDS_WAIT();
    int eL[2], rkL[2], entL[2]; bool actL[2];
#pragma unroll
    for (int h = 0; h < 2; ++h) { const int p = lane + 64 * h, ti = p >> 3; const int row = gw + ti * NGW;
        actL[h] = ti < it; eL[h] = 0; rkL[h] = 0; entL[h] = row * 8 + (p & 7);
        if (actL[h]) { eL[h] = sE[p]; EW[entL[h]] = sW[p]; rkL[h] = __hip_atomic_fetch_add(hcnt + eL[h], 1, __ATOMIC_RELAXED, __HIP_MEMORY_SCOPE_WORKGROUP); } }
    __syncthreads();
    { const int t_ = wave * 64 + lane; if (t_ < NE) { const int c = hcnt[t_]; hbase[t_] = c > 0 ? atomicAdd(&CNT[t_ * CNT_STRIDE], c) : 0; } }
    __syncthreads();
#pragma unroll
    for (int h = 0; h < 2; ++h) if (actL[h]) LIST[(size_t)eL[h] * T + hbase[eL[h]] + rkL[h]] = entL[h];
}

__device__ __forceinline__ int moe_tables(const Args& A, unsigned char* lds_, const int wave) {
    LAS int* cnt = (LAS int*)((LAS unsigned char*)lds_ + TAB_OFF); LAS int* tstart = cnt + 264;
    const int* CNT = (const int*)(A.ws + WS_CTL) + CW_CNT;
    const int tid = wave * 64 + lane_opaque();
    if (tid < NE) cnt[tid] = __hip_atomic_load(CNT + tid * CNT_STRIDE, __ATOMIC_RELAXED, __HIP_MEMORY_SCOPE_AGENT);
    if (tid == NE) cnt[NE] = T;
    __syncthreads();
    if (wave == 0) {
        const int l = tid; const u32x4 c4 = *(const LAS u32x4*)(cnt + 4 * l);
        const int t0 = (int)(c4.x + 255u) >> 8, t1 = (int)(c4.y + 255u) >> 8, t2 = (int)(c4.z + 255u) >> 8, t3 = (int)(c4.w + 255u) >> 8, loc = (t0 + t1) + (t2 + t3);
        int p = loc;
        p += idx::dpp_i0<0x111>(p); p += idx::dpp_i0<0x112>(p); p += idx::dpp_i0<0x114>(p); p += idx::dpp_i0<0x118>(p);
        const int r0 = __builtin_amdgcn_readlane(p, 15), r1 = __builtin_amdgcn_readlane(p, 31), r2 = __builtin_amdgcn_readlane(p, 47);
        const int rr = l >> 4; p += rr == 0 ? 0 : rr == 1 ? r0 : rr == 2 ? r0 + r1 : r0 + r1 + r2;
        const int ex = p - loc;
        *(LAS u32x4*)(tstart + 4 * l) = (u32x4){(unsigned)ex, (unsigned)(ex + t0), (unsigned)(ex + t0 + t1), (unsigned)(ex + t0 + t1 + t2)};
        if (l == 63) { tstart[NE] = p; tstart[NEX] = p + ((T + 255) >> 8); }
    }
    __syncthreads();
    return tstart[NEX];
}


__device__ __forceinline__ void phase14(const Args& A, const int wave) {
    const int lane = lane_opaque();
    const int gw = blockIdx.x * NWAVES + wave, NGW = gridDim.x * NWAVES;
    float* out = A.out; const float* mod = (const float*)(A.ws + WS_MOD); const int* INV = (const int*)(A.ws + WS_INV);
    const unsigned char* CA = (const unsigned char*)(A.ws + WS_CA); const bf16_t* SH = (const bf16_t*)(A.ws + WS_SH); const bf16_t* X1 = (const bf16_t*)(A.ws + WS_X1);
#define P14_LOAD(pr_, row_, w_, x_, g2_) do { _Pragma("unroll") for (int k = 0; k < 8; ++k) { const int p = __builtin_amdgcn_readlane(pr_, k); w_[k] = *((const u32x4*)(CA + (size_t)p * DM) + lane); } \
        _Pragma("unroll") for (int q = 0; q < 4; ++q) g2_[q] = *((const f32x4*)(mod + (size_t)((row_) >> 12) * 6144 + 5120 + 16 * lane) + q); \
        w_[8] = *((const u32x4*)((const unsigned char*)SH + (size_t)(row_) * DM) + lane); \
        w_[10] = *((const u32x4*)(X1 + (size_t)(row_) * DM + 16 * lane)); w_[11] = *((const u32x4*)(X1 + (size_t)(row_) * DM + 16 * lane) + 1); } while (0)
#define P14_FIN(row_, w_, x_, g2_) do { float* orow = out + (size_t)(row_) * DM + 16 * lane; \
        float y[16]; _Pragma("unroll") for (int q = 0; q < 16; ++q) y[q] = 0.f; \
        _Pragma("unroll") for (int k = 0; k < 8; ++k) _Pragma("unroll") for (int d = 0; d < 4; ++d) { \
            const f32x2 lo = __builtin_amdgcn_cvt_pk_f32_fp8((int)w_[k][d], false), hi = __builtin_amdgcn_cvt_pk_f32_fp8((int)w_[k][d], true); \
            y[4 * d] += lo[0]; y[4 * d + 1] += lo[1]; y[4 * d + 2] += hi[0]; y[4 * d + 3] += hi[1]; } \
        float ysh[16]; _Pragma("unroll") for (int d = 0; d < 4; ++d) { \
            const f32x2 lo = __builtin_amdgcn_cvt_pk_f32_fp8((int)w_[8][d], false), hi = __builtin_amdgcn_cvt_pk_f32_fp8((int)w_[8][d], true); \
            ysh[4 * d] = lo[0]; ysh[4 * d + 1] = lo[1]; ysh[4 * d + 2] = hi[0]; ysh[4 * d + 3] = hi[1]; } \
        float v[16]; float s = 0.f; \
        _Pragma("unroll") for (int q = 0; q < 4; ++q) { const f32x4 g = g2_[q]; \
            _Pragma("unroll") for (int e = 0; e < 4; ++e) { const unsigned xw = w_[10 + (q >> 1)][2 * (q & 1) + (e >> 1)]; \
                const float xv = (e & 1) ? bfhi(xw) : bflo(xw); \
                v[4 * q + e] = xv + g[e] * (y[4 * q + e] * (1.f / 16.f) + ysh[4 * q + e] * 0.25f); s += v[4 * q + e] * v[4 * q + e]; } } \
        const float rstd = 1.f / sqrtf(wave_sum_dpp(s) * (1.f / DM) + EPS); \
        _Pragma("unroll") for (int q = 0; q < 4; ++q) { const f32x4 g = gfin[q]; \
            *((f32x4*)orow + q) = (f32x4){v[4 * q] * rstd * g[0], v[4 * q + 1] * rstd * g[1], v[4 * q + 2] * rstd * g[2], v[4 * q + 3] * rstd * g[3]}; } } while (0)
    f32x4 gfin[4];
#pragma unroll
    for (int q = 0; q < 4; ++q) gfin[q] = *((const f32x4*)(A.in[20] + 16 * lane) + q);
    int prA = (gw < T) ? INV[(size_t)gw * 8 + (lane & 7)] : 0, prB = (gw + NGW < T) ? INV[(size_t)(gw + NGW) * 8 + (lane & 7)] : 0;
    for (int row = gw; row < T; row += 2 * NGW) {
        const int rowB = row + NGW; const bool hasB = rowB < T;
        const int pa = prA, pb = prB;
        if (row + 2 * NGW < T) prA = INV[(size_t)(row + 2 * NGW) * 8 + (lane & 7)];
        if (row + 3 * NGW < T) prB = INV[(size_t)(row + 3 * NGW) * 8 + (lane & 7)];
        u32x4 wa[12], wb[12]; f32x4 xa[4], xb[4], ga[4], gb[4];
        P14_LOAD(pa, row, wa, xa, ga);
        if (hasB) P14_LOAD(pb, rowB, wb, xb, gb);
        P14_FIN(row, wa, xa, ga);
        if (hasB) P14_FIN(rowB, wb, xb, gb);
    }
#undef P14_LOAD
#undef P14_FIN
}

__global__ void __launch_bounds__(NTHR, 2) fwd(Args args) {
    extern __shared__ __attribute__((aligned(16))) unsigned char lds[];
    const int wave = __builtin_amdgcn_readfirstlane((int)threadIdx.x >> 6);
    volatile LAS unsigned* MISC = (volatile LAS unsigned*)((LAS unsigned char*)lds + MISC_OFF);
    if (wave == 0) MISC[lane_opaque()] = 0u;
    __syncthreads();
    const int lo = args.ph_lo, hi = args.ph_hi;
    unsigned char* ws = args.ws;
    XcdBarrier bar; bar.bar = (unsigned*)(ws + WS_CTL); bar.x = 0; bar.st = nullptr;
    if (hi - lo > 1) bar = xcd_barrier_post((unsigned*)(ws + WS_CTL), MISC, wave == 0 && lane_opaque() == 0);
    const int G = gridDim.x, cid = blockIdx.x;
#define IN(k) (lo <= (k) && (k) < hi)
#define SEAM(k) do { if (IN(k) && IN((k) + 1)) xcd_barrier(bar, wave); } while (0)
    LAS unsigned char* ring = (LAS unsigned char*)lds;

    if (IN(0)) { phase0(args, lds, wave); __syncthreads(); } SEAM(0);
    if (IN(1)) { phase1(args, wave); } SEAM(1);
    if (IN(2)) {
        pg8::DenseSched S; S.init(ws + WS_H, 2048u, ws + WS_WIN, 2048u, T, NPROJP, G, cid);
        pg8::EpiProjFused E{(bf16_t*)(ws + WS_QM), (bf16_t*)(ws + WS_KM), (bf16_t*)(ws + WS_VM), (bf16_t*)(ws + WS_QD), (bf16_t*)(ws + WS_CKVN), (float*)(ws + WS_KVRAW),
                            (f16_t*)(ws + WS_QI), (f16_t*)(ws + WS_KI), (float*)(ws + WS_WI), (const float*)(ws + WS_COSH), (const float*)(ws + WS_SINH), (const float*)(ws + WS_COSI), (const float*)(ws + WS_SINI)};
        pg8::gemm_phase<pg8::EpiProjFused, pg8::DenseSched, true>(ring, S, E, 1024, wave);
    }
    if (IN(2) && IN(4)) xcd_barrier(bar, wave);
    if (IN(4)) {
        const int ngemm = T / 256;
        if (G > ngemm && cid >= ngemm) kmean_units(args, lds, wave, cid - ngemm, G - ngemm);
        else {
            pg8::DenseSched S; S.init(ws + WS_CKVN, 512u, ws + WS_WKV, 512u, T, 256, G, cid);
            pg8::EpiKV E{(bf16_t*)(ws + WS_KD), (bf16_t*)(ws + WS_VD), (const float*)(ws + WS_KVRAW), (const float*)(ws + WS_COSH), (const float*)(ws + WS_SINH)};
            pg8::gemm_phase<pg8::EpiKV, pg8::DenseSched, true>(ring, S, E, 256, wave);
            if (G <= ngemm) { __syncthreads(); kmean_units(args, lds, wave, cid, G); }
        }
    }
    if (IN(4) && IN(6)) xcd_barrier(bar, wave);
    if (IN(6)) { phase6(args, lds, wave); __syncthreads(); }
    if (IN(6) && IN(8)) xcd_barrier(bar, wave);
    if (IN(8)) {
        pg8::DenseSched S; S.init(ws + WS_H, 2048u, ws + WS_WOUT, 2048u, T, 1024, G, cid);
        pg8::EpiResidNorm E{args.in[0], (bf16_t*)(ws + WS_X1), (const float*)(ws + WS_MOD), (const float*)(ws + WS_OM), (LAS float*)((LAS unsigned char*)lds + TOK_OFF)};
        pg8::gemm_phase<pg8::EpiResidNorm, pg8::DenseSched, true, true>(ring, S, E, 1024, wave);
    } SEAM(8);
    if (IN(9)) { phase9(args, wave); } SEAM(9);
    if (IN(10)) {
        pg8::DenseSched S; S.init(ws + WS_H2, 4096u, ws + WS_WR, 4096u, T, 512, G, cid);
        pg8::EpiF32 E{(float*)(ws + WS_RLOG), 512};
        pg8::gemm_phase<pg8::EpiF32, pg8::DenseSched, true>(ring, S, E, 2048, wave);
    } SEAM(10);
    if (IN(11)) { phase11(args, lds, wave); } SEAM(11);
    if (IN(12)) {
        const int total_rt = moe_tables(args, lds, wave);
        pg8::MoeTab tb{(const LAS int*)((LAS unsigned char*)lds + TAB_OFF), (const LAS int*)((LAS unsigned char*)lds + TAB_OFF) + 264};
        LAS int* tokl = (LAS int*)((LAS unsigned char*)lds + TOK_OFF);
        LAS int* utab = (LAS int*)((LAS unsigned char*)lds + TAB_OFF) + 528;
        pg8::MoeUpSched S{tb, (const char*)(ws + WS_H2), tokl, (const char*)(ws + WS_WGU), 2048u, total_rt * 2, G, cid, utab};
        { const int t_ = wave * 64 + lane_opaque(); if (t_ < pg8::UT_MAX) { pg8::Unit u; const bool ok = S.compute(t_, u); *(LAS u32x4*)(utab + 4 * t_) = ok ? (u32x4){(unsigned)u.e, (unsigned)u.rt, (unsigned)(u.pn | ((u.e == NE ? 256 : (tb.cnt[u.e] - u.pm * 256 < 256 ? tb.cnt[u.e] - u.pm * 256 : 256)) << 8)), (unsigned)u.pm} : (u32x4){~0u, 0u, 0u, 0u}; } __syncthreads(); }
        {
            const int lane = lane_opaque(), tid = wave * 64 + lane, half = tid >> 8, row = tid & 255;
            const int* list = (const int*)(ws + WS_LIST); const float* ew = (const float*)(ws + WS_EW); int* inv = (int*)(ws + WS_INV);
            int ue = -1, upm = 0, urt = 0;
            { pg8::Unit u; if (lane < MAX_UNITS && S.next(lane, u)) { ue = u.e; upm = u.pm; urt = u.rt; } }
            const int nun = __popcll(__ballot(ue >= 0));
            for (int i0 = 0; i0 < MAX_UNITS / 2; i0 += 5) {
                int ent[5], ke[5], kpos[5], krt[5]; bool val[5];
#pragma unroll
                for (int jj = 0; jj < 5; ++jj) { const int k = half + 2 * (i0 + jj), kc = k < MAX_UNITS ? k : 0;
                    ke[jj] = __builtin_amdgcn_readlane(ue, kc); krt[jj] = __builtin_amdgcn_readlane(urt, kc); kpos[jj] = __builtin_amdgcn_readlane(upm, kc) * 256 + row;
                    val[jj] = k < nun && ke[jj] != NE && kpos[jj] < tb.cnt[ke[jj] < 0 ? 0 : ke[jj]];
                    ent[jj] = list[(size_t)(val[jj] ? ke[jj] : 0) * T + (val[jj] ? kpos[jj] : 0)]; }
                float wv[5];
#pragma unroll
                for (int jj = 0; jj < 5; ++jj) { ent[jj] = val[jj] ? ent[jj] : 0; wv[jj] = ew[ent[jj]]; }
#pragma unroll
                for (int jj = 0; jj < 5; ++jj) { const int k = half + 2 * (i0 + jj);
                    if (k < nun) { unsigned tw = 0u;
                        if (ke[jj] == NE) tw = (unsigned)kpos[jj] | 0x3C000000u;
                        else if (val[jj]) { const f16_t wh = (f16_t)wv[jj]; tw = (unsigned)(ent[jj] >> 3) | ((unsigned)__builtin_bit_cast(unsigned short, wh) << 16); inv[ent[jj]] = krt[jj] * 256 + row; }
                        tokl[k * 256 + row] = (int)tw; } }
            }
            __syncthreads();
        }
        pg8::EpiAct E{(bf16_t*)(ws + WS_ACT), tokl};
        pg8::gemm_phase<pg8::EpiAct, pg8::MoeUpSched, true>(ring, S, E, 1024, wave);
    } SEAM(12);
    if (IN(13)) {
        const int total_rt = moe_tables(args, lds, wave);
        pg8::MoeTab tb{(const LAS int*)((LAS unsigned char*)lds + TAB_OFF), (const LAS int*)((LAS unsigned char*)lds + TAB_OFF) + 264};
        LAS int* utab = (LAS int*)((LAS unsigned char*)lds + TAB_OFF) + 528;
        pg8::MoeDownSched S{tb, (const char*)(ws + WS_ACT), (const char*)(ws + WS_WD), 512u, total_rt * 4, G, cid, utab};
        { const int t_ = wave * 64 + lane_opaque(); if (t_ < pg8::UT_MAX) { pg8::Unit u; const bool ok = S.compute(t_, u); *(LAS u32x4*)(utab + 4 * t_) = ok ? (u32x4){(unsigned)u.e, (unsigned)u.rt, (unsigned)(u.pn | ((u.e == NE ? 256 : (tb.cnt[u.e] - u.pm * 256 < 256 ? tb.cnt[u.e] - u.pm * 256 : 256)) << 8)), (unsigned)u.pm} : (u32x4){~0u, 0u, 0u, 0u}; } __syncthreads(); }
        pg8::EpiDown E{(bf16_t*)(ws + WS_CA), (bf16_t*)(ws + WS_SH)};
        pg8::gemm_phase<pg8::EpiDown, pg8::MoeDownSched, true>(ring, S, E, 256, wave);
    } SEAM(13);
    if (IN(14)) { phase14(args, wave); }
#undef IN
#undef SEAM
}

#ifndef N_LAUNCHES
#define N_LAUNCHES 1
#endif
extern "C" void kernel_launch(void* const* d_in, const int* in_sizes, int n_in, void* d_out, int out_size, void* d_ws, size_t ws_size, hipStream_t stream) {
    static int grid = 0;
    if (grid == 0) {
        if (n_in != 21 || in_sizes[0] != T * DM || out_size != T * DM || ws_size < WS_END) {
            fprintf(stderr, "kernel_launch: shape/workspace mismatch (n_in %d, in0 %d, out %d, ws %zu, need %zu); nothing launched\n", n_in, n_in > 0 ? in_sizes[0] : -1, out_size, ws_size, (size_t)WS_END); grid = -1; return; }
        int dev = 0, cus = 0, per_cu = 0;
        if (hipGetDevice(&dev) != hipSuccess || hipDeviceGetAttribute(&cus, hipDeviceAttributeMultiprocessorCount, dev) != hipSuccess) { grid = -1; return; }
        if (hipFuncSetAttribute((const void*)fwd, hipFuncAttributeMaxDynamicSharedMemorySize, LDS_BYTES) != hipSuccess) { fprintf(stderr, "kernel_launch: hipFuncSetAttribute failed\n"); grid = -1; return; }
        if (hipOccupancyMaxActiveBlocksPerMultiprocessor(&per_cu, (const void*)fwd, NTHR, LDS_BYTES) != hipSuccess || per_cu < 1) fprintf(stderr, "kernel_launch: occupancy query says %d\n", per_cu);
        (void)hipGetLastError();
        grid = cus;
    }
    if (grid < 0) return;
    (void)hipMemsetAsync((char*)d_ws + WS_CTL, 0, CTL_ZERO_BYTES, stream);
    Args a{};
    for (int i = 0; i < 21; ++i) a.in[i] = (const float*)d_in[i];
    a.out = (float*)d_out; a.ws = (unsigned char*)d_ws;
    if (N_LAUNCHES == 1) { a.ph_lo = 0; a.ph_hi = NPHASE; hipLaunchKernelGGL(fwd, dim3(grid), dim3(NTHR), LDS_BYTES, stream, a); }
    else for (int p = 0; p < NPHASE; ++p) { a.ph_lo = p; a.ph_hi = p + 1; hipLaunchKernelGGL(fwd, dim3(grid), dim3(NTHR), LDS_BYTES, stream, a); }
}
```
